# Optimizing an MI355X kernel written in HIP

```python
import math
import jax, jax.numpy as jnp
from jax import lax
import numpy as np

D_MODEL = 4096
BATCH = 1
SEQ = 16384
DEPTH = 1
DEC_BATCH = 32
DEC_SEQ = 32
PAST_LEN = 1024

CHUNK = 64
N_META = 16
Q_BLOCK = 128
EPS = 1e-6

W_A = D_MODEL // 2
HEAD_DIM_A = 128
N_HEADS_A = W_A // (2 * HEAD_DIM_A)
N_BUCKETS = 32
MAX_DISTANCE = 1024

W_B = D_MODEL - W_A
HEAD_DIM_B = 128
N_HEADS_B = W_B // HEAD_DIM_B
CONV_W = 4

IN_COLS = 4 * W_A + 4 * W_B + 2 * N_HEADS_B
SPLIT_POINTS = (W_A, 2 * W_A, 3 * W_A, 4 * W_A, 4 * W_A + 3 * W_B, 4 * W_A + 4 * W_B,
                4 * W_A + 4 * W_B + N_HEADS_B)

kernel_name = 'hymba_diffattn_gdn_streaming_step'


def rms_norm(x, w):
    xf = x.astype(jnp.float32)
    y = xf * lax.rsqrt(jnp.mean(xf * xf, axis=-1, keepdims=True) + EPS)
    return (y * w.astype(jnp.float32)).astype(x.dtype)


def l2_norm(x):
    return x * lax.rsqrt(jnp.sum(x * x, axis=-1, keepdims=True) + EPS)


def lambda_init(layer):
    return 0.8 - 0.6 * math.exp(-0.3 * layer)


def diff_lambda(lq1, lk1, lq2, lk2, lam_init):
    f = jnp.float32
    return (jnp.exp(jnp.sum(lq1.astype(f) * lk1.astype(f)))
            - jnp.exp(jnp.sum(lq2.astype(f) * lk2.astype(f))) + lam_init)


def rel_bucket(rel):
    nb = N_BUCKETS // 2
    max_exact = nb // 2
    n = jnp.abs(rel)
    nf = jnp.maximum(n, 1).astype(jnp.float32)
    large = max_exact + (jnp.log(nf / max_exact) / math.log(MAX_DISTANCE / max_exact)
                         * (nb - max_exact)).astype(jnp.int32)
    large = jnp.minimum(large, nb - 1)
    return jnp.where(rel > 0, nb, 0) + jnp.where(n < max_exact, n, large)


def attend(q, k, v, q_pos, q_chunk, k_pos, k_chunk, rel_bias, lam):
    bias = jnp.transpose(rel_bias[rel_bucket(k_pos[None, :] - q_pos[:, None])], (2, 0, 1))
    visible = k_chunk[None, :] <= q_chunk[:, None]
    s = jnp.einsum('bqhcd,bkhcd->bhcqk', q, k).astype(jnp.float32) * (HEAD_DIM_A ** -0.5)
    s = jnp.where(visible, s + bias.astype(jnp.float32)[None, :, None], -jnp.inf)
    p = jax.nn.softmax(s, axis=-1)
    a = p[:, :, 0] - lam * p[:, :, 1]
    return jnp.einsum('bhqk,bkhe->bqhe', a.astype(v.dtype), v)


def in_proj(xn, w_in):
    B, L, _ = xn.shape
    q_a, k_a, v_a, z_a, qkv_b, z_b, b_raw, a_raw = jnp.split(xn @ w_in, SPLIT_POINTS, axis=-1)
    q_a = q_a.reshape(B, L, N_HEADS_A, 2, HEAD_DIM_A)
    k_a = k_a.reshape(B, L, N_HEADS_A, 2, HEAD_DIM_A)
    v_a = v_a.reshape(B, L, N_HEADS_A, 2 * HEAD_DIM_A)
    return q_a, k_a, v_a, z_a, qkv_b, z_b, b_raw, a_raw


def causal_conv_silu(x, buf, w):
    L = x.shape[1]
    xp = jnp.concatenate([buf.astype(x.dtype), x], axis=1)
    y = xp[:, 0:L] * w[0]
    for i in range(1, CONV_W):
        y = y + xp[:, i:i + L] * w[i]
    return jax.nn.silu(y), xp[:, -(CONV_W - 1):]


def gdn_inputs(qkv, b_raw, a_raw, a_log, dt_bias):
    B, L, _ = qkv.shape
    f = jnp.float32
    q, k, v = jnp.split(qkv.astype(f), 3, axis=-1)
    q = l2_norm(q.reshape(B, L, N_HEADS_B, HEAD_DIM_B)) * (HEAD_DIM_B ** -0.5)
    k = l2_norm(k.reshape(B, L, N_HEADS_B, HEAD_DIM_B))
    v = v.reshape(B, L, N_HEADS_B, HEAD_DIM_B)
    beta = jax.nn.sigmoid(b_raw.astype(f))
    g = -jnp.exp(a_log.astype(f)) * jax.nn.softplus(a_raw.astype(f) + dt_bias.astype(f))
    return q, k, v, g, beta


def gdn_chunk(S, q, k, v, g, beta):
    L = q.shape[1]
    dv = v.shape[-1]
    q, k, v = (jnp.swapaxes(t, 1, 2) for t in (q, k, v))
    g, beta = jnp.swapaxes(g, 1, 2), jnp.swapaxes(beta, 1, 2)
    G = jnp.cumsum(g, axis=-1)
    incl = jnp.tril(jnp.ones((L, L), dtype=bool))
    strict = jnp.tril(jnp.ones((L, L), dtype=bool), -1)
    gamma = jnp.exp(jnp.where(incl, G[..., :, None] - G[..., None, :], -jnp.inf))
    a_mat = jnp.where(strict, beta[..., :, None] * jnp.einsum('bhid,bhjd->bhij', k, k) * gamma, 0.0)
    a_mat = a_mat + jnp.eye(L, dtype=q.dtype)
    rhs = jnp.concatenate([v * beta[..., None], k * (beta * jnp.exp(G))[..., None]], axis=-1)
    sol = jax.lax.linalg.triangular_solve(a_mat, rhs, left_side=True, lower=True, unit_diagonal=True)
    u, w = sol[..., :dv], sol[..., dv:]
    v_new = u - jnp.einsum('bhlk,bhkv->bhlv', w, S)
    o = (jnp.einsum('bhlk,bhkv->bhlv', q * jnp.exp(G)[..., None], S)
         + jnp.einsum('bhij,bhjv->bhiv', jnp.einsum('bhid,bhjd->bhij', q, k) * gamma, v_new))
    g_last = G[..., -1:]
    S_new = (S * jnp.exp(g_last)[..., None]
             + jnp.einsum('bhlk,bhlv->bhkv', k * jnp.exp(g_last - G)[..., None], v_new))
    return S_new, jnp.swapaxes(o, 1, 2)


def attn_gate_out(o, z, subln, lam_init):
    B, L = o.shape[:2]
    o = (rms_norm(o, subln) * (1.0 - lam_init)).reshape(B, L, W_A)
    return o * jax.nn.silu(z.astype(o.dtype))


def gdn_gate_out(o, z, norm_w):
    B, L = o.shape[:2]
    o = rms_norm(o, norm_w).reshape(B, L, W_B)
    return o * jax.nn.silu(z.astype(o.dtype))


def merge(h, y_a, y_b, w_out, post_norm):
    y = jnp.concatenate([y_a.astype(h.dtype), y_b.astype(h.dtype)], axis=-1) @ w_out
    return h + rms_norm(y, post_norm)


def prompt_layer(h, layer, rel_bias, pre_norm, w_in, lq1, lk1, lq2, lk2, subln_a, conv_b,
                 a_log, dt_bias, norm_b, w_out, post_norm):
    B = h.shape[0]
    q_a, k_a, v_a, z_a, qkv_b, z_b, b_raw, a_raw = in_proj(rms_norm(h, pre_norm), w_in)
    lam_init = lambda_init(layer)
    lam = diff_lambda(lq1, lk1, lq2, lk2, lam_init)
    pos = jnp.concatenate([jnp.arange(-N_META, 0, dtype=jnp.int32), jnp.arange(SEQ, dtype=jnp.int32)])
    chunk = jnp.concatenate([jnp.full((N_META,), -1, jnp.int32),
                             jnp.arange(SEQ, dtype=jnp.int32) // CHUNK])
    o_meta = attend(q_a[:, :N_META], k_a, v_a, pos[:N_META], chunk[:N_META], pos, chunk, rel_bias, lam)
    n_blk = SEQ // Q_BLOCK
    q_blocks = jnp.moveaxis(q_a[:, N_META:].reshape(B, n_blk, Q_BLOCK, N_HEADS_A, 2, HEAD_DIM_A), 1, 0)
    o_frames = lax.map(
        lambda a: attend(a[0], k_a, v_a, a[1], a[2], pos, chunk, rel_bias, lam),
        (q_blocks, pos[N_META:].reshape(n_blk, Q_BLOCK), chunk[N_META:].reshape(n_blk, Q_BLOCK)))
    o_frames = jnp.moveaxis(o_frames, 0, 1).reshape(B, SEQ, N_HEADS_A, 2 * HEAD_DIM_A)
    y_a = attn_gate_out(jnp.concatenate([o_meta, o_frames], axis=1), z_a, subln_a, lam_init)
    qkv_c, conv_state = causal_conv_silu(qkv_b, jnp.zeros((B, CONV_W - 1, 3 * W_B), qkv_b.dtype), conv_b)
    q, k, v, g, beta = gdn_inputs(qkv_c, b_raw, a_raw, a_log, dt_bias)
    s0 = jnp.zeros((B, N_HEADS_B, HEAD_DIM_B, HEAD_DIM_B), jnp.float32)
    s1, o_meta_b = gdn_chunk(s0, q[:, :N_META], k[:, :N_META], v[:, :N_META], g[:, :N_META], beta[:, :N_META])
    n_ch = SEQ // CHUNK
    to_chunks = lambda t: jnp.moveaxis(t[:, N_META:].reshape((B, n_ch, CHUNK) + t.shape[2:]), 1, 0)
    s_fin, o_b = lax.scan(lambda s, xs: gdn_chunk(s, *xs), s1,
                          tuple(to_chunks(t) for t in (q, k, v, g, beta)))
    o_b = jnp.moveaxis(o_b, 0, 1).reshape(B, SEQ, N_HEADS_B, HEAD_DIM_B)
    y_b = gdn_gate_out(jnp.concatenate([o_meta_b, o_b], axis=1), z_b, norm_b)
    return merge(h, y_a, y_b, w_out, post_norm), (k_a, v_a, s_fin, conv_state)


def sample_layer(h, k_cache, v_cache, ssm, conv_buf, layer, rel_bias, pre_norm, w_in, lq1, lk1, lq2, lk2,
                 subln_a, conv_b, a_log, dt_bias, norm_b, w_out, post_norm):
    L = h.shape[1]
    q_a, k_a, v_a, z_a, qkv_b, z_b, b_raw, a_raw = in_proj(rms_norm(h, pre_norm), w_in)
    lam_init = lambda_init(layer)
    lam = diff_lambda(lq1, lk1, lq2, lk2, lam_init)
    k_all = jnp.concatenate([k_cache.astype(k_a.dtype), k_a], axis=1)
    v_all = jnp.concatenate([v_cache.astype(v_a.dtype), v_a], axis=1)
    k_pos = jnp.concatenate([jnp.arange(-N_META, 0, dtype=jnp.int32), jnp.arange(PAST_LEN + L, dtype=jnp.int32)])
    k_chunk = jnp.concatenate([jnp.full((N_META,), -1, jnp.int32),
                               jnp.arange(PAST_LEN + L, dtype=jnp.int32) // CHUNK])
    q_pos = PAST_LEN + jnp.arange(L, dtype=jnp.int32)
    o_a = attend(q_a, k_all, v_all, q_pos, q_pos // CHUNK, k_pos, k_chunk, rel_bias, lam)
    y_a = attn_gate_out(o_a, z_a, subln_a, lam_init)
    qkv_c, conv_new = causal_conv_silu(qkv_b, conv_buf, conv_b)
    q, k, v, g, beta = gdn_inputs(qkv_c, b_raw, a_raw, a_log, dt_bias)
    s_new, o_b = gdn_chunk(ssm.astype(jnp.float32), q, k, v, g, beta)
    y_b = gdn_gate_out(o_b, z_b, norm_b)
    return merge(h, y_a, y_b, w_out, post_norm), (k_a, v_a, s_new, conv_new)


def setup_inputs(seed: int = 0) -> dict:
    key = jax.random.key(seed)
    ks = jax.random.split(key, 24)
    f = jnp.float32
    nrm = lambda k, shape, s: jax.random.normal(k, shape, f) * s
    dt = jnp.exp(jax.random.uniform(ks[17], (DEPTH, N_HEADS_B), f, math.log(1e-3), math.log(1e-1)))
    return {
        'x_prompt': nrm(ks[0], (BATCH, SEQ, D_MODEL), 1.0),
        'x_sample': nrm(ks[1], (DEC_BATCH, DEC_SEQ, D_MODEL), 1.0),
        'cache_k_a': nrm(ks[2], (DEPTH, DEC_BATCH, N_META + PAST_LEN, N_HEADS_A, 2, HEAD_DIM_A), 1.0),
        'cache_v_a': nrm(ks[3], (DEPTH, DEC_BATCH, N_META + PAST_LEN, N_HEADS_A, 2 * HEAD_DIM_A), 1.0),
        'state_ssm_b': nrm(ks[4], (DEPTH, DEC_BATCH, N_HEADS_B, HEAD_DIM_B, HEAD_DIM_B), 0.1),
        'state_conv_b': nrm(ks[5], (DEPTH, DEC_BATCH, CONV_W - 1, 3 * W_B), 1.0),
        'meta_tokens': nrm(ks[6], (N_META, D_MODEL), 1.0),
        'rel_bias': nrm(ks[7], (N_BUCKETS, N_HEADS_A), 0.5),
        'pre_norm': 1.0 + nrm(ks[8], (DEPTH, D_MODEL), 0.05),
        'w_in': nrm(ks[9], (DEPTH, D_MODEL, IN_COLS), D_MODEL ** -0.5),
        'lambda_q1': nrm(ks[10], (DEPTH, HEAD_DIM_A), 0.1),
        'lambda_k1': nrm(ks[11], (DEPTH, HEAD_DIM_A), 0.1),
        'lambda_q2': nrm(ks[12], (DEPTH, HEAD_DIM_A), 0.1),
        'lambda_k2': nrm(ks[13], (DEPTH, HEAD_DIM_A), 0.1),
        'subln_a': 1.0 + nrm(ks[14], (DEPTH, 2 * HEAD_DIM_A), 0.05),
        'conv_b': nrm(ks[15], (DEPTH, CONV_W, 3 * W_B), CONV_W ** -0.5),
        'a_log_b': jnp.log(jax.random.uniform(ks[16], (DEPTH, N_HEADS_B), f, 1.0, 16.0)),
        'dt_bias_b': dt + jnp.log(-jnp.expm1(-dt)),
        'norm_b': 1.0 + nrm(ks[18], (DEPTH, HEAD_DIM_B), 0.05),
        'w_out': nrm(ks[19], (DEPTH, D_MODEL, D_MODEL), D_MODEL ** -0.5),
        'post_norm': 1.0 + nrm(ks[20], (DEPTH, D_MODEL), 0.05),
    }


def reference(x_prompt, x_sample, cache_k_a, cache_v_a, state_ssm_b, state_conv_b, meta_tokens, rel_bias,
              pre_norm, w_in, lambda_q1, lambda_k1, lambda_q2, lambda_k2, subln_a, conv_b, a_log_b, dt_bias_b,
              norm_b, w_out, post_norm):
    B = x_prompt.shape[0]
    hp = jnp.concatenate([jnp.broadcast_to(meta_tokens[None].astype(x_prompt.dtype), (B, N_META, D_MODEL)),
                          x_prompt], axis=1)
    hs = x_sample
    kp, vp, sp, cp, ksm, vsm, ssm_s, csm = [], [], [], [], [], [], [], []
    for l in range(DEPTH):
        lp = (pre_norm[l], w_in[l], lambda_q1[l], lambda_k1[l], lambda_q2[l], lambda_k2[l], subln_a[l],
              conv_b[l], a_log_b[l], dt_bias_b[l], norm_b[l], w_out[l], post_norm[l])
        hp, (k_p, v_p, s_p, c_p) = prompt_layer(hp, l, rel_bias, *lp)
        hs, (k_s, v_s, s_s, c_s) = sample_layer(hs, cache_k_a[l], cache_v_a[l], state_ssm_b[l],
                                                state_conv_b[l], l, rel_bias, *lp)
        kp.append(k_p); vp.append(v_p); sp.append(s_p); cp.append(c_p)
        ksm.append(k_s); vsm.append(v_s); ssm_s.append(s_s); csm.append(c_s)
    return (hp[:, N_META:], hs, jnp.stack(kp), jnp.stack(vp), jnp.stack(sp), jnp.stack(cp),
            jnp.stack(ksm), jnp.stack(vsm), jnp.stack(ssm_s), jnp.stack(csm))
```

```cpp
#ifndef EMU
#include <hip/hip_runtime.h>
#endif
#include <cstdio>
#include <cstdint>

#define DI __device__ __forceinline__
#ifdef EMU
#define LAS
#define GAS
#define WAIT_V(n) emu::wave_op(emu::op_nop)
#define WAIT_L(n) emu::wave_op(emu::op_nop)
#define WAIT_VL0() emu::wave_op(emu::op_nop)
#define WAIT_V1(n) ((void)0)
#define CFENCE() ((void)0)
#define PINV(x) ((void)0)
#define OPAQUE(x) ((void)0)
#define PIN4(a, b, c, d) ((void)0)
#define PIN2(a, b) ((void)0)
#else
#define LAS __attribute__((address_space(3)))
#define GAS __attribute__((address_space(1)))
#define WAIT_V(n) asm volatile("s_waitcnt vmcnt(" #n ")" ::: "memory")
#define WAIT_L(n) asm volatile("s_waitcnt lgkmcnt(" #n ")" ::: "memory")
#define WAIT_VL0() asm volatile("s_waitcnt vmcnt(0) lgkmcnt(0)" ::: "memory")
#define WAIT_V1(n) asm volatile("s_waitcnt vmcnt(" #n ")" ::: "memory")
#define CFENCE() asm volatile("" ::: "memory")
#define OPAQUE(x) asm volatile("" : "+v"(x))
#define PIN4(a, b, c, d) asm volatile("" : "+v"(a), "+v"(b), "+v"(c), "+v"(d) :: "memory")
#define PIN2(a, b) asm volatile("" : "+v"(a), "+v"(b) :: "memory")
#define PINV(x) asm volatile("" : "+v"(x) :: "memory")
#endif
#define SBAR() __builtin_amdgcn_sched_barrier(0)

#if defined(MIDCFG)
constexpr int D_MODEL = 512, SEQ = 2048, DEC_BATCH = 2, PAST_LEN = 1024;
#elif defined(SMALLCFG)
constexpr int D_MODEL = 512, SEQ = 512, DEC_BATCH = 2, PAST_LEN = 128;
#else
constexpr int D_MODEL = 4096, SEQ = 16384, DEC_BATCH = 32, PAST_LEN = 1024;
#endif
constexpr int DEC_SEQ = 32, N_META = 16, CHUNK = 64;
constexpr int W_A = D_MODEL / 2, NH_A = W_A / 256, W_B = D_MODEL / 2, NH_B = W_B / 128, C3 = 3 * W_B;
constexpr int IN_COLS = 4 * W_A + 4 * W_B + 2 * NH_B;
constexpr int NS = DEC_BATCH * DEC_SEQ;
constexpr int ROW_S0 = SEQ, ROW_M0 = SEQ + NS, NROWS = ROW_M0 + N_META;
constexpr int R = (NROWS + 255) / 256 * 256;
constexpr int NP_IN = (IN_COLS + 255) / 256 * 256;
constexpr int LCACHE = N_META + PAST_LEN;
constexpr int TA = W_A / 256, TB = W_B / 256;
constexpr int NCH_P = SEQ / CHUNK + 1;
constexpr int NSC = NCH_P + DEC_BATCH;
constexpr float EPS = 1e-6f;
constexpr float LOG2E = 1.4426950408889634f;
constexpr float C2Q = 0.08838834764831845f * LOG2E;
constexpr float LAM_INIT = 0.2f;
constexpr size_t O_YP = 0, O_YS = O_YP + (size_t)SEQ * D_MODEL, O_KP = O_YS + (size_t)NS * D_MODEL, O_VP = O_KP + (size_t)(N_META + SEQ) * W_A,
                 O_SP = O_VP + (size_t)(N_META + SEQ) * W_A, O_CP = O_SP + (size_t)NH_B * 16384, O_KS = O_CP + (size_t)3 * C3, O_VS = O_KS + (size_t)NS * W_A,
                 O_SS = O_VS + (size_t)NS * W_A, O_CS = O_SS + (size_t)DEC_BATCH * NH_B * 16384, O_END = O_CS + (size_t)DEC_BATCH * 3 * C3;

typedef unsigned short bf16_t;
typedef short bf16x8 __attribute__((ext_vector_type(8)));
typedef short s16x4 __attribute__((ext_vector_type(4)));
typedef float f32x4 __attribute__((ext_vector_type(4)));
typedef float f32x2 __attribute__((ext_vector_type(2)));
typedef float f32x16 __attribute__((ext_vector_type(16)));
typedef unsigned u32x4 __attribute__((ext_vector_type(4)));
typedef unsigned u32x2 __attribute__((ext_vector_type(2)));

constexpr size_t al256(size_t x) { return (x + 255) / 256 * 256; }
constexpr size_t WS_CTL = 0, CTL_ZERO_BYTES = 1u << 20;
constexpr size_t SZ_WINT = (size_t)NP_IN * D_MODEL * 2, SZ_XN = (size_t)R * D_MODEL * 2, SZ_RA = (size_t)R * W_A * 2, SZ_QKVB = (size_t)R * C3 * 2;
constexpr int PKG_BYTES = 73728;
constexpr size_t SZ_PKG = (size_t)NSC * NH_B * PKG_BYTES;
constexpr size_t WS_WINT = al256(WS_CTL + CTL_ZERO_BYTES);
constexpr size_t WS_XN = WS_WINT + SZ_WINT;
constexpr size_t WS_QKVN = WS_WINT;
constexpr size_t WS_YCAT = WS_WINT;
constexpr size_t WS_WOUTT = al256(WS_XN + SZ_XN);
constexpr size_t WS_Q = al256(WS_WOUTT + (size_t)D_MODEL * D_MODEL * 2), WS_K = WS_Q + SZ_RA, WS_V = WS_K + SZ_RA, WS_GA = WS_V + SZ_RA, WS_GB = WS_GA + SZ_RA;
constexpr size_t WS_QKVB = al256(WS_GB + SZ_RA);
constexpr size_t WS_PKG = WS_QKVB, WS_Y = WS_QKVB;
constexpr size_t SZ_BIG = SZ_PKG > SZ_QKVB ? SZ_PKG : SZ_QKVB;
constexpr size_t WS_AB = al256(WS_QKVB + SZ_BIG);
constexpr size_t WS_BG = al256(WS_AB + (size_t)R * 32 * 4);
constexpr size_t WS_SS = al256(WS_BG + (size_t)R * NH_B * 8);
constexpr int NTB = 1280, TB_OFF = 1216;
constexpr size_t WS_TB = al256(WS_SS + (size_t)R * 64 * 4);
constexpr size_t WS_DEC = al256(WS_TB + (size_t)NH_A * NTB * 4);
constexpr size_t WS_END = al256(WS_DEC + (size_t)NSC * NH_B * 4);
static_assert(SZ_WINT + SZ_XN >= SZ_QKVB && SZ_WINT + SZ_XN >= SZ_XN, "overlay sizes");
static_assert((size_t)R * D_MODEL * 2 <= SZ_BIG, "Y fits the PKG region");

constexpr int CW_TMO = 0, CW_BAR = 4096, CW_QUEUE = 8192;
constexpr int RING_BYTES = 147456;
constexpr int MISC_OFF = RING_BYTES, LDS_BYTES = RING_BYTES + 512;

DI unsigned f2bf(float f) { unsigned u = __builtin_bit_cast(unsigned, f); return (u + 0x7fffu + ((u >> 16) & 1u)) >> 16; }
DI float bf2f(unsigned short b) { return __builtin_bit_cast(float, ((unsigned)b) << 16); }
#ifdef EMU
DI unsigned cvtpk(float lo, float hi) { return f2bf(lo) | (f2bf(hi) << 16); }
DI s16x4 tr16(const LAS void* p) { return emu_tr16((const void*)p); }
#else
typedef __bf16 bf16x2_t __attribute__((ext_vector_type(2)));
typedef short v4i16_t __attribute__((ext_vector_type(4)));
DI unsigned cvtpk(float lo, float hi) { f32x2 v = {lo, hi}; bf16x2_t b = __builtin_convertvector(v, bf16x2_t); return __builtin_bit_cast(unsigned, b); }
DI s16x4 tr16(const LAS void* p) { return __builtin_bit_cast(s16x4, __builtin_amdgcn_ds_read_tr16_b64_v4i16((LAS v4i16_t*)p)); }
#endif
DI int crow_c(int r, int h) { return (r & 3) + 8 * (r >> 2) + 4 * h; }
DI float lo_bf(unsigned w) { return __builtin_bit_cast(float, w << 16); }
DI float hi_bf(unsigned w) { return __builtin_bit_cast(float, w & 0xffff0000u); }
DI float fast_exp2(float x) { return __builtin_amdgcn_exp2f(x); }
DI float fast_rcp(float x) { return __builtin_amdgcn_rcpf(x); }
DI float silu_f(float x) { return x * fast_rcp(1.0f + fast_exp2(-x * LOG2E)); }
#ifdef EMU
DI int lane_id() { return emu::cur->lane; }
#else
DI int lane_id() { return (int)__builtin_amdgcn_mbcnt_hi(~0u, __builtin_amdgcn_mbcnt_lo(~0u, 0u)); }
#endif
#ifdef EMU
DI float shfl_xor_l(float v, int k, int lane) { (void)lane; return __shfl_xor(v, k); }
#else
DI float shfl_xor_l(float v, int k, int lane) { return __builtin_bit_cast(float, __builtin_amdgcn_ds_bpermute((lane ^ k) << 2, __builtin_bit_cast(int, v))); }
#endif
DI float wave_sum(float v) {
#pragma unroll
    for (int o = 1; o < 64; o <<= 1) v += __shfl_xor(v, o);
    return v;
}

#ifdef EMU
typedef const unsigned char* lds_a;
#define LDS_A(p) ((const unsigned char*)(p))
#define TRRD(dst, base, off) dst = tr16((base) + (off))
#define LDRD128(dst, base, off) dst = *(const bf16x8*)((base) + (off))
#define LWAIT8(a, b, c, d, e, f, g, h) WAIT_L(0)
#define LWAIT4(a, b, c, d) WAIT_L(0)
DI void glds16(const void* g, const unsigned char* l) { emu_glds16(g, (void*)l); }
template <class T> DI void asm_lwait2(T&, T&) { WAIT_L(0); }
#else
typedef unsigned lds_a;
#define LDS_A(p) ((unsigned)(size_t)(p))
#define TRRD(dst, base, off) asm volatile("ds_read_b64_tr_b16 %0, %1 offset:%2" : "=&v"(dst) : "v"(base), "i"(off) : "memory")
#define LDRD128(dst, base, off) asm volatile("ds_read_b128 %0, %1 offset:%2" : "=&v"(dst) : "v"(base), "i"(off) : "memory")
#define LWAIT8(a, b, c, d, e, f, g, h) do { asm volatile("s_waitcnt lgkmcnt(0)" : "+v"(a), "+v"(b), "+v"(c), "+v"(d), "+v"(e), "+v"(f), "+v"(g), "+v"(h) :: "memory"); SBAR(); } while (0)
#define LWAIT4(a, b, c, d) do { asm volatile("s_waitcnt lgkmcnt(0)" : "+v"(a), "+v"(b), "+v"(c), "+v"(d) :: "memory"); SBAR(); } while (0)
template <class T> DI void asm_lwait2(T& a, T& b) { asm volatile("s_waitcnt lgkmcnt(0)" : "+v"(a), "+v"(b) :: "memory"); SBAR(); }
DI void glds16(const void* gsrc, unsigned lds_dst) { unsigned keep;
    asm volatile("s_mov_b32 %0, m0\n\ts_mov_b32 m0, %2\n\ts_nop 0\n\tglobal_load_lds_dwordx4 %1, off\n\ts_mov_b32 m0, %0" : "=&s"(keep) : "v"(gsrc), "s"(lds_dst) : "memory"); }
#endif

#ifdef EMU
DI float max3f(float a, float b, float c) { return fmaxf(fmaxf(a, b), c); }
DI float max2f(float a, float b) { return fmaxf(a, b); }
DI float fadd_s(float a, float b) { return a + b; }
#define MFMA_PAD2(a, b) ((void)0)
#define VALU_PAD(x) ((void)0)
#define TRANS_PAD2(a, b) ((void)0)
#else
DI float max3f(float a, float b, float c) { float r; asm("v_max3_f32 %0, %1, %2, %3" : "=v"(r) : "v"(a), "v"(b), "v"(c)); return r; }
DI float max2f(float a, float b) { float r; asm("v_max_f32_e32 %0, %1, %2" : "=v"(r) : "v"(a), "v"(b)); return r; }
DI float fadd_s(float a, float b) { float r; asm("v_add_f32_e32 %0, %1, %2" : "=v"(r) : "v"(a), "v"(b)); return r; }
#define VALU_PAD(x) asm volatile("s_nop 1" : "+v"(x))
#define TRANS_PAD2(a, b) asm volatile("s_nop 3" : "+v"(a), "+v"(b))
#define MFMA_PAD2(a, b) asm volatile("s_nop 15\n\ts_nop 7" : "+v"(a), "+v"(b))
#endif
#define RLX_AGENT __ATOMIC_RELAXED, __HIP_MEMORY_SCOPE_AGENT

#define XB_TMO      128
#define XB_XCNT(j)  (256  + 64 * (j))
#define XB_XSUB(j)  (1280 + 64 * (j))
#define XB_XGEN(j)  (2304 + 64 * (j))
#define XB_TOP      3328
#define XB_TOPGEN   3392
#define XCD_BAR_WORDS 3456
#define XB_SPIN_CAP (1u << 18)
DI unsigned xb_ld(unsigned* p)              { return __hip_atomic_load(p, __ATOMIC_RELAXED, __HIP_MEMORY_SCOPE_AGENT); }
DI unsigned xb_add(unsigned* p, unsigned v) { return __hip_atomic_fetch_add(p, v, __ATOMIC_RELAXED, __HIP_MEMORY_SCOPE_AGENT); }
DI unsigned xb_xcc_id() { return (unsigned)__builtin_amdgcn_s_getreg((3 << 11) | 20) & 0xFu; }
#define XB_SPIN(cond, bar) do { unsigned _sp = 0; while (cond) { __builtin_amdgcn_s_sleep(1); \
    if ((++_sp & 255u) == 0u) { if (xb_ld(&(bar)[XB_TMO])) break; if (_sp > XB_SPIN_CAP) { atomicAdd(&(bar)[XB_TMO], 1u); break; } } } } while (0)
struct XcdBarrier { unsigned* bar; unsigned x; volatile LAS unsigned* st; int wave; };
DI XcdBarrier xcd_barrier_post(unsigned* bar, volatile LAS unsigned* st, int wave) {
    XcdBarrier b; b.bar = bar; b.x = xb_xcc_id(); b.st = st; b.wave = wave;
    if (wave == 0 && lane_id() == 0) (void)xb_add(&bar[XB_XCNT(b.x)], 1u);
    return b;
}
DI void xcd_barrier_complete(unsigned* bar, unsigned x, unsigned& nloc, unsigned& nx) {
    const unsigned G = gridDim.x * gridDim.y * gridDim.z;
    unsigned sum, cnt, mine, sp = 0u;
    for (;;) {
        sum = 0u; cnt = 0u; mine = 0u;
#pragma unroll
        for (unsigned j = 0; j < 16; ++j) { const unsigned c = xb_ld(&bar[XB_XCNT(j)]); sum += c; cnt += (c > 0u) ? 1u : 0u; mine = (j == x) ? c : mine; }
        if (sum == G) break;
        __builtin_amdgcn_s_sleep(1);
        if ((++sp & 255u) == 0u) { if (xb_ld(&bar[XB_TMO])) break; if (sp > XB_SPIN_CAP) { atomicAdd(&bar[XB_TMO], 1u); break; } }
    }
    nloc = mine > 0u ? mine : 1u; nx = cnt > 0u ? cnt : 1u;
}
DI void xcd_barrier(const XcdBarrier& b) {
    WAIT_V(0);
    __syncthreads();
    if (b.wave == 0 && lane_id() == 0) {
        unsigned* bar = b.bar;
        __builtin_amdgcn_s_waitcnt(0);
        unsigned nloc = b.st[0], nx = b.st[1];
        if (nloc == 0u) { xcd_barrier_complete(bar, b.x, nloc, nx); b.st[0] = nloc; b.st[1] = nx; }
        const unsigned old = xb_add(&bar[XB_XSUB(b.x)], 1u);
        const unsigned gen = old / nloc;
        if (old + 1u == (gen + 1u) * nloc) {
            __builtin_amdgcn_fence(__ATOMIC_RELEASE, "agent");
            WAIT_V1(0);
            const unsigned og = xb_add(&bar[XB_TOP], 1u);
            const unsigned tg = og / nx;
            if (og + 1u == (tg + 1u) * nx) xb_add(&bar[XB_TOPGEN], 1u);
            else XB_SPIN(xb_ld(&bar[XB_TOPGEN]) == tg, bar);
            __builtin_amdgcn_fence(__ATOMIC_ACQUIRE, "agent");
            xb_add(&bar[XB_XGEN(b.x)], 1u);
            WAIT_V1(0);
        } else {
            XB_SPIN(xb_ld(&bar[XB_XGEN(b.x)]) == gen, bar);
            __builtin_amdgcn_fence(__ATOMIC_ACQUIRE, "agent");
            WAIT_V1(0);
        }
    }
    __syncthreads();
}

namespace pg8 {
constexpr int BM = 256, BK = 64, HALF = 128, HTB = HALF * BK * 2, STAGE_BYTES = 8 * HTB, NXCD = 8, WGM = 8;
DI int lds_byte(int r, int c) { const int st = (r >> 4) * 2 + (c >> 5), rr = r & 15, cc = c & 31, ob = rr * 64 + cc * 2; return st * 1024 + (ob ^ (((ob >> 9) & 1) << 5)); }
DI void stage_rc(int b, int& R_, int& C_) { const int st = b / 1024, sb = b % 1024, swz = sb ^ (((sb >> 9) & 1) << 5); R_ = (st >> 1) * 16 + swz / 64; C_ = (st & 1) * 32 + (swz % 64) / 2; }
DI int perm32(int rho) { const int n = rho >> 4, i = rho & 15; return 8 * (i >> 2) + 4 * n + (i & 3); }
struct Unit { int pm, pn; };
struct Gemm { const bf16_t* A; const bf16_t* Bt; int M, N, K; };
struct StaticOrder {
    int nM, nN, nwg, G, c;
    DI void init(int M, int N, int G_, int c_) { nM = M / BM; nN = N / BM; nwg = nM * nN; G = G_; c = c_; }
    DI bool next(int i, Unit& u) const {
        const long L = (long)i * G + c; if (L >= nwg) return false;
        int wgid = (int)L; { const int q = nwg / NXCD, r = nwg % NXCD, xcd = wgid % NXCD, off = wgid / NXCD; wgid = (xcd < r ? xcd * (q + 1) : r * (q + 1) + (xcd - r) * q) + off; }
        const int nig = WGM * nN, gid = wgid / nig, fm = gid * WGM, gsz = (nM - fm) < WGM ? (nM - fm) : WGM;
        u.pm = fm + ((wgid % nig) % gsz); u.pn = (wgid % nig) / gsz; return true;
    }
    DI void a_ready(const Unit&) const {}
    DI void done(const Unit&) const {}
};
struct AlignedOrder {
    StaticOrder so; bool al;
    DI void init(int M, int N, int G_, int c_) { so.init(M, N, G_, c_); al = (G_ == 256 && so.nM == 68 && so.nN == 64); }
    DI bool next(int i, Unit& u) const {
        if (!al) return so.next(i, u);
        if (i > 16) return false;
        const int xcd = so.c & 7, slot = so.c >> 3;
        if (i < 16) { u.pm = 8 * xcd + (slot & 7); u.pn = 4 * i + (slot >> 3); } else { u.pm = 64 + (slot & 3); u.pn = 8 * xcd + (slot >> 2); }
        return true;
    }
    DI void a_ready(const Unit&) const {}
    DI void done(const Unit&) const {}
};
template <class Epi, class Sched, bool ALIGN_EPI = false, bool SP2 = false>
DI void gemm_phase(LAS unsigned char* lds, const Gemm g, const Sched& S, const Epi& E, int wid) {
    const int lane = lane_id(), tid = wid * 64 + lane, wr = wid >> 2, wc = wid & 3, fr = lane & 15, fq = lane >> 4;
    const int K = g.K, nt = K / BK;
    unsigned voffA[2], voffB[2];
#pragma unroll
    for (int i = 0; i < 2; ++i) { int R_, C_; stage_rc(tid * 16 + i * 8192, R_, C_); const int Rb = Epi::PERM ? ((R_ & ~31) + perm32(R_ & 31)) : R_;
        voffA[i] = (unsigned)(R_ * K + C_) * 2u; voffB[i] = (unsigned)(Rb * K + C_) * 2u; }
    const size_t kstep = (size_t)(BK * 2);
    const size_t hstep = (size_t)HALF * K * 2;
    const size_t tstep = 2 * hstep;
    const unsigned ldsw = (unsigned)wid * 1024u;
    const int aoff = lds_byte(wr * 64 + fr, fq * 8), boff = lds_byte(wc * 32 + fr, fq * 8);
#define PG8_SA(b, h) (((b) * 2 + (h)) * HTB)
#define PG8_SB(b, h) ((4 + (b) * 2 + (h)) * HTB)
#define PG8_STAGE(bufoff, gbase, voff) do { _Pragma("unroll") for (int _i = 0; _i < 2; ++_i) \
        __builtin_amdgcn_global_load_lds((const unsigned*)((const char*)(gbase) + (voff)[_i]), (LAS unsigned*)(lds + (bufoff) + ldsw + _i * 8192), 16, 0, 0); } while (0)
#define PG8_LDA(dst, b, h) do { _Pragma("unroll") for (int m = 0; m < 4; ++m) _Pragma("unroll") for (int k = 0; k < 2; ++k) dst[m][k] = *(const LAS bf16x8*)(lds + PG8_SA(b, h) + aoff + m * 2048 + k * 1024); } while (0)
#define PG8_LDB(dst, b, h) do { _Pragma("unroll") for (int n = 0; n < 2; ++n) _Pragma("unroll") for (int k = 0; k < 2; ++k) dst[n][k] = *(const LAS bf16x8*)(lds + PG8_SB(b, h) + boff + n * 2048 + k * 1024); } while (0)
#define PG8_MMA(ai, bj, At, Bt) do { __builtin_amdgcn_s_setprio(1); _Pragma("unroll") for (int m = 0; m < 4; ++m) _Pragma("unroll") for (int n = 0; n < 2; ++n) _Pragma("unroll") for (int k = 0; k < 2; ++k) \
        acc[ai][bj][m][n] = __builtin_amdgcn_mfma_f32_16x16x32_bf16(Bt[n][k], At[m][k], acc[ai][bj][m][n], 0, 0, 0); __builtin_amdgcn_s_setprio(0); } while (0)
#define PG8_WAIT_V(n) WAIT_V(n)
#define PG8_WAIT_L(n) WAIT_L(n)
#define PG8_BAR __builtin_amdgcn_s_barrier()
#define PG8_SCHED __builtin_amdgcn_sched_barrier(0)
    Unit cur, nxt; int ui = 0;
    if (!S.next(0, cur)) return;
    f32x4 acc[2][2][4][2];
#pragma unroll
    for (int a = 0; a < 2; ++a)
#pragma unroll
        for (int b = 0; b < 2; ++b)
#pragma unroll
            for (int m = 0; m < 4; ++m)
#pragma unroll
                for (int n = 0; n < 2; ++n) acc[a][b][m][n] = (f32x4){0.f, 0.f, 0.f, 0.f};
    bf16x8 At[4][2], B0[2][2], B1[2][2];
    const char* cA = (const char*)g.A + (size_t)cur.pm * tstep; const char* cB = (const char*)g.Bt + (size_t)cur.pn * tstep;
    S.a_ready(cur);
    if constexpr (SP2) {
        PG8_STAGE(PG8_SB(0, 0), cB, voffB); PG8_STAGE(PG8_SB(0, 1), cB + hstep, voffB); PG8_STAGE(PG8_SA(0, 0), cA, voffA); PG8_STAGE(PG8_SA(0, 1), cA + hstep, voffA);
        if (wr == 1) PG8_BAR;
        PG8_WAIT_V(2); PG8_BAR;
        PG8_STAGE(PG8_SB(1, 0), cB + kstep, voffB); PG8_STAGE(PG8_SA(1, 0), cA + kstep, voffA); PG8_STAGE(PG8_SB(1, 1), cB + hstep + kstep, voffB);
        PG8_WAIT_V(6); PG8_BAR;
    } else {
        PG8_STAGE(PG8_SB(0, 0), cB, voffB); PG8_STAGE(PG8_SA(0, 0), cA, voffA); PG8_STAGE(PG8_SB(0, 1), cB + hstep, voffB); PG8_STAGE(PG8_SA(0, 1), cA + hstep, voffA);
        if (wr == 1) PG8_BAR;
        PG8_WAIT_V(4); PG8_BAR;
        PG8_STAGE(PG8_SB(1, 0), cB + kstep, voffB); PG8_STAGE(PG8_SA(1, 0), cA + kstep, voffA); PG8_STAGE(PG8_SB(1, 1), cB + hstep + kstep, voffB);
        PG8_WAIT_V(6); PG8_BAR;
    }
    for (;;) {
        const bool has_next = S.next(ui + 1, nxt);
        const char* nA = has_next ? (const char*)g.A + (size_t)nxt.pm * tstep : cA; const char* nB = has_next ? (const char*)g.Bt + (size_t)nxt.pn * tstep : cB;
        for (int t = 0; t < nt; t += 2) {
            const bool last = (t == nt - 2);
            const char* a1 = cA + (size_t)(t + 1) * kstep;
            const char* a2 = last ? nA : cA + (size_t)(t + 2) * kstep; const char* b2 = last ? nB : cB + (size_t)(t + 2) * kstep;
            const char* a3 = a2 + kstep; const char* b3 = b2 + kstep;
            if (last && has_next) S.a_ready(nxt);
            if constexpr (SP2) {
            PG8_LDB(B0, 0, 0); PG8_LDB(B1, 0, 1); PG8_SCHED; PG8_LDA(At, 0, 0); PG8_STAGE(PG8_SA(1, 1), a1 + hstep, voffA);
            PG8_WAIT_V(8); PG8_WAIT_L(0); PG8_BAR; PG8_MMA(0, 0, At, B0); PG8_MMA(0, 1, At, B1); PG8_BAR; PG8_SCHED;
            PG8_LDA(At, 0, 1); PG8_STAGE(PG8_SB(0, 0), b2, voffB); PG8_STAGE(PG8_SB(0, 1), b2 + hstep, voffB); PG8_STAGE(PG8_SA(0, 0), a2, voffA);
            PG8_WAIT_V(8); PG8_WAIT_L(0); PG8_BAR; PG8_MMA(1, 0, At, B0); PG8_MMA(1, 1, At, B1); PG8_BAR; PG8_SCHED;
            PG8_LDB(B0, 1, 0); PG8_LDB(B1, 1, 1); PG8_SCHED; PG8_LDA(At, 1, 0); PG8_STAGE(PG8_SA(0, 1), a2 + hstep, voffA);
            PG8_WAIT_V(8); PG8_WAIT_L(0); PG8_BAR; PG8_MMA(0, 0, At, B0); PG8_MMA(0, 1, At, B1); PG8_BAR; PG8_SCHED;
            PG8_LDA(At, 1, 1); PG8_STAGE(PG8_SB(1, 0), b3, voffB); PG8_STAGE(PG8_SB(1, 1), b3 + hstep, voffB); PG8_STAGE(PG8_SA(1, 0), a3, voffA);
            PG8_WAIT_V(8); PG8_WAIT_L(0); PG8_BAR; PG8_MMA(1, 0, At, B0); PG8_MMA(1, 1, At, B1); PG8_BAR; PG8_SCHED;
            } else {
            PG8_LDB(B0, 0, 0); PG8_SCHED; PG8_LDA(At, 0, 0); PG8_STAGE(PG8_SA(1, 1), a1 + hstep, voffA);
            PG8_WAIT_L(8); PG8_BAR; PG8_WAIT_L(0); PG8_MMA(0, 0, At, B0); PG8_BAR; PG8_SCHED;
            PG8_LDB(B1, 0, 1); PG8_STAGE(PG8_SB(0, 0), b2, voffB);
            PG8_BAR; PG8_WAIT_L(0); PG8_MMA(0, 1, At, B1); PG8_BAR;
            PG8_LDA(At, 0, 1); PG8_STAGE(PG8_SA(0, 0), a2, voffA);
            PG8_BAR; PG8_WAIT_L(0); PG8_MMA(1, 0, At, B0); PG8_BAR; PG8_SCHED;
            PG8_STAGE(PG8_SB(0, 1), b2 + hstep, voffB);
            PG8_WAIT_V(6); PG8_BAR; PG8_MMA(1, 1, At, B1); PG8_BAR;
            PG8_LDB(B0, 1, 0); PG8_SCHED; PG8_LDA(At, 1, 0); PG8_STAGE(PG8_SA(0, 1), a2 + hstep, voffA);
            PG8_WAIT_L(8); PG8_BAR; PG8_WAIT_L(0); PG8_MMA(0, 0, At, B0); PG8_BAR; PG8_SCHED;
            PG8_LDB(B1, 1, 1); PG8_STAGE(PG8_SB(1, 0), b3, voffB);
            PG8_BAR; PG8_WAIT_L(0); PG8_MMA(0, 1, At, B1); PG8_BAR;
            PG8_LDA(At, 1, 1); PG8_STAGE(PG8_SA(1, 0), a3, voffA);
            PG8_BAR; PG8_WAIT_L(0); PG8_MMA(1, 0, At, B0); PG8_BAR; PG8_SCHED;
            PG8_STAGE(PG8_SB(1, 1), b3 + hstep, voffB);
            PG8_WAIT_V(6); PG8_BAR; PG8_MMA(1, 1, At, B1); PG8_BAR;
            }
        }
        if constexpr (ALIGN_EPI) { if (wr == 0) PG8_BAR; }
        E(acc, cur, wr, wc, fr, fq); S.done(cur);
        if (!has_next) break;
#pragma unroll
        for (int a = 0; a < 2; ++a)
#pragma unroll
            for (int b = 0; b < 2; ++b)
#pragma unroll
                for (int m = 0; m < 4; ++m)
#pragma unroll
                    for (int n = 0; n < 2; ++n) acc[a][b][m][n] = (f32x4){0.f, 0.f, 0.f, 0.f};
        cur = nxt; cA = nA; cB = nB; ++ui;
        if constexpr (ALIGN_EPI) { if (wr == 1) PG8_BAR; }
    }
    PG8_WAIT_V(0);
    if constexpr (!ALIGN_EPI) { if (wr == 0) PG8_BAR; }
    PG8_BAR;
#undef PG8_SA
#undef PG8_SB
#undef PG8_STAGE
#undef PG8_LDA
#undef PG8_LDB
#undef PG8_MMA
#undef PG8_WAIT_V
#undef PG8_WAIT_L
#undef PG8_BAR
#undef PG8_SCHED
}
}
#ifndef PG8_SP2
#define PG8_SP2 true
#endif
#ifndef PG8_ALIGN
#define PG8_ALIGN true
#endif

struct Params {
    const float* in[21]; float* out; unsigned char* ws; int ph_lo, ph_hi, li, pad;
};
struct Frame {
    LAS unsigned char* lds; volatile LAS unsigned* MISC; unsigned* ctl;
    int tid, lane, wave, vcu, G;
    const Params* P; float* out; unsigned char* ws;
};
enum { IN_XP = 0, IN_XS, IN_CK, IN_CV, IN_SSM, IN_CONVS, IN_META, IN_RELB, IN_PREN, IN_WIN, IN_LQ1, IN_LK1, IN_LQ2, IN_LK2, IN_SUBLN, IN_CONVW, IN_ALOG, IN_DTB, IN_NORMB, IN_WOUT, IN_POSTN };

DI const float* src_row(const Frame& F, int r) {
    if (r < ROW_S0) return F.P->in[IN_XP] + (size_t)r * D_MODEL;
    if (r < ROW_M0) return F.P->in[IN_XS] + (size_t)(r - ROW_S0) * D_MODEL;
    if (r < NROWS) return F.P->in[IN_META] + (size_t)(r - ROW_M0) * D_MODEL;
    return nullptr;
}

DI void p0_transpose_item(const float* W, int K, int N, bf16_t* WT, LAS float* scr, int item, int nblk, int lane) {
    const int kb = item / nblk, nb = item % nblk, k0 = 64 * kb, n0 = 64 * nb;
    const int c4 = (lane & 15) * 4, r0 = lane >> 4;
    f32x4 v[16];
#pragma unroll
    for (int i = 0; i < 16; ++i) { const int kk = 4 * i + r0; v[i] = (n0 + c4 < N) ? *(const f32x4*)(W + (size_t)(k0 + kk) * N + n0 + c4) : (f32x4){0.f, 0.f, 0.f, 0.f}; }
#pragma unroll
    for (int i = 0; i < 16; ++i) { const int kk = 4 * i + r0; LAS float* d = scr + kk * 65 + c4; d[0] = v[i][0]; d[1] = v[i][1]; d[2] = v[i][2]; d[3] = v[i][3]; }
    WAIT_L(0); CFENCE();
    const int c = lane & 7;
#pragma unroll
    for (int j = 0; j < 8; ++j) { const int n = (lane >> 3) + 8 * j; const LAS float* sp = scr + (8 * c) * 65 + n;
        u32x4 o; o.x = cvtpk(sp[0 * 65], sp[1 * 65]); o.y = cvtpk(sp[2 * 65], sp[3 * 65]); o.z = cvtpk(sp[4 * 65], sp[5 * 65]); o.w = cvtpk(sp[6 * 65], sp[7 * 65]);
        *(u32x4*)(WT + (size_t)(n0 + n) * K + k0 + 8 * c) = o; }
    WAIT_L(0); CFENCE();
}
DI int rel_bucket_dev(int rel) {
    const int n = rel < 0 ? -rel : rel;
    int b = n < 8 ? n : 8 + (n >= 15) + (n >= 27) + (n >= 50) + (n >= 91) + (n >= 166) + (n >= 305) + (n >= 559);
    return (rel > 0 ? 16 : 0) + b;
}
DI void p0_prologue(Frame& F) {
    LAS float* scr = (LAS float*)(F.lds + F.wave * 16896);
    const int gw = F.vcu * 8 + F.wave, NGW = F.G * 8;
    bf16_t* WinT = (bf16_t*)(F.ws + WS_WINT); bf16_t* WoutT = (bf16_t*)(F.ws + WS_WOUTT); bf16_t* XN = (bf16_t*)(F.ws + WS_XN);
    constexpr int NB_IN = NP_IN / 64, I_IN = (D_MODEL / 64) * NB_IN, NB_O = D_MODEL / 64, I_O = (D_MODEL / 64) * NB_O;
    for (int it = gw; it < I_IN + I_O; it += NGW) {
        if (it < I_IN) p0_transpose_item(F.P->in[IN_WIN], D_MODEL, IN_COLS, WinT, scr, it, NB_IN, F.lane);
        else p0_transpose_item(F.P->in[IN_WOUT], D_MODEL, D_MODEL, WoutT, scr, it - I_IN, NB_O, F.lane);
    }
    constexpr int NJ = D_MODEL / 256;
    for (int r = gw; r < R; r += NGW) {
        const float* xr = src_row(F, r);
        unsigned long long* o8 = (unsigned long long*)(XN + (size_t)r * D_MODEL) + F.lane;
        if (!xr) {
#pragma unroll
            for (int j = 0; j < NJ; ++j) o8[64 * j] = 0ull;
            continue; }
        f32x4 v[NJ]; float s = 0.f;
#pragma unroll
        for (int j = 0; j < NJ; ++j) { v[j] = ((const f32x4*)xr)[F.lane + 64 * j]; s += (v[j].x * v[j].x + v[j].y * v[j].y) + (v[j].z * v[j].z + v[j].w * v[j].w); }
        const float rs = 1.0f / sqrtf(wave_sum(s) * (1.f / D_MODEL) + EPS);
#pragma unroll
        for (int j = 0; j < NJ; ++j) { const f32x4 w = ((const f32x4*)F.P->in[IN_PREN])[F.lane + 64 * j];
            o8[64 * j] = (unsigned long long)cvtpk(v[j].x * rs * w.x, v[j].y * rs * w.y) | ((unsigned long long)cvtpk(v[j].z * rs * w.z, v[j].w * rs * w.w) << 32); }
    }
    float* TBL = (float*)(F.ws + WS_TB);
    for (int i = F.vcu * 512 + F.tid; i < NH_A * NTB; i += F.G * 512) { const int h = i / NTB, idx = i % NTB; TBL[i] = F.P->in[IN_RELB][rel_bucket_dev(idx - TB_OFF) * NH_A + h] * LOG2E; }
}

struct EpiIn {
    static constexpr bool PERM = true;
    float* out; unsigned char* ws;
    DI void operator()(const f32x4 (&acc)[2][2][4][2], const pg8::Unit& u, int wr, int wc, int fr, int fq) const {
        const int pn = u.pn; const int row0 = u.pm * 256 + wr * 64 + fr;
        int seg, colt;
        if (pn < 4 * TA) { seg = pn / TA; colt = (pn - seg * TA) * 256; }
        else if (pn < 4 * TA + 3 * TB) { seg = 4; colt = (pn - 4 * TA) * 256; }
        else if (pn < 4 * TA + 4 * TB) { seg = 5; colt = (pn - 4 * TA - 3 * TB) * 256; }
        else { seg = 6; colt = 0; }
        const int col0 = colt + wc * 32 + 8 * fq;
#pragma unroll
        for (int ai = 0; ai < 2; ++ai)
#pragma unroll
            for (int m = 0; m < 4; ++m) {
                const int r = row0 + ai * 128 + m * 16;
#pragma unroll
                for (int bj = 0; bj < 2; ++bj) {
                    const f32x4 v0 = acc[ai][bj][m][0], v1 = acc[ai][bj][m][1]; const int col = col0 + bj * 128;
                    if (seg == 0) { u32x4 w; w.x = cvtpk(v0[0] * C2Q, v0[1] * C2Q); w.y = cvtpk(v0[2] * C2Q, v0[3] * C2Q); w.z = cvtpk(v1[0] * C2Q, v1[1] * C2Q); w.w = cvtpk(v1[2] * C2Q, v1[3] * C2Q);
                        *(u32x4*)((bf16_t*)(ws + WS_Q) + (size_t)r * W_A + col) = w; }
                    else if (seg == 1 || seg == 2) {
                        u32x4 w; w.x = cvtpk(v0[0], v0[1]); w.y = cvtpk(v0[2], v0[3]); w.z = cvtpk(v1[0], v1[1]); w.w = cvtpk(v1[2], v1[3]);
                        *(u32x4*)((bf16_t*)(ws + (seg == 1 ? WS_K : WS_V)) + (size_t)r * W_A + col) = w;
                        float* o = nullptr;
                        if (r < ROW_S0) o = out + (seg == 1 ? O_KP : O_VP) + (size_t)(N_META + r) * W_A;
                        else if (r < ROW_M0) o = out + (seg == 1 ? O_KS : O_VS) + (size_t)(r - ROW_S0) * W_A;
                        else if (r < NROWS) o = out + (seg == 1 ? O_KP : O_VP) + (size_t)(r - ROW_M0) * W_A;
                        if (o) { *(f32x4*)(o + col) = v0; *(f32x4*)(o + col + 4) = v1; } }
                    else if (seg == 3 || seg == 5) {
                        u32x4 w; w.x = cvtpk(silu_f(v0[0]), silu_f(v0[1])); w.y = cvtpk(silu_f(v0[2]), silu_f(v0[3])); w.z = cvtpk(silu_f(v1[0]), silu_f(v1[1])); w.w = cvtpk(silu_f(v1[2]), silu_f(v1[3]));
                        *(u32x4*)((bf16_t*)(ws + (seg == 3 ? WS_GA : WS_GB)) + (size_t)r * W_A + col) = w; }
                    else if (seg == 4) {
                        u32x4 w; w.x = cvtpk(v0[0], v0[1]); w.y = cvtpk(v0[2], v0[3]); w.z = cvtpk(v1[0], v1[1]); w.w = cvtpk(v1[2], v1[3]);
                        *(u32x4*)((bf16_t*)(ws + WS_QKVB) + (size_t)r * C3 + col) = w;
                        float* o = nullptr;
                        if (r >= SEQ - 3 && r < SEQ) o = out + O_CP + (size_t)(r - (SEQ - 3)) * C3;
                        else if (r >= ROW_S0 && r < ROW_M0 && ((r - ROW_S0) & 31) >= 29) o = out + O_CS + (size_t)(((r - ROW_S0) >> 5) * 3 + (((r - ROW_S0) & 31) - 29)) * C3;
                        if (o) { *(f32x4*)(o + col) = v0; *(f32x4*)(o + col + 4) = v1; } }
                    else { if (col < 32) { float* o = (float*)(ws + WS_AB) + (size_t)r * 32 + col; *(f32x4*)o = v0; *(f32x4*)(o + 4) = v1; } }
                }
            }
    }
};

struct EpiOut {
    static constexpr bool PERM = true;
    unsigned char* ws;
    DI void operator()(const f32x4 (&acc)[2][2][4][2], const pg8::Unit& u, int wr, int wc, int fr, int fq) const {
        const int row0 = u.pm * 256 + wr * 64 + fr, col0 = u.pn * 256 + wc * 32 + 8 * fq;
        bf16_t* Y = (bf16_t*)(ws + WS_Y); float* SSp = (float*)(ws + WS_SS);
#pragma unroll
        for (int ai = 0; ai < 2; ++ai)
#pragma unroll
            for (int m = 0; m < 4; ++m) {
                const int r = row0 + ai * 128 + m * 16; float s = 0.f;
#pragma unroll
                for (int bj = 0; bj < 2; ++bj) { const f32x4 v0 = acc[ai][bj][m][0], v1 = acc[ai][bj][m][1];
                    s += (v0[0] * v0[0] + v0[1] * v0[1]) + (v0[2] * v0[2] + v0[3] * v0[3]) + (v1[0] * v1[0] + v1[1] * v1[1]) + (v1[2] * v1[2] + v1[3] * v1[3]);
                    u32x4 w; w.x = cvtpk(v0[0], v0[1]); w.y = cvtpk(v0[2], v0[3]); w.z = cvtpk(v1[0], v1[1]); w.w = cvtpk(v1[2], v1[3]);
                    *(u32x4*)(Y + (size_t)r * D_MODEL + col0 + bj * 128) = w; }
                s += __shfl_xor(s, 16); s += __shfl_xor(s, 32);
                if (fq == 0) SSp[(size_t)r * 64 + u.pn * 4 + wc] = s;
            }
    }
};
static_assert(D_MODEL / 256 * 4 <= 64, "SS slots");

constexpr int M_MAIN = (ROW_M0 + 255) / 256 * 256, N_MAIN = 4 * W_A + 4 * W_B;
constexpr int SK_AB_TILES = (NROWS + 31) / 32, SK_META_TILES = (2 * W_A + 3 * W_B) / 32;
#define SK_LOAD(A_, B_, KB_) do { const int kk_ = 64 * ((KB_) < kbe ? (KB_) : kbe - 1); _Pragma("unroll") for (int q = 0; q < 4; ++q) { A_[q] = *(const bf16x8*)(ap + kk_ + 8 * q); B_[q] = *(const bf16x8*)(bp + kk_ + 8 * q); } } while (0)
#define SK_MMA(A_, B_) do { _Pragma("unroll") for (int q = 0; q < 4; ++q) acc = __builtin_amdgcn_mfma_f32_32x32x16_bf16(A_[q], B_[q], acc, 0, 0, 0); } while (0)
DI f32x16 skinny_tile(const bf16_t* Arows, const bf16_t* Brows, int lane, int kb0, int nkb) {
    const int r = lane & 31, h = lane >> 5, kbe = kb0 + nkb;
    const bf16_t* ap = Arows + (size_t)r * D_MODEL + 32 * h; const bf16_t* bp = Brows + (size_t)r * D_MODEL + 32 * h;
    f32x16 acc = {};
    bf16x8 A0[4], B0[4], A1[4], B1[4], A2[4], B2[4], A3[4], B3[4];
    SK_LOAD(A0, B0, kb0); SK_LOAD(A1, B1, kb0 + 1); SK_LOAD(A2, B2, kb0 + 2);
    for (int kb = kb0; kb < kbe; kb += 4) {
        SK_LOAD(A3, B3, kb + 3); SBAR(); SK_MMA(A0, B0); SBAR();
        SK_LOAD(A0, B0, kb + 4); SBAR(); SK_MMA(A1, B1); SBAR();
        SK_LOAD(A1, B1, kb + 5); SBAR(); SK_MMA(A2, B2); SBAR();
        SK_LOAD(A2, B2, kb + 6); SBAR(); SK_MMA(A3, B3); SBAR();
    }
    return acc;
}
static_assert((D_MODEL / 64 / 2) % 4 == 0, "skinny K halves are whole prefetch rings");
DI void p1a_skinny(Frame& F) {
    const int lane = F.lane, j = lane & 31, h = lane >> 5, ws4 = F.wave & 3, kh = F.wave >> 2;
    const bf16_t* XN = (const bf16_t*)(F.ws + WS_XN); const bf16_t* WinT = (const bf16_t*)(F.ws + WS_WINT);
    constexpr int NT = SK_AB_TILES + SK_META_TILES, NKH = D_MODEL / 64 / 2;
    float* xch = (float*)(F.lds) + (size_t)ws4 * 64 * 17;
    const int nit = (NT + F.G * 4 - 1) / (F.G * 4);
    for (int n = 0; n < nit; ++n) {
        const int it = F.vcu + F.G * (ws4 + 4 * n);
        const bool valid = it < NT, isab = it < SK_AB_TILES;
        int seg = 0, colp = 0; const bf16_t* Ar = WinT + (size_t)N_MAIN * D_MODEL; const bf16_t* Br = XN;
        if (valid) {
            if (isab) Br = XN + (size_t)(32 * it) * D_MODEL;
            else {
                const int ct = it - SK_AB_TILES;
                if (ct < W_A / 32) { seg = 0; colp = 32 * ct; } else if (ct < 2 * W_A / 32) { seg = 1; colp = 32 * ct - W_A; } else { seg = 2; colp = 32 * ct - 2 * W_A; }
                const int gcol = seg == 0 ? W_A + colp : (seg == 1 ? 2 * W_A + colp : 4 * W_A + colp);
                Ar = XN + (size_t)ROW_M0 * D_MODEL; Br = WinT + (size_t)gcol * D_MODEL;
            }
        }
        f32x16 acc = {};
        if (valid) acc = skinny_tile(Ar, Br, lane, kh * NKH, NKH);
        if (kh == 1) {
#pragma unroll
            for (int q = 0; q < 16; ++q) xch[lane * 17 + q] = acc[q]; }
        __syncthreads();
        if (kh == 0 && valid) {
#pragma unroll
            for (int q = 0; q < 16; ++q) acc[q] += xch[lane * 17 + q];
            if (isab) {
                float* o = (float*)(F.ws + WS_AB) + (size_t)(32 * it + j) * 32 + 4 * h;
#pragma unroll
                for (int q = 0; q < 4; ++q) *(f32x4*)(o + 8 * q) = (f32x4){acc[4 * q], acc[4 * q + 1], acc[4 * q + 2], acc[4 * q + 3]};
            } else {
#pragma unroll
                for (int r = 0; r < 8; ++r) { const int tok = crow_c(r, h); const float v = acc[r];
                    if (seg == 2) ((bf16_t*)(F.ws + WS_QKVB))[(size_t)(ROW_M0 + tok) * C3 + colp + j] = (bf16_t)f2bf(v);
                    else { ((bf16_t*)(F.ws + (seg == 0 ? WS_K : WS_V)))[(size_t)(ROW_M0 + tok) * W_A + colp + j] = (bf16_t)f2bf(v);
                           F.out[(seg == 0 ? O_KP : O_VP) + (size_t)tok * W_A + colp + j] = v; } }
            }
        }
        __syncthreads();
    }
}
DI int dummy_unused() { return 0; }

DI void p5_final(Frame& F) {
    const int gw = F.vcu * 8 + F.wave, NGW = F.G * 8;
    const bf16_t* Y = (const bf16_t*)(F.ws + WS_Y); const float* SSp = (const float*)(F.ws + WS_SS);
    constexpr int NJ = D_MODEL / 512, NSL = D_MODEL / 256 * 4;
    for (int r = gw; r < ROW_M0; r += NGW) {
        float s = F.lane < NSL ? SSp[(size_t)r * 64 + F.lane] : 0.f; s = wave_sum(s);
        const float rs = 1.0f / sqrtf(s * (1.f / D_MODEL) + EPS);
        const float* h = src_row(F, r); float* o = r < ROW_S0 ? F.out + O_YP + (size_t)r * D_MODEL : F.out + O_YS + (size_t)(r - ROW_S0) * D_MODEL;
#pragma unroll
        for (int j = 0; j < NJ; ++j) { const int c = (F.lane + 64 * j) * 8;
            const u32x4 yv = *(const u32x4*)(Y + (size_t)r * D_MODEL + c);
            const f32x4 h0 = *(const f32x4*)(h + c), h1 = *(const f32x4*)(h + c + 4), w0 = *(const f32x4*)(F.P->in[IN_POSTN] + c), w1 = *(const f32x4*)(F.P->in[IN_POSTN] + c + 4);
            f32x4 o0, o1; o0[0] = h0[0] + lo_bf(yv.x) * rs * w0[0]; o0[1] = h0[1] + hi_bf(yv.x) * rs * w0[1]; o0[2] = h0[2] + lo_bf(yv.y) * rs * w0[2]; o0[3] = h0[3] + hi_bf(yv.y) * rs * w0[3];
            o1[0] = h1[0] + lo_bf(yv.z) * rs * w1[0]; o1[1] = h1[1] + hi_bf(yv.z) * rs * w1[1]; o1[2] = h1[2] + lo_bf(yv.w) * rs * w1[2]; o1[3] = h1[3] + hi_bf(yv.w) * rs * w1[3];
            *(f32x4*)(o + c) = o0; *(f32x4*)(o + c + 4) = o1; }
    }
}

DI void load8_hist(const Frame& F, int r, int i, int cb, float (&x)[8]) {
    const bf16_t* QKVB = (const bf16_t*)(F.ws + WS_QKVB);
    int row = -1; const float* cs = nullptr;
    if (r < ROW_S0) { const int p = r - i; row = p >= 0 ? p : ROW_M0 + N_META + p; }
    else if (r < ROW_M0) { const int s = (r - ROW_S0) & 31, b = (r - ROW_S0) >> 5; if (s - i >= 0) row = r - i; else cs = F.P->in[IN_CONVS] + ((size_t)b * 3 + (3 + s - i)) * C3 + cb; }
    else { const int m = r - ROW_M0; if (m - i >= 0) row = r - i; }
    if (row >= 0) { const u32x4 w = *(const u32x4*)(QKVB + (size_t)row * C3 + cb); x[0] = lo_bf(w.x); x[1] = hi_bf(w.x); x[2] = lo_bf(w.y); x[3] = hi_bf(w.y); x[4] = lo_bf(w.z); x[5] = hi_bf(w.z); x[6] = lo_bf(w.w); x[7] = hi_bf(w.w); }
    else if (cs) { const f32x4 a = *(const f32x4*)cs, b = *(const f32x4*)(cs + 4); x[0] = a[0]; x[1] = a[1]; x[2] = a[2]; x[3] = a[3]; x[4] = b[0]; x[5] = b[1]; x[6] = b[2]; x[7] = b[3]; }
    else {
#pragma unroll
        for (int j = 0; j < 8; ++j) x[j] = 0.f; }
}
DI void p2_conv(Frame& F) {
    const int gw = F.vcu * 8 + F.wave, NGW = F.G * 8, sub = F.lane >> 4, l16 = F.lane & 15;
    bf16_t* QKVN = (bf16_t*)(F.ws + WS_QKVN); const float* AB = (const float*)(F.ws + WS_AB); float* BG = (float*)(F.ws + WS_BG);
    const float* cw = F.P->in[IN_CONVW];
    constexpr int NRB = (NROWS + 63) / 64, NIT = NRB * NH_B * 3;
    for (int it = gw; it < NIT; it += NGW) {
        const int t = it % 3, hb = (it / 3) % NH_B, rb = it / (3 * NH_B), r0 = rb * 64 + sub * 16;
        const float adt = F.P->in[IN_DTB][hb], nea = -expf(F.P->in[IN_ALOG][hb]);
        {
            const int cb = t * W_B + hb * 128 + l16 * 8;
            float w[4][8];
#pragma unroll
            for (int i = 0; i < 4; ++i) { const f32x4 w0 = *(const f32x4*)(cw + (size_t)i * C3 + cb), w1 = *(const f32x4*)(cw + (size_t)i * C3 + cb + 4);
#pragma unroll
                for (int j = 0; j < 4; ++j) { w[i][j] = w0[j]; w[i][4 + j] = w1[j]; } }
            float x0[8], x1[8], x2[8], x3[8];
            if (r0 < NROWS) { load8_hist(F, r0, 3, cb, x0); load8_hist(F, r0, 2, cb, x1); load8_hist(F, r0, 1, cb, x2); }
            else {
#pragma unroll
                for (int j = 0; j < 8; ++j) { x0[j] = 0.f; x1[j] = 0.f; x2[j] = 0.f; } }
            const float post = t == 0 ? 0.08838834764831845f : 1.0f;
            u32x4 raw[16];
            { const bf16_t* QKVB = (const bf16_t*)(F.ws + WS_QKVB);
#pragma unroll
              for (int k = 0; k < 16; ++k) { raw[k] = (u32x4){0u, 0u, 0u, 0u}; if (r0 + k < NROWS) raw[k] = *(const u32x4*)(QKVB + (size_t)(r0 + k) * C3 + cb); } }
#pragma unroll
            for (int k = 0; k < 16; ++k) {
                const int r = r0 + k; const bool valid = r < NROWS;
                { const u32x4 wq = raw[k]; x3[0] = lo_bf(wq.x); x3[1] = hi_bf(wq.x); x3[2] = lo_bf(wq.y); x3[3] = hi_bf(wq.y); x3[4] = lo_bf(wq.z); x3[5] = hi_bf(wq.z); x3[6] = lo_bf(wq.w); x3[7] = hi_bf(wq.w); }
                float y[8]; float ss = 0.f;
#pragma unroll
                for (int j = 0; j < 8; ++j) { y[j] = silu_f(x0[j] * w[0][j] + x1[j] * w[1][j] + x2[j] * w[2][j] + x3[j] * w[3][j]); ss += y[j] * y[j]; x0[j] = x1[j]; x1[j] = x2[j]; x2[j] = x3[j]; }
                float sc = 1.0f;
                if (t < 2) { ss += __shfl_xor(ss, 1); ss += __shfl_xor(ss, 2); ss += __shfl_xor(ss, 4); ss += __shfl_xor(ss, 8); sc = post / sqrtf(ss + EPS); }
                if (valid) { u32x4 o; o.x = cvtpk(y[0] * sc, y[1] * sc); o.y = cvtpk(y[2] * sc, y[3] * sc); o.z = cvtpk(y[4] * sc, y[5] * sc); o.w = cvtpk(y[6] * sc, y[7] * sc);
                    *(u32x4*)(QKVN + (size_t)r * C3 + cb) = o; }
            }
        }
        { const int r = rb * 64 + F.lane;
          if (t == 0 && r < NROWS) { const float braw = AB[(size_t)r * 32 + hb], araw = AB[(size_t)r * 32 + NH_B + hb];
              const float beta = 1.0f / (1.0f + expf(-braw)); const float xx = araw + adt; const float sp = xx > 20.f ? xx : log1pf(expf(xx));
              BG[((size_t)r * NH_B + hb) * 2] = beta; BG[((size_t)r * NH_B + hb) * 2 + 1] = nea * sp; } }
    }
}

constexpr int PK_W = 0, PK_Q = 16384, PK_A = 32768, PK_K = 40960, PK_U = 57344;
DI int crow(int r, int h) { return (r & 3) + 8 * (r >> 2) + 4 * h; }
DI int sc_base_row(int sc) { return sc == 0 ? ROW_M0 : (sc < NCH_P ? (sc - 1) * 64 : ROW_S0 + (sc - NCH_P) * 32); }
DI int sc_len(int sc) { return sc == 0 ? N_META : (sc < NCH_P ? 64 : DEC_SEQ); }
DI float rdlane_f(float v, int lane) { return __builtin_bit_cast(float, __builtin_amdgcn_readlane(__builtin_bit_cast(int, v), lane)); }
DI bf16x8 pack8f(const float* x) { u32x4 w; w.x = cvtpk(x[0], x[1]); w.y = cvtpk(x[2], x[3]); w.z = cvtpk(x[4], x[5]); w.w = cvtpk(x[6], x[7]); return __builtin_bit_cast(bf16x8, w); }
DI bf16x8 pack8v(const f32x16& v, int b, float sc) { u32x4 w; w.x = cvtpk(v[b] * sc, v[b + 1] * sc); w.y = cvtpk(v[b + 2] * sc, v[b + 3] * sc); w.z = cvtpk(v[b + 4] * sc, v[b + 5] * sc); w.w = cvtpk(v[b + 6] * sc, v[b + 7] * sc); return __builtin_bit_cast(bf16x8, w); }
template <int C> struct InvStep {
    static DI void run(float (&T)[64], const LAS float* Al, int lane) {
        float a0 = 0.f, a1 = 0.f;
#pragma unroll
        for (int j4 = ((C + 1) & ~3); j4 < 64; j4 += 4) { const f32x4 a = *(const LAS f32x4*)(Al + C * 64 + j4);
#pragma unroll
            for (int e = 0; e < 4; ++e) { const int j = j4 + e; if (j > C) { if (j & 1) a1 = __builtin_fmaf(-T[j], a[e], a1); else a0 = __builtin_fmaf(-T[j], a[e], a0); } }
            }
        T[C] = (lane == C) ? 1.0f : (a0 + a1);
        PINV(T[C]);
        if constexpr (C > 0) InvStep<C - 1>::run(T, Al, lane);
    }
};
DI void p3_prep(Frame& F) {
    const int gw = F.vcu * 8 + F.wave, NGW = F.G * 8, lane = F.lane, r32 = lane & 31, h = lane >> 5;
    const bf16_t* QKVN = (const bf16_t*)(F.ws + WS_QKVN); const float* BG = (const float*)(F.ws + WS_BG);
    LAS unsigned char* tile = F.lds + F.wave * 17408;
    LAS float* gs = (LAS float*)(F.lds + F.wave * 17408 + 16384);
    for (int rnd = 0; rnd * NGW < NSC * NH_B; ++rnd) {
        const int item = rnd * NGW + (((rnd + 1) * NGW <= NSC * NH_B) ? gw : F.vcu + F.G * F.wave);
        if (item >= NSC * NH_B) break;
        const int sc = item / NH_B, hb = item % NH_B, row0 = sc_base_row(sc), L = sc_len(sc);
        unsigned char* pkg = F.ws + WS_PKG + (size_t)item * PKG_BYTES;
        float g = 0.f, beta = 0.f; if (lane < L) { beta = BG[((size_t)(row0 + lane) * NH_B + hb) * 2]; g = BG[((size_t)(row0 + lane) * NH_B + hb) * 2 + 1]; }
        float G = g;
#pragma unroll
        for (int off = 1; off < 64; off <<= 1) { const float t = __shfl(G, (lane - off) & 63); if (lane >= off) G += t; }
        const float Glast = __shfl(G, 63);
        gs[lane] = G; gs[64 + lane] = fast_exp2((Glast - G) * LOG2E); gs[128 + lane] = beta * fast_exp2(G * LOG2E); gs[192 + lane] = beta;
        if (lane == 0) ((float*)(F.ws + WS_DEC))[item] = fast_exp2(Glast * LOG2E);
        WAIT_L(0); CFENCE();
        bf16x8 kf[2][8], qf[2][8];
#pragma unroll
        for (int tt = 0; tt < 2; ++tt) { const int tok = 32 * tt + r32; const bool ok = tok < L; const bf16_t* rp = QKVN + (size_t)(row0 + tok) * C3 + hb * 128;
#pragma unroll
            for (int ks = 0; ks < 8; ++ks) { const int ch = 16 * ks + 4 * h; u32x2 a = {0u, 0u}, b = {0u, 0u}, c = {0u, 0u}, d = {0u, 0u};
                if (ok) { a = *(const u32x2*)(rp + W_B + ch); b = *(const u32x2*)(rp + W_B + ch + 8); c = *(const u32x2*)(rp + ch); d = *(const u32x2*)(rp + ch + 8); }
                kf[tt][ks] = __builtin_bit_cast(bf16x8, (u32x4){a.x, a.y, b.x, b.y}); qf[tt][ks] = __builtin_bit_cast(bf16x8, (u32x4){c.x, c.y, d.x, d.y}); } }
        const float Gi0 = __shfl(G, r32), Gi1 = __shfl(G, 32 + r32);
#pragma unroll
        for (int tl = 0; tl < 3; ++tl) {
            const int jt = tl >> 1, it = (tl + 1) >> 1; f32x16 Sx = {};
#pragma unroll
            for (int ks = 0; ks < 8; ++ks) Sx = __builtin_amdgcn_mfma_f32_32x32x16_bf16(kf[jt][ks], qf[it][ks], Sx, 0, 0, 0);
            const float Gi = it ? Gi1 : Gi0;
#pragma unroll
            for (int q4 = 0; q4 < 4; ++q4) { const f32x4 gj = *(const LAS f32x4*)(gs + 32 * jt + 8 * q4 + 4 * h);
#pragma unroll
                for (int e = 0; e < 4; ++e) { const int r = 4 * q4 + e, j0 = 8 * q4 + 4 * h + e; const float v = Sx[r] * fast_exp2((Gi - gj[e]) * LOG2E); Sx[r] = (jt != it || j0 <= r32) ? v : 0.f; } }
#pragma unroll
            for (int s2 = 0; s2 < 2; ++s2) *(bf16x8*)(pkg + PK_A + (it * 4 + jt * 2 + s2) * 1024 + lane * 16) = pack8v(Sx, 8 * s2, 1.f);
            SBAR();
        }
        { bf16x8 z = {}; *(bf16x8*)(pkg + PK_A + (0 * 4 + 1 * 2 + 0) * 1024 + lane * 16) = z; *(bf16x8*)(pkg + PK_A + (0 * 4 + 1 * 2 + 1) * 1024 + lane * 16) = z; }
        {
            const float e0 = fast_exp2(Gi0 * LOG2E), e1 = fast_exp2(Gi1 * LOG2E);
#pragma unroll
            for (int tt = 0; tt < 2; ++tt)
#pragma unroll
                for (int ks = 0; ks < 8; ++ks) { const u32x4 w = __builtin_bit_cast(u32x4, qf[tt][ks]); const float e = tt ? e1 : e0;
                    u32x4 o; o.x = cvtpk(lo_bf(w.x) * e, hi_bf(w.x) * e); o.y = cvtpk(lo_bf(w.y) * e, hi_bf(w.y) * e); o.z = cvtpk(lo_bf(w.z) * e, hi_bf(w.z) * e); o.w = cvtpk(lo_bf(w.w) * e, hi_bf(w.w) * e);
                    *(u32x4*)(pkg + PK_Q + (tt * 8 + ks) * 1024 + lane * 16) = o; }
        }
        {
            const float b0 = __shfl(beta, r32), b1 = __shfl(beta, 32 + r32);
            LAS float* Al = (LAS float*)tile;
#pragma unroll
            for (int tl = 0; tl < 3; ++tl) {
                const int ct = tl >> 1, jt = (tl + 1) >> 1; f32x16 Kx = {};
#pragma unroll
                for (int ks = 0; ks < 8; ++ks) Kx = __builtin_amdgcn_mfma_f32_32x32x16_bf16(kf[ct][ks], kf[jt][ks], Kx, 0, 0, 0);
                const float Gj = jt ? Gi1 : Gi0, bj = jt ? b1 : b0;
#pragma unroll
                for (int q4 = 0; q4 < 4; ++q4) { const f32x4 gc = *(const LAS f32x4*)(gs + 32 * ct + 8 * q4 + 4 * h);
#pragma unroll
                    for (int e = 0; e < 4; ++e) { const int r = 4 * q4 + e; Al[(32 * ct + crow(r, h)) * 64 + 32 * jt + r32] = Kx[r] * bj * fast_exp2(fminf(Gj - gc[e], 0.f) * LOG2E); } }
                SBAR();
            }
        }
        WAIT_L(0); CFENCE();
        float T[64];
#pragma unroll
        for (int j = 0; j < 64; ++j) T[j] = (lane == j) ? 1.f : 0.f;
        InvStep<62>::run(T, (const LAS float*)tile, lane);
        WAIT_L(0); CFENCE();
#pragma unroll
        for (int tt = 0; tt < 2; ++tt) { const int tok = 32 * tt + r32; const bool ok = tok < L; const bf16_t* rp = QKVN + (size_t)(row0 + tok) * C3 + hb * 128;
#pragma unroll
            for (int ks = 0; ks < 8; ++ks) { const int ch = 16 * ks + 4 * h; u32x2 a = {0u, 0u}, b = {0u, 0u};
                if (ok) { a = *(const u32x2*)(rp + W_B + ch); b = *(const u32x2*)(rp + W_B + ch + 8); }
                kf[tt][ks] = __builtin_bit_cast(bf16x8, (u32x4){a.x, a.y, b.x, b.y}); } }
#pragma unroll
        for (int tt = 0; tt < 2; ++tt)
#pragma unroll
            for (int ks = 0; ks < 8; ++ks) { const u32x4 w = __builtin_bit_cast(u32x4, kf[tt][ks]); LAS unsigned char* p = tile + (32 * tt + r32) * 256 + (16 * ks + 4 * h) * 2;
                *(LAS u32x2*)p = (u32x2){w.x, w.y}; *(LAS u32x2*)(p + 16) = (u32x2){w.z, w.w}; }
        bf16x8 TW[2][4], TU[2][4];
#pragma unroll
        for (int ks = 0; ks < 4; ++ks) {
            float xa[8], xb[8], ya[8], yb[8];
#pragma unroll
            for (int q = 0; q < 2; ++q) { const f32x4 w0 = *(const LAS f32x4*)(gs + 128 + 16 * ks + 4 * q), w1 = *(const LAS f32x4*)(gs + 128 + 16 * ks + 8 + 4 * q), u0 = *(const LAS f32x4*)(gs + 192 + 16 * ks + 4 * q), u1 = *(const LAS f32x4*)(gs + 192 + 16 * ks + 8 + 4 * q);
#pragma unroll
                for (int e = 0; e < 4; ++e) { const int jj = 4 * q + e; xa[jj] = T[16 * ks + jj] * w0[e]; xb[jj] = T[16 * ks + 8 + jj] * w1[e]; ya[jj] = T[16 * ks + jj] * u0[e]; yb[jj] = T[16 * ks + 8 + jj] * u1[e]; } }
            const u32x4 a = __builtin_bit_cast(u32x4, pack8f(xa)), b = __builtin_bit_cast(u32x4, pack8f(xb)), c = __builtin_bit_cast(u32x4, pack8f(ya)), d = __builtin_bit_cast(u32x4, pack8f(yb));
            u32x4 t0, t1, u0v, u1v;
#pragma unroll
            for (int e = 0; e < 4; ++e) { auto rr = __builtin_amdgcn_permlane32_swap(a[e], b[e], false, false); t0[e] = rr[0]; t1[e] = rr[1];
                auto r2 = __builtin_amdgcn_permlane32_swap(c[e], d[e], false, false); u0v[e] = r2[0]; u1v[e] = r2[1]; }
            TW[0][ks] = __builtin_bit_cast(bf16x8, t0); TW[1][ks] = __builtin_bit_cast(bf16x8, t1); TU[0][ks] = __builtin_bit_cast(bf16x8, u0v); TU[1][ks] = __builtin_bit_cast(bf16x8, u1v);
        }
        WAIT_L(0); CFENCE();
        const int tr_off = ((lane >> 2) & 3) * 256 + (16 * ((lane >> 4) & 1) + 4 * (lane & 3)) * 2;
#define TRF(tok0, ch0) ({ const s16x4 lo_ = tr16(tile + tr_off + (tok0) * 256 + (ch0) * 2), hi_ = tr16(tile + tr_off + ((tok0) + 4) * 256 + (ch0) * 2); (bf16x8){lo_[0], lo_[1], lo_[2], lo_[3], hi_[0], hi_[1], hi_[2], hi_[3]}; })
#pragma unroll
        for (int it = 0; it < 2; ++it) {
            f32x16 acc[4] = {};
#pragma unroll
            for (int ks = 0; ks < 4; ++ks)
#pragma unroll
                for (int ct = 0; ct < 4; ++ct) { const bf16x8 a = TRF(16 * ks + 8 * h, 32 * ct); acc[ct] = __builtin_amdgcn_mfma_f32_32x32x16_bf16(a, TW[it][ks], acc[ct], 0, 0, 0); }
#pragma unroll
            for (int ct = 0; ct < 4; ++ct)
#pragma unroll
                for (int s = 0; s < 2; ++s) *(bf16x8*)(pkg + PK_W + (it * 8 + ct * 2 + s) * 1024 + lane * 16) = pack8v(acc[ct], 8 * s, -1.f);
        }
#pragma unroll
        for (int ct = 0; ct < 4; ++ct)
#pragma unroll
            for (int ts = 0; ts < 4; ++ts) { const int tb = 16 * ts + 4 * h;
                const s16x4 lo_ = tr16(tile + tr_off + tb * 256 + (32 * ct) * 2), hi_ = tr16(tile + tr_off + (tb + 8) * 256 + (32 * ct) * 2);
                const f32x4 e0 = *(const LAS f32x4*)(gs + 64 + tb), e1 = *(const LAS f32x4*)(gs + 64 + tb + 8);
                float x[8];
#pragma unroll
                for (int e = 0; e < 4; ++e) { x[e] = bf2f((unsigned short)lo_[e]) * e0[e]; x[4 + e] = bf2f((unsigned short)hi_[e]) * e1[e]; }
                *(bf16x8*)(pkg + PK_K + (ct * 4 + ts) * 1024 + lane * 16) = pack8f(x); }
        WAIT_L(0); CFENCE();
#pragma unroll
        for (int tt = 0; tt < 2; ++tt) { const int tok = 32 * tt + r32; const bool ok = tok < L; const bf16_t* rp = QKVN + (size_t)(row0 + tok) * C3 + 2 * W_B + hb * 128;
#pragma unroll
            for (int cs = 0; cs < 8; ++cs) { u32x4 w = {0u, 0u, 0u, 0u}; if (ok) w = *(const u32x4*)(rp + 16 * cs + 8 * h); *(LAS u32x4*)(tile + tok * 256 + (16 * cs + 8 * h) * 2) = w; } }
        WAIT_L(0); CFENCE();
#pragma unroll
        for (int it = 0; it < 2; ++it) {
            f32x16 acc[4] = {};
#pragma unroll
            for (int ks = 0; ks < 4; ++ks)
#pragma unroll
                for (int ct = 0; ct < 4; ++ct) { const bf16x8 b = TRF(16 * ks + 8 * h, 32 * ct); acc[ct] = __builtin_amdgcn_mfma_f32_32x32x16_bf16(TU[it][ks], b, acc[ct], 0, 0, 0); }
#pragma unroll
            for (int ct = 0; ct < 4; ++ct) { unsigned char* up = pkg + PK_U + (ct * 2 + it) * 2048 + lane * 32; *(bf16x8*)up = pack8v(acc[ct], 0, 1.f); *(bf16x8*)(up + 16) = pack8v(acc[ct], 8, 1.f); }
        }
#undef TRF
        WAIT_L(0); CFENCE();
    }
}
constexpr int SC_FRAG = 57344, SC_OEX = 2 * SC_FRAG, SC_OEXB = 16384;
constexpr int SG = 4;
constexpr int N_SCAN_P = NH_B, N_SCAN_S = (DEC_BATCH * NH_B + SG - 1) / SG;
DI void scan_unit(Frame& F, int kind, int idx) {
    const int lane = F.lane, w = F.wave, r32 = lane & 31, h = lane >> 5;
    const int n = kind == 0 ? NCH_P : ((DEC_BATCH * NH_B - idx * SG) < SG ? (DEC_BATCH * NH_B - idx * SG) : SG);
    const float* DEC = (const float*)(F.ws + WS_DEC);
    bf16_t* YCAT = (bf16_t*)(F.ws + WS_YCAT); const bf16_t* GB = (const bf16_t*)(F.ws + WS_GB);
#define SC_ITEM(k) (kind == 0 ? (k) * NH_B + idx : (NCH_P + (idx * SG + (k)) / NH_B) * NH_B + (idx * SG + (k)) % NH_B)
    f32x16 S[4] = {};
    if (w >= 4) {
        const unsigned char* src = F.ws + WS_PKG + (size_t)SC_ITEM(0) * PKG_BYTES;
        for (int b = w - 4; b < 56; b += 4) __builtin_amdgcn_global_load_lds((const unsigned*)(src + b * 1024 + lane * 16), (LAS unsigned*)(F.lds + b * 1024), 16, 0, 0);
    }
    WAIT_V(0); __syncthreads();
    for (int k = 0; k < n; ++k) {
        const int item = SC_ITEM(k), sc = item / NH_B, hb = item % NH_B;
        LAS unsigned char* buf = F.lds + (k & 1) * SC_FRAG;
        if (w >= 4) {
            if (k + 1 < n) { const unsigned char* src = F.ws + WS_PKG + (size_t)SC_ITEM(k + 1) * PKG_BYTES; LAS unsigned char* dst = F.lds + ((k + 1) & 1) * SC_FRAG;
                for (int b = w - 4; b < 56; b += 4) __builtin_amdgcn_global_load_lds((const unsigned*)(src + b * 1024 + lane * 16), (LAS unsigned*)(dst + b * 1024), 16, 0, 0); }
        }
        if (w >= 4 && k > 0) {
            const int pit = SC_ITEM(k - 1), psc = pit / NH_B, phb = pit % NH_B, prow0 = sc_base_row(psc), pL = sc_len(psc);
            const LAS unsigned char* ox = F.lds + SC_OEX + ((k - 1) & 1) * SC_OEXB;
            if (psc != 0) {
#pragma unroll
                for (int ps = 0; ps < 4; ++ps) { const int t = (w - 4) * 16 + ps * 4 + (lane >> 4), ch = (lane & 15) * 8;
                    const u32x4 xv = *(const LAS u32x4*)(ox + t * 256 + ch * 2);
                    float x[8] = {lo_bf(xv.x), hi_bf(xv.x), lo_bf(xv.y), hi_bf(xv.y), lo_bf(xv.z), hi_bf(xv.z), lo_bf(xv.w), hi_bf(xv.w)};
                    float ss = 0.f;
#pragma unroll
                    for (int j = 0; j < 8; ++j) ss += x[j] * x[j];
                    { int lq = F.lane; OPAQUE(lq); ss += shfl_xor_l(ss, 1, lq); ss += shfl_xor_l(ss, 2, lq); ss += shfl_xor_l(ss, 4, lq); ss += shfl_xor_l(ss, 8, lq); }
                    const float rs = 1.0f / sqrtf(ss * (1.f / 128.f) + EPS);
                    if (t < pL) { const int row = prow0 + t; const u32x4 gv = *(const u32x4*)(GB + (size_t)row * W_B + phb * 128 + ch);
                        const f32x4 n0 = *(const f32x4*)(F.P->in[IN_NORMB] + ch), n1 = *(const f32x4*)(F.P->in[IN_NORMB] + ch + 4);
                        u32x4 o; o.x = cvtpk(x[0] * rs * n0[0] * lo_bf(gv.x), x[1] * rs * n0[1] * hi_bf(gv.x)); o.y = cvtpk(x[2] * rs * n0[2] * lo_bf(gv.y), x[3] * rs * n0[3] * hi_bf(gv.y));
                        o.z = cvtpk(x[4] * rs * n1[0] * lo_bf(gv.z), x[5] * rs * n1[1] * hi_bf(gv.z)); o.w = cvtpk(x[6] * rs * n1[2] * lo_bf(gv.w), x[7] * rs * n1[3] * hi_bf(gv.w));
                        *(u32x4*)(YCAT + (size_t)row * D_MODEL + W_A + phb * 128 + ch) = o; } }
            }
        }
        if (w < 4) {
            const unsigned char* pkg = F.ws + WS_PKG + (size_t)item * PKG_BYTES;
            if (kind == 1) {
                const float* sp = F.P->in[IN_SSM] + (size_t)((sc - NCH_P) * NH_B + hb) * 16384 + (size_t)(4 * h) * 128 + 32 * w + r32;
#pragma unroll
                for (int T = 0; T < 4; ++T) {
#pragma unroll
                    for (int r = 0; r < 16; ++r) S[T][r] = sp[(32 * T + (r & 3) + 8 * (r >> 2)) * 128];
                    SBAR(); }
            }
            const float d = DEC[item];
            f32x16 vn[2], o[2] = {};
#pragma unroll
            for (int rt = 0; rt < 2; ++rt) { const u32x4 a = *(const u32x4*)(pkg + PK_U + (w * 2 + rt) * 2048 + lane * 32), b = *(const u32x4*)(pkg + PK_U + (w * 2 + rt) * 2048 + lane * 32 + 16);
                vn[rt][0] = lo_bf(a.x); vn[rt][1] = hi_bf(a.x); vn[rt][2] = lo_bf(a.y); vn[rt][3] = hi_bf(a.y); vn[rt][4] = lo_bf(a.z); vn[rt][5] = hi_bf(a.z); vn[rt][6] = lo_bf(a.w); vn[rt][7] = hi_bf(a.w);
                vn[rt][8] = lo_bf(b.x); vn[rt][9] = hi_bf(b.x); vn[rt][10] = lo_bf(b.y); vn[rt][11] = hi_bf(b.y); vn[rt][12] = lo_bf(b.z); vn[rt][13] = hi_bf(b.z); vn[rt][14] = lo_bf(b.w); vn[rt][15] = hi_bf(b.w); }
            SBAR();
#define FRAG(off, blk) (*(const LAS bf16x8*)(buf + (off) + (blk) * 1024 + lane * 16))
#pragma unroll
            for (int T = 0; T < 4; ++T)
#pragma unroll
                for (int s = 0; s < 2; ++s) { const bf16x8 sb = pack8v(S[T], 8 * s, 1.f);
#pragma unroll
                    for (int rt = 0; rt < 2; ++rt) { vn[rt] = __builtin_amdgcn_mfma_f32_32x32x16_bf16(FRAG(PK_W, rt * 8 + T * 2 + s), sb, vn[rt], 0, 0, 0);
                        o[rt] = __builtin_amdgcn_mfma_f32_32x32x16_bf16(FRAG(PK_Q, rt * 8 + T * 2 + s), sb, o[rt], 0, 0, 0); }
                    SBAR(); }
#pragma unroll
            for (int T = 0; T < 4; ++T) S[T] *= d;
#pragma unroll
            for (int Tt = 0; Tt < 2; ++Tt)
#pragma unroll
                for (int s = 0; s < 2; ++s) { const bf16x8 vb = pack8v(vn[Tt], 8 * s, 1.f);
#pragma unroll
                    for (int rt = 0; rt < 2; ++rt) o[rt] = __builtin_amdgcn_mfma_f32_32x32x16_bf16(FRAG(PK_A, rt * 4 + Tt * 2 + s), vb, o[rt], 0, 0, 0);
                    SBAR();
#pragma unroll
                    for (int T = 0; T < 4; ++T) S[T] = __builtin_amdgcn_mfma_f32_32x32x16_bf16(FRAG(PK_K, T * 4 + Tt * 2 + s), vb, S[T], 0, 0, 0);
                    SBAR(); }
#undef FRAG
            LAS unsigned short* ox = (LAS unsigned short*)(F.lds + SC_OEX + (k & 1) * SC_OEXB);
#pragma unroll
            for (int rt = 0; rt < 2; ++rt)
#pragma unroll
                for (int r = 0; r < 16; ++r) ox[(32 * rt + crow(r, h)) * 128 + 32 * w + r32] = (unsigned short)f2bf(o[rt][r]);
            if (kind == 1 || k == n - 1) {
                float* dp = (kind == 1 ? F.out + O_SS + (size_t)((sc - NCH_P) * NH_B + hb) * 16384 : F.out + O_SP + (size_t)hb * 16384) + (size_t)(4 * h) * 128 + 32 * w + r32;
#pragma unroll
                for (int T = 0; T < 4; ++T) {
#pragma unroll
                    for (int r = 0; r < 16; ++r) dp[(32 * T + (r & 3) + 8 * (r >> 2)) * 128] = S[T][r];
                    SBAR(); }
            }
        }
        WAIT_VL0(); __syncthreads();
    }
    if (w >= 4) {
        const int pit = SC_ITEM(n - 1), psc = pit / NH_B, phb = pit % NH_B, prow0 = sc_base_row(psc), pL = sc_len(psc);
        const LAS unsigned char* ox = F.lds + SC_OEX + ((n - 1) & 1) * SC_OEXB;
        if (psc != 0) {
#pragma unroll
            for (int ps = 0; ps < 4; ++ps) { const int t = (w - 4) * 16 + ps * 4 + (lane >> 4), ch = (lane & 15) * 8;
                const u32x4 xv = *(const LAS u32x4*)(ox + t * 256 + ch * 2);
                float x[8] = {lo_bf(xv.x), hi_bf(xv.x), lo_bf(xv.y), hi_bf(xv.y), lo_bf(xv.z), hi_bf(xv.z), lo_bf(xv.w), hi_bf(xv.w)};
                float ss = 0.f;
#pragma unroll
                for (int j = 0; j < 8; ++j) ss += x[j] * x[j];
                { int lq = F.lane; OPAQUE(lq); ss += shfl_xor_l(ss, 1, lq); ss += shfl_xor_l(ss, 2, lq); ss += shfl_xor_l(ss, 4, lq); ss += shfl_xor_l(ss, 8, lq); }
                const float rs = 1.0f / sqrtf(ss * (1.f / 128.f) + EPS);
                if (t < pL) { const int row = prow0 + t; const u32x4 gv = *(const u32x4*)(GB + (size_t)row * W_B + phb * 128 + ch);
                    const f32x4 n0 = *(const f32x4*)(F.P->in[IN_NORMB] + ch), n1 = *(const f32x4*)(F.P->in[IN_NORMB] + ch + 4);
                    u32x4 o; o.x = cvtpk(x[0] * rs * n0[0] * lo_bf(gv.x), x[1] * rs * n0[1] * hi_bf(gv.x)); o.y = cvtpk(x[2] * rs * n0[2] * lo_bf(gv.y), x[3] * rs * n0[3] * hi_bf(gv.y));
                    o.z = cvtpk(x[4] * rs * n1[0] * lo_bf(gv.z), x[5] * rs * n1[1] * hi_bf(gv.z)); o.w = cvtpk(x[6] * rs * n1[2] * lo_bf(gv.w), x[7] * rs * n1[3] * hi_bf(gv.w));
                    *(u32x4*)(YCAT + (size_t)row * D_MODEL + W_A + phb * 128 + ch) = o; } }
        }
    }
    __syncthreads();
#undef SC_ITEM
}
constexpr int AT_KB = 32768, AT_K = 0, AT_V = 2 * AT_KB, AT_TB = 4 * AT_KB, AT_WS = AT_TB + NTB * 4, AT_END = AT_WS + 8 * 256;
static_assert(AT_END <= RING_BYTES, "attention LDS");
constexpr float THR_L2 = 11.5f;
DI int v_rd_base(int lane) { return ((lane & 3) << 3) | (((lane >> 2) & 3) << 6) | (((lane >> 4) & 1) << 5) | (((lane >> 5) & 1) << 8); }
struct AttnW { bf16x8 qr[8]; f32x16 o[8]; float m, l; };
DI void attn_tile(AttnW& A, const LAS unsigned char* Kc, const LAS unsigned char* Vt, const LAS float* tbl, LAS float* wsf, int lane, int tbi, float bu, int nvalid) {
    const int r32 = lane & 31, hi = lane >> 5;
    const float ub = tbi >= 0 ? 0.f : bu;
    const LAS unsigned char* vb0 = Vt + v_rd_base(lane);
#pragma unroll
    for (int hf = 0; hf < 2; ++hf) {
        f32x16 p = {};
        {
            const LAS unsigned char* kb[4];
#pragma unroll
            for (int dd = 0; dd < 4; ++dd) kb[dd] = Kc + hf * 8192 + r32 * 256 + (((dd * 16 + hi * 8) * 2) ^ ((r32 & 7) << 4));
#pragma unroll
            for (int d0 = 0; d0 < 8; ++d0) { const bf16x8 b0 = *(const LAS bf16x8*)(kb[d0 & 3] + (d0 >> 2) * 128); p = __builtin_amdgcn_mfma_f32_32x32x16_bf16(b0, A.qr[d0], p, 0, 0, 0); }
        }
        SBAR();
        if (tbi >= 0) {
            const LAS float* tp = tbl + tbi + 4 * hi + 32 * hf;
#pragma unroll
            for (int r = 0; r < 16; ++r) p[r] += tp[(r & 3) + 8 * (r >> 2)];
        }
        if (nvalid < 64) {
            const float NEG = -__builtin_inff();
#pragma unroll
            for (int r = 0; r < 16; ++r) { if ((r & 3) + 8 * (r >> 2) + 4 * hi + 32 * hf >= nvalid) p[r] = NEG; }
        }
        float pmax = p[0];
#pragma unroll
        for (int r = 1; r < 16; ++r) pmax = fmaxf(pmax, p[r]);
        { auto rr = __builtin_amdgcn_permlane32_swap(__float_as_uint(pmax), __float_as_uint(pmax), false, false); pmax = fmaxf(__uint_as_float(rr[0]), __uint_as_float(rr[1])); }
        pmax += ub;
        float mn, alpha;
        if (__all(pmax - A.m <= THR_L2)) { mn = A.m; alpha = 1.f; }
        else { mn = fmaxf(A.m, pmax); alpha = fast_exp2(A.m - mn); A.m = mn; }
        const float sh = ub - mn;
        float ps = 0.f;
#pragma unroll
        for (int r = 0; r < 16; ++r) { p[r] = fast_exp2(p[r] + sh); ps += p[r]; }
        { auto rr = __builtin_amdgcn_permlane32_swap(__float_as_uint(ps), __float_as_uint(ps), false, false); ps = __uint_as_float(rr[0]) + __uint_as_float(rr[1]); }
        A.l = A.l * alpha + ps;
        if (__any(alpha < 1.f)) {
            if (hi == 0) wsf[r32] = alpha;
            WAIT_L(0); CFENCE();
#pragma unroll
            for (int r = 0; r < 16; ++r) { const float al = wsf[crow(r, hi)];
#pragma unroll
                for (int d = 0; d < 8; ++d) A.o[d][r] *= al; }
            WAIT_L(0); CFENCE();
        }
        bf16x8 pa[2];
#define PK4(P, B_, OUT) do { const unsigned a0 = cvtpk(P[B_ + 0], P[B_ + 1]), a1 = cvtpk(P[B_ + 2], P[B_ + 3]), b0_ = cvtpk(P[B_ + 4], P[B_ + 5]), b1_ = cvtpk(P[B_ + 6], P[B_ + 7]); \
            auto r0 = __builtin_amdgcn_permlane32_swap(a0, b0_, false, false); auto r1 = __builtin_amdgcn_permlane32_swap(a1, b1_, false, false); \
            u32x4 w_ = {r0[0], r1[0], r0[1], r1[1]}; OUT = __builtin_bit_cast(bf16x8, w_); } while (0)
        PK4(p, 0, pa[0]); PK4(p, 8, pa[1]);
#undef PK4
        SBAR();
#pragma unroll
        for (int d0 = 0; d0 < 8; ++d0) {
#pragma unroll
            for (int k2 = 0; k2 < 2; ++k2) { const int ks = 2 * hf + k2; const s16x4 lo_ = tr16(vb0 + d0 * 512 + ks * 8192), hi_ = tr16(vb0 + d0 * 512 + ks * 8192 + 4096);
                const bf16x8 vf = {lo_[0], lo_[1], lo_[2], lo_[3], hi_[0], hi_[1], hi_[2], hi_[3]};
                A.o[d0] = __builtin_amdgcn_mfma_f32_32x32x16_bf16(pa[k2], vf, A.o[d0], 0, 0, 0); }
            if (d0 & 1) SBAR();
        }
    }
}
DI void attn_dma_k(const Frame& F, int kr0, int h, int bufi, int l) {
    const unsigned char* Kg = F.ws + WS_K + ((size_t)kr0 * W_A + h * 256) * 2; const int w = F.wave;
#pragma unroll
    for (int i = 0; i < 4; ++i) { const int cc = w >> 2, m = 4 * (w & 3) + i, row = 4 * m + (l >> 4), ch = (l & 15) ^ (row & 7); const unsigned off = (unsigned)(row * W_A + cc * 128 + ch * 8) * 2u;
        glds16(Kg + off, LDS_A(F.lds) + (unsigned)__builtin_amdgcn_readfirstlane(AT_K + bufi * AT_KB + cc * 16384 + m * 1024)); }
}
DI void attn_dma_v(const Frame& F, int kr0, int h, int bufi, int l) {
    const unsigned char* Vg = F.ws + WS_V + ((size_t)kr0 * W_A + h * 256) * 2; const int w = F.wave;
#pragma unroll
    for (int i = 0; i < 4; ++i) { const int j = 4 * w + i, key = 2 * j + (l >> 5); const unsigned off = (unsigned)(key * W_A * 2) + (unsigned)((16 * (l & 31)) ^ ((key & 3) << 6));
        glds16(Vg + off, LDS_A(F.lds) + (unsigned)__builtin_amdgcn_readfirstlane(AT_V + bufi * AT_KB + j * 1024)); }
}
DI void attn_QK(const AttnW& A, f32x16& p0, f32x16& p1, const LAS unsigned char* Kc, int lane, float init) {
    const int r32 = lane & 31, hi = lane >> 5;
#pragma unroll
    for (int r = 0; r < 16; ++r) { p0[r] = init; p1[r] = init; }
    lds_a kb[4];
#pragma unroll
    for (int dd = 0; dd < 4; ++dd) kb[dd] = LDS_A(Kc) + (unsigned)(r32 * 256 + (((dd * 16 + hi * 8) * 2) ^ ((r32 & 7) << 4)));
    bf16x8 x0, x1, y0, y1;
#define KBATCH(d0, a0, a1) do { LDRD128(a0, kb[(d0) & 3], ((d0) >> 2) * 128); LDRD128(a1, kb[(d0) & 3], ((d0) >> 2) * 128 + 8192); } while (0)
#define KMMA(d0, a0, a1) do { p0 = __builtin_amdgcn_mfma_f32_32x32x16_bf16(a0, A.qr[d0], p0, 0, 0, 0); p1 = __builtin_amdgcn_mfma_f32_32x32x16_bf16(a1, A.qr[d0], p1, 0, 0, 0); } while (0)
#define LWAIT2(a, b) do { asm_lwait2(a, b); } while (0)
    KBATCH(0, x0, x1); LWAIT2(x0, x1);
    KBATCH(1, y0, y1); KMMA(0, x0, x1); LWAIT2(y0, y1);
    KBATCH(2, x0, x1); KMMA(1, y0, y1); LWAIT2(x0, x1);
    KBATCH(3, y0, y1); KMMA(2, x0, x1); LWAIT2(y0, y1);
    KBATCH(4, x0, x1); KMMA(3, y0, y1); LWAIT2(x0, x1);
    KBATCH(5, y0, y1); KMMA(4, x0, x1); LWAIT2(y0, y1);
    KBATCH(6, x0, x1); KMMA(5, y0, y1); LWAIT2(x0, x1);
    KBATCH(7, y0, y1); KMMA(6, x0, x1); LWAIT2(y0, y1);
    KMMA(7, y0, y1);
    PIN2(p0, p1);
#undef KBATCH
#undef KMMA
#undef LWAIT2
}
DI bool attn_SM(AttnW& A, f32x16& p0, f32x16& p1, bf16x8 (&pa)[4], const LAS float* tbl, LAS float* wsf, int lane, int tbi, int nvalid, bool first) {
    const int r32 = lane & 31, hi = lane >> 5;
    if (tbi >= 0) {
        const LAS float* tp = tbl + tbi + 4 * hi;
#pragma unroll
        for (int r = 0; r < 16; ++r) { const int c = (r & 3) + 8 * (r >> 2); p0[r] += tp[c]; p1[r] += tp[c + 32]; }
    }
    if (nvalid < 64) {
        const float NEG = -__builtin_inff();
#pragma unroll
        for (int r = 0; r < 16; ++r) { const int c = (r & 3) + 8 * (r >> 2) + 4 * hi; if (c >= nvalid) p0[r] = NEG; if (c + 32 >= nvalid) p1[r] = NEG; }
    }
    MFMA_PAD2(p0, p1);
    float pmax;
    { float a = max3f(p0[0], p0[1], p1[0]), b = max3f(p0[2], p0[3], p1[1]); a = max3f(a, p1[2], p1[3]);
#pragma unroll
      for (int r = 4; r < 16; r += 4) { a = max3f(a, p0[r], p0[r + 1]); b = max3f(b, p0[r + 2], p0[r + 3]); a = max3f(a, p1[r], p1[r + 1]); b = max3f(b, p1[r + 2], p1[r + 3]); }
      pmax = max2f(a, b); }
    VALU_PAD(pmax);
    { auto rr = __builtin_amdgcn_permlane32_swap(__float_as_uint(pmax), __float_as_uint(pmax), false, false); pmax = fmaxf(__uint_as_float(rr[0]), __uint_as_float(rr[1])); }
    bool resc = false;
    if (first || !__all(pmax <= THR_L2)) {
        const float delta = first ? pmax : fmaxf(pmax, 0.f);
#pragma unroll
        for (int r = 0; r < 16; ++r) { p0[r] -= delta; p1[r] -= delta; }
        const float alpha = first ? 0.f : fast_exp2(-delta);
        A.m += delta; A.l *= alpha; resc = !first; if (hi == 0) wsf[r32] = alpha;
    }
#pragma unroll
    for (int r = 0; r < 16; ++r) { p0[r] = fast_exp2(p0[r]); p1[r] = fast_exp2(p1[r]); }
    TRANS_PAD2(p0, p1);
    { float a = fadd_s(p0[0], p1[0]), b = fadd_s(p0[1], p1[1]);
#pragma unroll
      for (int r = 2; r < 16; r += 2) { a = fadd_s(a, p0[r]); b = fadd_s(b, p0[r + 1]); a = fadd_s(a, p1[r]); b = fadd_s(b, p1[r + 1]); }
      A.l += fadd_s(a, b); }
    pa[0] = pack8v(p0, 0, 1.f); pa[1] = pack8v(p0, 8, 1.f); pa[2] = pack8v(p1, 0, 1.f); pa[3] = pack8v(p1, 8, 1.f);
    PIN4(pa[0], pa[1], pa[2], pa[3]);
    return resc;
}
DI void attn_PV(AttnW& A, const bf16x8 (&pa)[4], const LAS unsigned char* Vt, const LAS float* wsf, int lane, bool resc) {
    const int hi = lane >> 5;
    if (resc) {
#pragma unroll
        for (int r = 0; r < 16; ++r) { const float al = wsf[crow(r, hi)];
#pragma unroll
            for (int d = 0; d < 8; ++d) A.o[d][r] *= al; }
    }
    lds_a vb[4];
    { const int q = (lane >> 2) & 3, pp = lane & 3, ch = (lane >> 4) & 1;
#pragma unroll
      for (int dd = 0; dd < 4; ++dd) vb[dd] = LDS_A(Vt) + (unsigned)((4 * hi + q) * 512 + ((64 * dd + 32 * ch + 8 * pp) ^ (q << 6))); }
    s16x4 xl0, xh0, xl1, xh1, yl0, yh0, yl1, yh1;
#define VBATCH(hb, l0, h0, l1, h1) do { TRRD(l0, vb[((hb) >> 1) & 3], ((hb) >> 3) * 256 + ((hb) & 1) * 16384); TRRD(h0, vb[((hb) >> 1) & 3], ((hb) >> 3) * 256 + ((hb) & 1) * 16384 + 4096); \
        TRRD(l1, vb[((hb) >> 1) & 3], ((hb) >> 3) * 256 + ((hb) & 1) * 16384 + 8192); TRRD(h1, vb[((hb) >> 1) & 3], ((hb) >> 3) * 256 + ((hb) & 1) * 16384 + 12288); } while (0)
#define VF(l, h) ((bf16x8){l[0], l[1], l[2], l[3], h[0], h[1], h[2], h[3]})
#define VMMA(hb, l0, h0, l1, h1) do { A.o[(hb) >> 1] = __builtin_amdgcn_mfma_f32_32x32x16_bf16(pa[2 * ((hb) & 1)], VF(l0, h0), A.o[(hb) >> 1], 0, 0, 0); \
        A.o[(hb) >> 1] = __builtin_amdgcn_mfma_f32_32x32x16_bf16(pa[2 * ((hb) & 1) + 1], VF(l1, h1), A.o[(hb) >> 1], 0, 0, 0); } while (0)
#define VSTEP2(hb) do { VBATCH((hb) + 1, yl0, yh0, yl1, yh1); VMMA(hb, xl0, xh0, xl1, xh1); LWAIT4(yl0, yh0, yl1, yh1); \
        VBATCH((hb) + 2, xl0, xh0, xl1, xh1); VMMA((hb) + 1, yl0, yh0, yl1, yh1); LWAIT4(xl0, xh0, xl1, xh1); } while (0)
    VBATCH(0, xl0, xh0, xl1, xh1); LWAIT4(xl0, xh0, xl1, xh1);
    VSTEP2(0); VSTEP2(2); VSTEP2(4); VSTEP2(6); VSTEP2(8); VSTEP2(10); VSTEP2(12);
    VBATCH(15, yl0, yh0, yl1, yh1); VMMA(14, xl0, xh0, xl1, xh1); LWAIT4(yl0, yh0, yl1, yh1);
    VMMA(15, yl0, yh0, yl1, yh1);
#undef VBATCH
#undef VF
#undef VMMA
#undef VSTEP2
}
DI void attn_epilogue(Frame& F, AttnW& A, int h, int row0, bool act, float lam, bool half_l) {
    int lane = F.lane; OPAQUE(lane);
    const int r32 = lane & 31, hi = lane >> 5, rg = F.wave & 3, c = F.wave >> 2;
    LAS float* wsf = (LAS float*)(F.lds + AT_WS + F.wave * 256);
    LAS float* ex = (LAS float*)(F.lds + rg * 32768);
    { float lt = A.l; if (half_l) lt += shfl_xor_l(lt, 32, lane); if (hi == 0) wsf[32 + r32] = lt; }
    WAIT_L(0); CFENCE();
    float rl[16];
#pragma unroll
    for (int r = 0; r < 16; ++r) rl[r] = fast_rcp(wsf[32 + crow(r, hi)]);
    if (c == 1 && act) {
#pragma unroll
        for (int d = 0; d < 8; ++d)
#pragma unroll
            for (int r = 0; r < 16; ++r) ex[crow(r, hi) * 256 + d * 32 + r32] = A.o[d][r] * rl[r] * lam;
    }
    WAIT_L(0); __syncthreads();
    if (c == 0 && act) {
        const bf16_t* GA = (const bf16_t*)(F.ws + WS_GA) + (size_t)(row0 + rg * 32 + 4 * hi) * W_A + (size_t)h * 256 + r32;
        bf16_t* YC = (bf16_t*)(F.ws + WS_YCAT) + (size_t)(row0 + rg * 32 + 4 * hi) * D_MODEL + (size_t)h * 256 + r32;
        float sw[8];
#pragma unroll
        for (int d = 0; d < 8; ++d) sw[d] = F.P->in[IN_SUBLN][d * 32 + r32] * (1.0f - LAM_INIT);
#pragma unroll
        for (int r = 0; r < 16; ++r) { const int rr = (r & 3) + 8 * (r >> 2); float s = 0.f; float v[8];
#pragma unroll
            for (int d = 0; d < 8; ++d) { v[d] = A.o[d][r] * rl[r] - ex[(rr + 4 * hi) * 256 + d * 32 + r32]; s += v[d] * v[d]; }
            s += shfl_xor_l(s, 1, lane); s += shfl_xor_l(s, 2, lane); s += shfl_xor_l(s, 4, lane); s += shfl_xor_l(s, 8, lane); s += shfl_xor_l(s, 16, lane);
            const float rs = 1.0f / sqrtf(s * (1.f / 256.f) + EPS);
#pragma unroll
            for (int d = 0; d < 8; ++d) YC[(size_t)rr * D_MODEL + d * 32] = (bf16_t)f2bf(v[d] * rs * sw[d] * bf2f(GA[(size_t)rr * W_A + d * 32]));
            SBAR(); }
    }
    __syncthreads();
}
DI float diff_lambda(const Frame& F) {
    int l = F.lane; OPAQUE(l);
    float a = F.P->in[IN_LQ1][l] * F.P->in[IN_LK1][l] + F.P->in[IN_LQ1][l + 64] * F.P->in[IN_LK1][l + 64], b = F.P->in[IN_LQ2][l] * F.P->in[IN_LK2][l] + F.P->in[IN_LQ2][l + 64] * F.P->in[IN_LK2][l + 64];
#pragma unroll
    for (int o = 1; o < 64; o <<= 1) { a += shfl_xor_l(a, o, l); b += shfl_xor_l(b, o, l); }
    return __builtin_expf(a) - __builtin_expf(b) + LAM_INIT;
}
DI void attn_init(const Frame& F, AttnW& A, int h, int c, int qrow0) {
    int ln = F.lane; OPAQUE(ln);
    const bf16_t* Qg = (const bf16_t*)(F.ws + WS_Q) + (size_t)(qrow0 + (ln & 31)) * W_A + h * 256 + c * 128 + (ln >> 5) * 8;
#pragma unroll
    for (int d0 = 0; d0 < 8; ++d0) A.qr[d0] = *(const bf16x8*)(Qg + d0 * 16);
#pragma unroll
    for (int d = 0; d < 8; ++d) A.o[d] = (f32x16){};
    A.m = 0.f; A.l = 0.f;
}
DI void attn_load_table(const Frame& F, int h) { const float* T = (const float*)(F.ws + WS_TB) + (size_t)h * NTB; LAS float* t = (LAS float*)(F.lds + AT_TB); int t0 = F.tid; OPAQUE(t0); for (int i = t0; i < NTB; i += 512) t[i] = T[i]; }
DI void attn_prompt_unit(Frame& F, int h, int qb, float lam) {
    const int w = F.wave, rg = w & 3, c = w >> 2;
    const LAS float* tbl = (const LAS float*)(F.lds + AT_TB); LAS float* wsf = (LAS float*)(F.lds + AT_WS + w * 256);
    AttnW A; attn_init(F, A, h, c, qb * 128 + rg * 32);
    attn_load_table(F, h);
    const int q0w = qb * 128 + rg * 32, qc = q0w >> 6;
    const int NT = 2 * qb + 3;
    const int NTW = (qc + 2) < NT ? (qc + 2) : NT;
#define KROW(t) ((t) == 0 ? ROW_M0 : ((t) - 1) * 64)
    { int ln = F.lane; OPAQUE(ln); attn_dma_k(F, KROW(0), h, 0, ln); attn_dma_v(F, KROW(0), h, 0, ln); attn_dma_k(F, KROW(1), h, 1, ln); }
    WAIT_V(0); WAIT_L(0); __builtin_amdgcn_s_barrier();
    const float bu = tbl[0];
    bf16x8 pa[4]; f32x16 p0, p1; bool resc = false;
#define KPOS0(t) ((t) == 0 ? -N_META : ((t) - 1) * 64)
#define NEAR(t) (KPOS0(t) + 63 - q0w > -559)
#define DO_QK(t) do { int ln = F.lane; OPAQUE(ln); attn_QK(A, p0, p1, F.lds + AT_K + ((t) & 1) * AT_KB + c * 16384, ln, (NEAR(t) ? 0.f : bu) - A.m); } while (0)
#define DO_SM(t) do { int ln = F.lane; OPAQUE(ln); resc = attn_SM(A, p0, p1, pa, tbl, wsf, ln, NEAR(t) ? KPOS0(t) - (q0w + (ln & 31)) + TB_OFF : -1, (t) == 0 ? N_META : 64, (t) == 0); } while (0)
#define DO_PV(t) do { int ln = F.lane; OPAQUE(ln); attn_PV(A, pa, F.lds + AT_V + ((t) & 1) * AT_KB, wsf, ln, resc); } while (0)
#define END_SUB(issued) do { if (issued) { WAIT_V(4); } else { WAIT_V(0); } WAIT_L(0); __builtin_amdgcn_s_barrier(); } while (0)
#define DMA_K2(u) do { if ((u) < NT) { int ln = F.lane; OPAQUE(ln); attn_dma_k(F, KROW(u), h, (u) & 1, ln); } } while (0)
#define DMA_V2(u) do { if ((u) < NT) { int ln = F.lane; OPAQUE(ln); attn_dma_v(F, KROW(u), h, (u) & 1, ln); } } while (0)
    if (c == 0) {
        DO_QK(0); END_SUB(false);
        for (int t = 0; t < NT; ++t) {
            DMA_K2(t + 2); if (t < NTW) { DO_SM(t); if (t + 1 < NTW) DO_QK(t + 1); } END_SUB(t + 2 < NT);
            DMA_V2(t + 1); if (t < NTW) DO_PV(t); END_SUB(t + 1 < NT);
        }
        END_SUB(false);
    } else {
        DO_QK(0); END_SUB(false);
        DMA_K2(2); END_SUB(2 < NT);
        for (int t = 0; t < NT; ++t) {
            DMA_V2(t + 1); if (t < NTW) { DO_SM(t); if (t + 1 < NTW) DO_QK(t + 1); } END_SUB(t + 1 < NT);
            DMA_K2(t + 3); if (t < NTW) DO_PV(t); END_SUB(t + 3 < NT);
        }
    }
#undef KROW
#undef KPOS0
#undef NEAR
#undef DO_QK
#undef DO_SM
#undef DO_PV
#undef END_SUB
#undef DMA_K2
#undef DMA_V2
    attn_epilogue(F, A, h, qb * 128, true, lam, true);
}
DI void attn_sample_unit(Frame& F, int b, int h, float lam) {
    const int w = F.wave, rg = w & 3, c = w >> 2;
    const LAS float* tbl = (const LAS float*)(F.lds + AT_TB); LAS float* wsf = (LAS float*)(F.lds + AT_WS + w * 256);
    const bool act = rg == 0;
    AttnW A; attn_init(F, A, h, c, ROW_S0 + b * 32); A.m = -1e30f;
    attn_load_table(F, h);
    constexpr int NKEY = LCACHE + DEC_SEQ, NT = (NKEY + 63) / 64;
    const float* CK = F.P->in[IN_CK] + (size_t)b * LCACHE * W_A + h * 256; const float* CV = F.P->in[IN_CV] + (size_t)b * LCACHE * W_A + h * 256;
    const bf16_t* Kn = (const bf16_t*)(F.ws + WS_K) + (size_t)(ROW_S0 + b * 32) * W_A + h * 256; const bf16_t* Vn = (const bf16_t*)(F.ws + WS_V) + (size_t)(ROW_S0 + b * 32) * W_A + h * 256;
    __syncthreads();
    for (int t = 0; t < NT; ++t) {
        int tid = F.tid; OPAQUE(tid); const int lane = tid & 63, r32 = lane & 31;
        const int qpos = PAST_LEN + r32;
        const int key = tid >> 3, j = t * 64 + key, g8 = tid & 7;
#pragma unroll
        for (int kv = 0; kv < 2; ++kv) {
#pragma unroll
            for (int q4 = 0; q4 < 4; ++q4) { const int col = g8 * 32 + q4 * 8; u32x4 wv = {0u, 0u, 0u, 0u};
                if (j < LCACHE) { const float* sp = (kv ? CV : CK) + (size_t)j * W_A + col; const f32x4 a = *(const f32x4*)sp, bq = *(const f32x4*)(sp + 4);
                    wv.x = cvtpk(a[0], a[1]); wv.y = cvtpk(a[2], a[3]); wv.z = cvtpk(bq[0], bq[1]); wv.w = cvtpk(bq[2], bq[3]); }
                else if (j < NKEY) wv = *(const u32x4*)((kv ? Vn : Kn) + (size_t)(j - LCACHE) * W_A + col);
                if (kv == 0) { const int cc = col >> 7, chk = (col & 127) >> 3; *(LAS u32x4*)(F.lds + AT_K + cc * 16384 + key * 256 + ((chk ^ (key & 7)) << 4)) = wv; }
                else { const int kk = (key & ~0xC) | ((key & 4) << 1) | ((key & 8) >> 1); *(LAS u32x4*)(F.lds + AT_V + ((kk >> 3) * 8 + (col >> 5)) * 512 + ((kk & 7) * 32 + (col & 31)) * 2) = wv; } }
        }
        WAIT_VL0(); __syncthreads();
        if (act) { const int kpos0 = t * 64 - N_META; const int nv = NKEY - t * 64;
            attn_tile(A, F.lds + AT_K + c * 16384, F.lds + AT_V, tbl, wsf, lane, kpos0 - qpos + TB_OFF, 0.f, nv < 64 ? nv : 64); }
        WAIT_VL0(); __syncthreads();
    }
    attn_epilogue(F, A, h, ROW_S0 + b * 32, act, lam, false);
}
template <int MIXM, int QB = 0> DI void p4_mixer(Frame& F) {
    constexpr int NAP = NH_A * (SEQ / 128), NAS = DEC_BATCH * NH_A;
    const float lam = diff_lambda(F);
    if (MIXM & 1) { for (int u = F.vcu; u < N_SCAN_P; u += F.G) scan_unit(F, 0, u); }
#define DEQ(qi, uvar) do { __syncthreads(); if (F.tid == 0) F.MISC[16] = __hip_atomic_fetch_add(F.ctl + CW_QUEUE + 64 * (qi), 1u, __ATOMIC_RELAXED, __HIP_MEMORY_SCOPE_AGENT); __syncthreads(); uvar = (int)F.MISC[16]; uvar = __builtin_amdgcn_readfirstlane(uvar); } while (0)
    if (MIXM & 2) {
        const int h0 = (int)(xb_xcc_id() % (unsigned)NH_A);
        for (int hs = 0; hs < NH_A; ++hs) { const int hh = (h0 + hs) % NH_A;
            for (;;) { int a; DEQ(QB + 8 + hh, a); if (a >= SEQ / 128) break; attn_prompt_unit(F, hh, (SEQ / 128 - 1) - a, lam); } }
    }
    if (MIXM & 4) { for (;;) { int a; DEQ(QB + 1, a); if (a >= NAS) break; attn_sample_unit(F, a / NH_A, a % NH_A, lam); } }
    if (MIXM & 1) { for (;;) { int a; DEQ(QB + 2, a); if (a >= N_SCAN_S) break; scan_unit(F, 1, a); } }
#undef DEQ
}

constexpr int N_PHASES = 7;
#ifndef MK_N_LAUNCHES
#define MK_N_LAUNCHES 1
#endif
__global__ void __launch_bounds__(512, 2) hymba_fwd(Params p) {
#ifdef EMU
    unsigned char* lds_raw = emu::cur->block->lds;
#else
    extern __shared__ __attribute__((aligned(16))) unsigned char lds_raw[];
#endif
    Frame F;
    F.lds = (LAS unsigned char*)lds_raw; F.MISC = (volatile LAS unsigned*)(F.lds + MISC_OFF);
    F.wave = __builtin_amdgcn_readfirstlane((int)threadIdx.x >> 6); F.lane = lane_id(); F.tid = F.wave * 64 + F.lane;
    F.G = gridDim.x; { const int bx = blockIdx.x; F.vcu = (F.G % 8 == 0) ? (bx % 8) * (F.G / 8) + bx / 8 : bx; }
    F.P = &p; F.out = p.out; F.ws = p.ws; F.ctl = (unsigned*)(p.ws + WS_CTL);
    for (int u = F.tid; u < (LDS_BYTES - MISC_OFF) / 4; u += 512) ((LAS unsigned*)(F.lds + MISC_OFF))[u] = 0u;
    __syncthreads();
    const bool use_bar = (p.ph_hi - p.ph_lo) > 1;
    XcdBarrier bar; bar.bar = F.ctl + CW_BAR + p.li * XCD_BAR_WORDS; bar.x = 0; bar.st = nullptr; bar.wave = F.wave;
    if (use_bar) bar = xcd_barrier_post(F.ctl + CW_BAR + p.li * XCD_BAR_WORDS, F.MISC + 8, F.wave);
    const int lo = p.ph_lo, hi = p.ph_hi;
#ifdef ONLY_PHASE
#define IN(k) ((k) == ONLY_PHASE && lo <= (k) && (k) < hi)
#else
#define IN(k) (lo <= (k) && (k) < hi)
#endif
#ifdef EMU
#define PHMARK(k) ((void)0)
#else
#define PHMARK(k) asm volatile("; PHASE_MARK " #k ::: "memory")
#endif
#define SEAM(k) do { PHMARK(k); if (IN(k) && IN((k) + 1)) xcd_barrier(bar); F.lane = lane_id(); F.tid = F.wave * 64 + F.lane; } while (0)
#ifndef REPEAT_MASK
#define REPEAT_MASK 0
#endif
#define RBIT(k) ((((REPEAT_MASK) >> (k)) & 1) != 0)
#define P1BODY() do { p1a_skinny(F); __syncthreads(); pg8::Gemm g{(const bf16_t*)(F.ws + WS_XN), (const bf16_t*)(F.ws + WS_WINT), M_MAIN, N_MAIN, D_MODEL}; pg8::AlignedOrder S; S.init(M_MAIN, N_MAIN, F.G, (int)blockIdx.x); \
        EpiIn E{F.out, F.ws}; pg8::gemm_phase<EpiIn, pg8::AlignedOrder, PG8_ALIGN, PG8_SP2>(F.lds, g, S, E, F.wave); } while (0)
#define P5BODY() do { pg8::Gemm g{(const bf16_t*)(F.ws + WS_YCAT), (const bf16_t*)(F.ws + WS_WOUTT), R, D_MODEL, D_MODEL}; pg8::StaticOrder S; S.init(R, D_MODEL, F.G, (int)blockIdx.x); \
        EpiOut E{F.ws}; pg8::gemm_phase<EpiOut, pg8::StaticOrder, PG8_ALIGN, PG8_SP2>(F.lds, g, S, E, F.wave); } while (0)
    if (IN(0)) { p0_prologue(F); if constexpr (RBIT(0)) { __syncthreads(); p0_prologue(F); } } SEAM(0);
    if (IN(1)) { P1BODY(); if constexpr (RBIT(1)) { P1BODY(); } } SEAM(1);
    if (IN(2)) { p2_conv(F); if constexpr (RBIT(2)) { p2_conv(F); } } SEAM(2);
    if (IN(3)) { p3_prep(F); if constexpr (RBIT(3)) { p3_prep(F); } } SEAM(3);
#ifndef MIX_MAIN
#define MIX_MAIN 7
#endif
#ifndef MIX_REP
#define MIX_REP 7
#endif
    if (IN(4)) { p4_mixer<MIX_MAIN>(F); if constexpr (RBIT(4)) { __syncthreads(); p4_mixer<MIX_REP, 32>(F); } } SEAM(4);
    if (IN(5)) { P5BODY(); if constexpr (RBIT(5)) { P5BODY(); } } SEAM(5);
    if (IN(6)) { p5_final(F); if constexpr (RBIT(6)) { p5_final(F); } }
#undef IN
#undef SEAM
}

extern "C" void kernel_launch(void* const* d_in, const int* in_sizes, int n_in, void* d_out, int out_size, void* d_ws, size_t ws_size, hipStream_t stream) {
    static int grid = 0;
    if (grid == 0) {
        if (n_in != 21 || (size_t)out_size != O_END || ws_size < WS_END) { fprintf(stderr, "kernel_launch: shape/workspace mismatch (n_in %d out %d ws %zu need %zu)\n", n_in, out_size, ws_size, (size_t)WS_END); grid = -1; return; }
        int dev = 0, cus = 0;
        if (hipGetDevice(&dev) != hipSuccess || hipDeviceGetAttribute(&cus, hipDeviceAttributeMultiprocessorCount, dev) != hipSuccess) { grid = -1; return; }
        if (hipFuncSetAttribute((const void*)hymba_fwd, hipFuncAttributeMaxDynamicSharedMemorySize, LDS_BYTES) != hipSuccess) { fprintf(stderr, "kernel_launch: hipFuncSetAttribute failed\n"); grid = -1; return; }
        int per_cu = 0; (void)hipOccupancyMaxActiveBlocksPerMultiprocessor(&per_cu, (const void*)hymba_fwd, 512, LDS_BYTES); (void)hipGetLastError();
        grid = cus;
    }
    if (grid < 0) return;
    (void)hipMemsetAsync((char*)d_ws + WS_CTL, 0, CTL_ZERO_BYTES, stream);
    Params p{};
    for (int i = 0; i < 21; ++i) p.in[i] = (const float*)d_in[i];
    p.out = (float*)d_out; p.ws = (unsigned char*)d_ws; p.pad = 0;
#if MK_N_LAUNCHES == 1
    p.ph_lo = 0; p.ph_hi = N_PHASES; p.li = 0;
    hipLaunchKernelGGL(hymba_fwd, dim3(grid), dim3(512), LDS_BYTES, stream, p);
#else
    for (int k = 0; k < N_PHASES; ++k) { p.ph_lo = k; p.ph_hi = k + 1; p.li = 0; hipLaunchKernelGGL(hymba_fwd, dim3(grid), dim3(512), LDS_BYTES, stream, p); }
#endif
}
```

```cpp
#ifndef EMU
#include <hip/hip_runtime.h>
#endif
#include <cstdio>
#include <cstdint>

#define DI __device__ __forceinline__
#ifdef EMU
#define LAS
#define GAS
#define WAIT_V(n) emu::wave_op(emu::op_nop)
#define WAIT_L(n) emu::wave_op(emu::op_nop)
#define WAIT_VL0() emu::wave_op(emu::op_nop)
#define WAIT_V1(n) ((void)0)
#define CFENCE() ((void)0)
#define PINV(x) ((void)0)
#define OPAQUE(x) ((void)0)
#define PIN4(a, b, c, d) ((void)0)
#define PIN2(a, b) ((void)0)
#else
#define LAS __attribute__((address_space(3)))
#define GAS __attribute__((address_space(1)))
#define WAIT_V(n) asm volatile("s_waitcnt vmcnt(" #n ")" ::: "memory")
#define WAIT_L(n) asm volatile("s_waitcnt lgkmcnt(" #n ")" ::: "memory")
#define WAIT_VL0() asm volatile("s_waitcnt vmcnt(0) lgkmcnt(0)" ::: "memory")
#define WAIT_V1(n) asm volatile("s_waitcnt vmcnt(" #n ")" ::: "memory")
#define CFENCE() asm volatile("" ::: "memory")
#define OPAQUE(x) asm volatile("" : "+v"(x))
#define PIN4(a, b, c, d) asm volatile("" : "+v"(a), "+v"(b), "+v"(c), "+v"(d) :: "memory")
#define PIN2(a, b) asm volatile("" : "+v"(a), "+v"(b) :: "memory")
#define PINV(x) asm volatile("" : "+v"(x) :: "memory")
#endif
#define SBAR() __builtin_amdgcn_sched_barrier(0)

#if defined(MIDCFG)
constexpr int D_MODEL = 512, SEQ = 2048, DEC_BATCH = 2, PAST_LEN = 1024;
#elif defined(SMALLCFG)
constexpr int D_MODEL = 512, SEQ = 512, DEC_BATCH = 2, PAST_LEN = 128;
#else
constexpr int D_MODEL = 4096, SEQ = 16384, DEC_BATCH = 32, PAST_LEN = 1024;
#endif
constexpr int DEC_SEQ = 32, N_META = 16, CHUNK = 64;
constexpr int W_A = D_MODEL / 2, NH_A = W_A / 256, W_B = D_MODEL / 2, NH_B = W_B / 128, C3 = 3 * W_B;
constexpr int IN_COLS = 4 * W_A + 4 * W_B + 2 * NH_B;
constexpr int NS = DEC_BATCH * DEC_SEQ;
constexpr int ROW_S0 = SEQ, ROW_M0 = SEQ + NS, NROWS = ROW_M0 + N_META;
constexpr int R = (NROWS + 255) / 256 * 256;
constexpr int NP_IN = (IN_COLS + 255) / 256 * 256;
constexpr int LCACHE = N_META + PAST_LEN;
constexpr int TA = W_A / 256, TB = W_B / 256;
constexpr int NCH_P = SEQ / CHUNK + 1;
constexpr int NSC = NCH_P + DEC_BATCH;
constexpr float EPS = 1e-6f;
constexpr float LOG2E = 1.4426950408889634f;
constexpr float C2Q = 0.08838834764831845f * LOG2E;
constexpr float LAM_INIT = 0.2f;
constexpr size_t O_YP = 0, O_YS = O_YP + (size_t)SEQ * D_MODEL, O_KP = O_YS + (size_t)NS * D_MODEL, O_VP = O_KP + (size_t)(N_META + SEQ) * W_A,
                 O_SP = O_VP + (size_t)(N_META + SEQ) * W_A, O_CP = O_SP + (size_t)NH_B * 16384, O_KS = O_CP + (size_t)3 * C3, O_VS = O_KS + (size_t)NS * W_A,
                 O_SS = O_VS + (size_t)NS * W_A, O_CS = O_SS + (size_t)DEC_BATCH * NH_B * 16384, O_END = O_CS + (size_t)DEC_BATCH * 3 * C3;

typedef unsigned short bf16_t;
typedef short bf16x8 __attribute__((ext_vector_type(8)));
typedef short s16x4 __attribute__((ext_vector_type(4)));
typedef float f32x4 __attribute__((ext_vector_type(4)));
typedef float f32x2 __attribute__((ext_vector_type(2)));
typedef float f32x16 __attribute__((ext_vector_type(16)));
typedef unsigned u32x4 __attribute__((ext_vector_type(4)));
typedef unsigned u32x2 __attribute__((ext_vector_type(2)));

constexpr size_t al256(size_t x) { return (x + 255) / 256 * 256; }
constexpr size_t WS_CTL = 0, CTL_ZERO_BYTES = 1u << 20;
constexpr size_t SZ_WINT = (size_t)NP_IN * D_MODEL * 2, SZ_XN = (size_t)R * D_MODEL * 2, SZ_RA = (size_t)R * W_A * 2, SZ_QKVB = (size_t)R * C3 * 2;
constexpr int PKG_BYTES = 73728;
constexpr size_t SZ_PKG = (size_t)NSC * NH_B * PKG_BYTES;
constexpr size_t WS_WINT = al256(WS_CTL + CTL_ZERO_BYTES);
constexpr size_t WS_XN = WS_WINT + SZ_WINT;
constexpr size_t WS_QKVN = WS_WINT;
constexpr size_t WS_YCAT = WS_WINT;
constexpr size_t WS_WOUTT = al256(WS_XN + SZ_XN);
constexpr size_t WS_Q = al256(WS_WOUTT + (size_t)D_MODEL * D_MODEL * 2), WS_K = WS_Q + SZ_RA, WS_V = WS_K + SZ_RA, WS_GA = WS_V + SZ_RA, WS_GB = WS_GA + SZ_RA;
constexpr size_t WS_QKVB = al256(WS_GB + SZ_RA);
constexpr size_t WS_PKG = WS_QKVB, WS_Y = WS_QKVB;
constexpr size_t SZ_BIG = SZ_PKG > SZ_QKVB ? SZ_PKG : SZ_QKVB;
constexpr size_t WS_AB = al256(WS_QKVB + SZ_BIG);
constexpr size_t WS_BG = al256(WS_AB + (size_t)R * 32 * 4);
constexpr size_t WS_SS = al256(WS_BG + (size_t)R * NH_B * 8);
constexpr int NTB = 1280, TB_OFF = 1216;
constexpr size_t WS_TB = al256(WS_SS + (size_t)R * 64 * 4);
constexpr size_t WS_DEC = al256(WS_TB + (size_t)NH_A * NTB * 4);
constexpr size_t WS_END = al256(WS_DEC + (size_t)NSC * NH_B * 4);
static_assert(SZ_WINT + SZ_XN >= SZ_QKVB && SZ_WINT + SZ_XN >= SZ_XN, "overlay sizes");
static_assert((size_t)R * D_MODEL * 2 <= SZ_BIG, "Y fits the PKG region");

constexpr int CW_TMO = 0, CW_BAR = 4096, CW_QUEUE = 8192;
constexpr int RING_BYTES = 147456;
constexpr int MISC_OFF = RING_BYTES, LDS_BYTES = RING_BYTES + 512;

DI unsigned f2bf(float f) { unsigned u = __builtin_bit_cast(unsigned, f); return (u + 0x7fffu + ((u >> 16) & 1u)) >> 16; }
DI float bf2f(unsigned short b) { return __builtin_bit_cast(float, ((unsigned)b) << 16); }
#ifdef EMU
DI unsigned cvtpk(float lo, float hi) { return f2bf(lo) | (f2bf(hi) << 16); }
DI s16x4 tr16(const LAS void* p) { return emu_tr16((const void*)p); }
#else
typedef __bf16 bf16x2_t __attribute__((ext_vector_type(2)));
typedef short v4i16_t __attribute__((ext_vector_type(4)));
DI unsigned cvtpk(float lo, float hi) { f32x2 v = {lo, hi}; bf16x2_t b = __builtin_convertvector(v, bf16x2_t); return __builtin_bit_cast(unsigned, b); }
DI s16x4 tr16(const LAS void* p) { return __builtin_bit_cast(s16x4, __builtin_amdgcn_ds_read_tr16_b64_v4i16((LAS v4i16_t*)p)); }
#endif
DI int crow_c(int r, int h) { return (r & 3) + 8 * (r >> 2) + 4 * h; }
DI float lo_bf(unsigned w) { return __builtin_bit_cast(float, w << 16); }
DI float hi_bf(unsigned w) { return __builtin_bit_cast(float, w & 0xffff0000u); }
DI float fast_exp2(float x) { return __builtin_amdgcn_exp2f(x); }
DI float fast_rcp(float x) { return __builtin_amdgcn_rcpf(x); }
DI float silu_f(float x) { return x * fast_rcp(1.0f + fast_exp2(-x * LOG2E)); }
#ifdef EMU
DI int lane_id() { return emu::cur->lane; }
#else
DI int lane_id() { return (int)__builtin_amdgcn_mbcnt_hi(~0u, __builtin_amdgcn_mbcnt_lo(~0u, 0u)); }
#endif
#ifdef EMU
DI float shfl_xor_l(float v, int k, int lane) { (void)lane; return __shfl_xor(v, k); }
#else
DI float shfl_xor_l(float v, int k, int lane) { return __builtin_bit_cast(float, __builtin_amdgcn_ds_bpermute((lane ^ k) << 2, __builtin_bit_cast(int, v))); }
#endif
DI float wave_sum(float v) {
#pragma unroll
    for (int o = 1; o < 64; o <<= 1) v += __shfl_xor(v, o);
    return v;
}

#ifdef EMU
typedef const unsigned char* lds_a;
#define LDS_A(p) ((const unsigned char*)(p))
#define TRRD(dst, base, off) dst = tr16((base) + (off))
#define LDRD128(dst, base, off) dst = *(const bf16x8*)((base) + (off))
#define LWAIT8(a, b, c, d, e, f, g, h) WAIT_L(0)
#define LWAIT4(a, b, c, d) WAIT_L(0)
DI void glds16(const void* g, const unsigned char* l) { emu_glds16(g, (void*)l); }
template <class T> DI void asm_lwait2(T&, T&) { WAIT_L(0); }
#else
typedef unsigned lds_a;
#define LDS_A(p) ((unsigned)(size_t)(p))
#define TRRD(dst, base, off) asm volatile("ds_read_b64_tr_b16 %0, %1 offset:%2" : "=&v"(dst) : "v"(base), "i"(off) : "memory")
#define LDRD128(dst, base, off) asm volatile("ds_read_b128 %0, %1 offset:%2" : "=&v"(dst) : "v"(base), "i"(off) : "memory")
#define LWAIT8(a, b, c, d, e, f, g, h) do { asm volatile("s_waitcnt lgkmcnt(0)" : "+v"(a), "+v"(b), "+v"(c), "+v"(d), "+v"(e), "+v"(f), "+v"(g), "+v"(h) :: "memory"); SBAR(); } while (0)
#define LWAIT4(a, b, c, d) do { asm volatile("s_waitcnt lgkmcnt(0)" : "+v"(a), "+v"(b), "+v"(c), "+v"(d) :: "memory"); SBAR(); } while (0)
template <class T> DI void asm_lwait2(T& a, T& b) { asm volatile("s_waitcnt lgkmcnt(0)" : "+v"(a), "+v"(b) :: "memory"); SBAR(); }
DI void glds16(const void* gsrc, unsigned lds_dst) { unsigned keep;
    asm volatile("s_mov_b32 %0, m0\n\ts_mov_b32 m0, %2\n\ts_nop 0\n\tglobal_load_lds_dwordx4 %1, off\n\ts_mov_b32 m0, %0" : "=&s"(keep) : "v"(gsrc), "s"(lds_dst) : "memory"); }
#endif

#ifdef EMU
DI float max3f(float a, float b, float c) { return fmaxf(fmaxf(a, b), c); }
DI float max2f(float a, float b) { return fmaxf(a, b); }
DI float fadd_s(float a, float b) { return a + b; }
#define MFMA_PAD2(a, b) ((void)0)
#define VALU_PAD(x) ((void)0)
#define TRANS_PAD2(a, b) ((void)0)
#else
DI float max3f(float a, float b, float c) { float r; asm("v_max3_f32 %0, %1, %2, %3" : "=v"(r) : "v"(a), "v"(b), "v"(c)); return r; }
DI float max2f(float a, float b) { float r; asm("v_max_f32_e32 %0, %1, %2" : "=v"(r) : "v"(a), "v"(b)); return r; }
DI float fadd_s(float a, float b) { float r; asm("v_add_f32_e32 %0, %1, %2" : "=v"(r) : "v"(a), "v"(b)); return r; }
#define VALU_PAD(x) asm volatile("s_nop 1" : "+v"(x))
#define TRANS_PAD2(a, b) asm volatile("s_nop 3" : "+v"(a), "+v"(b))
#define MFMA_PAD2(a, b) asm volatile("s_nop 15\n\ts_nop 7" : "+v"(a), "+v"(b))
#endif
#define RLX_AGENT __ATOMIC_RELAXED, __HIP_MEMORY_SCOPE_AGENT

#define XB_TMO      128
#define XB_XCNT(j)  (256  + 64 * (j))
#define XB_XSUB(j)  (1280 + 64 * (j))
#define XB_XGEN(j)  (2304 + 64 * (j))
#define XB_TOP      3328
#define XB_TOPGEN   3392
#define XCD_BAR_WORDS 3456
#define XB_SPIN_CAP (1u << 18)
DI unsigned xb_ld(unsigned* p)              { return __hip_atomic_load(p, __ATOMIC_RELAXED, __HIP_MEMORY_SCOPE_AGENT); }
DI unsigned xb_add(unsigned* p, unsigned v) { return __hip_atomic_fetch_add(p, v, __ATOMIC_RELAXED, __HIP_MEMORY_SCOPE_AGENT); }
DI unsigned xb_xcc_id() { return (unsigned)__builtin_amdgcn_s_getreg((3 << 11) | 20) & 0xFu; }
#define XB_SPIN(cond, bar) do { unsigned _sp = 0; while (cond) { __builtin_amdgcn_s_sleep(1); \
    if ((++_sp & 255u) == 0u) { if (xb_ld(&(bar)[XB_TMO])) break; if (_sp > XB_SPIN_CAP) { atomicAdd(&(bar)[XB_TMO], 1u); break; } } } } while (0)
struct XcdBarrier { unsigned* bar; unsigned x; volatile LAS unsigned* st; int wave; };
DI XcdBarrier xcd_barrier_post(unsigned* bar, volatile LAS unsigned* st, int wave) {
    XcdBarrier b; b.bar = bar; b.x = xb_xcc_id(); b.st = st; b.wave = wave;
    if (wave == 0 && lane_id() == 0) (void)xb_add(&bar[XB_XCNT(b.x)], 1u);
    return b;
}
DI void xcd_barrier_complete(unsigned* bar, unsigned x, unsigned& nloc, unsigned& nx) {
    const unsigned G = gridDim.x * gridDim.y * gridDim.z;
    unsigned sum, cnt, mine, sp = 0u;
    for (;;) {
        sum = 0u; cnt = 0u; mine = 0u;
#pragma unroll
        for (unsigned j = 0; j < 16; ++j) { const unsigned c = xb_ld(&bar[XB_XCNT(j)]); sum += c; cnt += (c > 0u) ? 1u : 0u; mine = (j == x) ? c : mine; }
        if (sum == G) break;
        __builtin_amdgcn_s_sleep(1);
        if ((++sp & 255u) == 0u) { if (xb_ld(&bar[XB_TMO])) break; if (sp > XB_SPIN_CAP) { atomicAdd(&bar[XB_TMO], 1u); break; } }
    }
    nloc = mine > 0u ? mine : 1u; nx = cnt > 0u ? cnt : 1u;
}
DI void xcd_barrier(const XcdBarrier& b) {
    WAIT_V(0);
    __syncthreads();
    if (b.wave == 0 && lane_id() == 0) {
        unsigned* bar = b.bar;
        __builtin_amdgcn_s_waitcnt(0);
        unsigned nloc = b.st[0], nx = b.st[1];
        if (nloc == 0u) { xcd_barrier_complete(bar, b.x, nloc, nx); b.st[0] = nloc; b.st[1] = nx; }
        const unsigned old = xb_add(&bar[XB_XSUB(b.x)], 1u);
        const unsigned gen = old / nloc;
        if (old + 1u == (gen + 1u) * nloc) {
            __builtin_amdgcn_fence(__ATOMIC_RELEASE, "agent");
            WAIT_V1(0);
            const unsigned og = xb_add(&bar[XB_TOP], 1u);
            const unsigned tg = og / nx;
            if (og + 1u == (tg + 1u) * nx) xb_add(&bar[XB_TOPGEN], 1u);
            else XB_SPIN(xb_ld(&bar[XB_TOPGEN]) == tg, bar);
            __builtin_amdgcn_fence(__ATOMIC_ACQUIRE, "agent");
            xb_add(&bar[XB_XGEN(b.x)], 1u);
            WAIT_V1(0);
        } else {
            XB_SPIN(xb_ld(&bar[XB_XGEN(b.x)]) == gen, bar);
            __builtin_amdgcn_fence(__ATOMIC_ACQUIRE, "agent");
            WAIT_V1(0);
        }
    }
    __syncthreads();
}

namespace pg8 {
constexpr int BM = 256, BK = 64, HALF = 128, HTB = HALF * BK * 2, STAGE_BYTES = 8 * HTB, NXCD = 8, WGM = 8;
DI int lds_byte(int r, int c) { const int st = (r >> 4) * 2 + (c >> 5), rr = r & 15, cc = c & 31, ob = rr * 64 + cc * 2; return st * 1024 + (ob ^ (((ob >> 9) & 1) << 5)); }
DI void stage_rc(int b, int& R_, int& C_) { const int st = b / 1024, sb = b % 1024, swz = sb ^ (((sb >> 9) & 1) << 5); R_ = (st >> 1) * 16 + swz / 64; C_ = (st & 1) * 32 + (swz % 64) / 2; }
DI int perm32(int rho) { const int n = rho >> 4, i = rho & 15; return 8 * (i >> 2) + 4 * n + (i & 3); }
struct Unit { int pm, pn; };
struct Gemm { const bf16_t* A; const bf16_t* Bt; int M, N, K; };
struct StaticOrder {
    int nM, nN, nwg, G, c;
    DI void init(int M, int N, int G_, int c_) { nM = M / BM; nN = N / BM; nwg = nM * nN; G = G_; c = c_; }
    DI bool next(int i, Unit& u) const {
        const long L = (long)i * G + c; if (L >= nwg) return false;
        int wgid = (int)L; { const int q = nwg / NXCD, r = nwg % NXCD, xcd = wgid % NXCD, off = wgid / NXCD; wgid = (xcd < r ? xcd * (q + 1) : r * (q + 1) + (xcd - r) * q) + off; }
        const int nig = WGM * nN, gid = wgid / nig, fm = gid * WGM, gsz = (nM - fm) < WGM ? (nM - fm) : WGM;
        u.pm = fm + ((wgid % nig) % gsz); u.pn = (wgid % nig) / gsz; return true;
    }
    DI void a_ready(const Unit&) const {}
    DI void done(const Unit&) const {}
};
struct AlignedOrder {
    StaticOrder so; bool al;
    DI void init(int M, int N, int G_, int c_) { so.init(M, N, G_, c_); al = (G_ == 256 && so.nM == 68 && so.nN == 64); }
    DI bool next(int i, Unit& u) const {
        if (!al) return so.next(i, u);
        if (i > 16) return false;
        const int xcd = so.c & 7, slot = so.c >> 3;
        if (i < 16) { u.pm = 8 * xcd + (slot & 7); u.pn = 4 * i + (slot >> 3); } else { u.pm = 64 + (slot & 3); u.pn = 8 * xcd + (slot >> 2); }
        return true;
    }
    DI void a_ready(const Unit&) const {}
    DI void done(const Unit&) const {}
};
template <class Epi, class Sched, bool ALIGN_EPI = false, bool SP2 = false>
DI void gemm_phase(LAS unsigned char* lds, const Gemm g, const Sched& S, const Epi& E, int wid) {
    const int lane = lane_id(), tid = wid * 64 + lane, wr = wid >> 2, wc = wid & 3, fr = lane & 15, fq = lane >> 4;
    const int K = g.K, nt = K / BK;
    unsigned voffA[2], voffB[2];
#pragma unroll
    for (int i = 0; i < 2; ++i) { int R_, C_; stage_rc(tid * 16 + i * 8192, R_, C_); const int Rb = Epi::PERM ? ((R_ & ~31) + perm32(R_ & 31)) : R_;
        voffA[i] = (unsigned)(R_ * K + C_) * 2u; voffB[i] = (unsigned)(Rb * K + C_) * 2u; }
    const size_t kstep = (size_t)(BK * 2);
    const size_t hstep = (size_t)HALF * K * 2;
    const size_t tstep = 2 * hstep;
    const unsigned ldsw = (unsigned)wid * 1024u;
    const int aoff = lds_byte(wr * 64 + fr, fq * 8), boff = lds_byte(wc * 32 + fr, fq * 8);
#define PG8_SA(b, h) (((b) * 2 + (h)) * HTB)
#define PG8_SB(b, h) ((4 + (b) * 2 + (h)) * HTB)
#define PG8_STAGE(bufoff, gbase, voff) do { _Pragma("unroll") for (int _i = 0; _i < 2; ++_i) \
        __builtin_amdgcn_global_load_lds((const unsigned*)((const char*)(gbase) + (voff)[_i]), (LAS unsigned*)(lds + (bufoff) + ldsw + _i * 8192), 16, 0, 0); } while (0)
#define PG8_LDA(dst, b, h) do { _Pragma("unroll") for (int m = 0; m < 4; ++m) _Pragma("unroll") for (int k = 0; k < 2; ++k) dst[m][k] = *(const LAS bf16x8*)(lds + PG8_SA(b, h) + aoff + m * 2048 + k * 1024); } while (0)
#define PG8_LDB(dst, b, h) do { _Pragma("unroll") for (int n = 0; n < 2; ++n) _Pragma("unroll") for (int k = 0; k < 2; ++k) dst[n][k] = *(const LAS bf16x8*)(lds + PG8_SB(b, h) + boff + n * 2048 + k * 1024); } while (0)
#define PG8_MMA(ai, bj, At, Bt) do { __builtin_amdgcn_s_setprio(1); _Pragma("unroll") for (int m = 0; m < 4; ++m) _Pragma("unroll") for (int n = 0; n < 2; ++n) _Pragma("unroll") for (int k = 0; k < 2; ++k) \
        acc[ai][bj][m][n] = __builtin_amdgcn_mfma_f32_16x16x32_bf16(Bt[n][k], At[m][k], acc[ai][bj][m][n], 0, 0, 0); __builtin_amdgcn_s_setprio(0); } while (0)
#define PG8_WAIT_V(n) WAIT_V(n)
#define PG8_WAIT_L(n) WAIT_L(n)
#define PG8_BAR __builtin_amdgcn_s_barrier()
#define PG8_SCHED __builtin_amdgcn_sched_barrier(0)
    Unit cur, nxt; int ui = 0;
    if (!S.next(0, cur)) return;
    f32x4 acc[2][2][4][2];
#pragma unroll
    for (int a = 0; a < 2; ++a)
#pragma unroll
        for (int b = 0; b < 2; ++b)
#pragma unroll
            for (int m = 0; m < 4; ++m)
#pragma unroll
                for (int n = 0; n < 2; ++n) acc[a][b][m][n] = (f32x4){0.f, 0.f, 0.f, 0.f};
    bf16x8 At[4][2], B0[2][2], B1[2][2];
    const char* cA = (const char*)g.A + (size_t)cur.pm * tstep; const char* cB = (const char*)g.Bt + (size_t)cur.pn * tstep;
    S.a_ready(cur);
    if constexpr (SP2) {
        PG8_STAGE(PG8_SB(0, 0), cB, voffB); PG8_STAGE(PG8_SB(0, 1), cB + hstep, voffB); PG8_STAGE(PG8_SA(0, 0), cA, voffA); PG8_STAGE(PG8_SA(0, 1), cA + hstep, voffA);
        if (wr == 1) PG8_BAR;
        PG8_WAIT_V(2); PG8_BAR;
        PG8_STAGE(PG8_SB(1, 0), cB + kstep, voffB); PG8_STAGE(PG8_SA(1, 0), cA + kstep, voffA); PG8_STAGE(PG8_SB(1, 1), cB + hstep + kstep, voffB);
        PG8_WAIT_V(6); PG8_BAR;
    } else {
        PG8_STAGE(PG8_SB(0, 0), cB, voffB); PG8_STAGE(PG8_SA(0, 0), cA, voffA); PG8_STAGE(PG8_SB(0, 1), cB + hstep, voffB); PG8_STAGE(PG8_SA(0, 1), cA + hstep, voffA);
        if (wr == 1) PG8_BAR;
        PG8_WAIT_V(4); PG8_BAR;
        PG8_STAGE(PG8_SB(1, 0), cB + kstep, voffB); PG8_STAGE(PG8_SA(1, 0), cA + kstep, voffA); PG8_STAGE(PG8_SB(1, 1), cB + hstep + kstep, voffB);
        PG8_WAIT_V(6); PG8_BAR;
    }
    for (;;) {
        const bool has_next = S.next(ui + 1, nxt);
        const char* nA = has_next ? (const char*)g.A + (size_t)nxt.pm * tstep : cA; const char* nB = has_next ? (const char*)g.Bt + (size_t)nxt.pn * tstep : cB;
        for (int t = 0; t < nt; t += 2) {
            const bool last = (t == nt - 2);
            const char* a1 = cA + (size_t)(t + 1) * kstep;
            const char* a2 = last ? nA : cA + (size_t)(t + 2) * kstep; const char* b2 = last ? nB : cB + (size_t)(t + 2) * kstep;
            const char* a3 = a2 + kstep; const char* b3 = b2 + kstep;
            if (last && has_next) S.a_ready(nxt);
            if constexpr (SP2) {
            PG8_LDB(B0, 0, 0); PG8_LDB(B1, 0, 1); PG8_SCHED; PG8_LDA(At, 0, 0); PG8_STAGE(PG8_SA(1, 1), a1 + hstep, voffA);
            PG8_WAIT_V(8); PG8_WAIT_L(0); PG8_BAR; PG8_MMA(0, 0, At, B0); PG8_MMA(0, 1, At, B1); PG8_BAR; PG8_SCHED;
            PG8_LDA(At, 0, 1); PG8_STAGE(PG8_SB(0, 0), b2, voffB); PG8_STAGE(PG8_SB(0, 1), b2 + hstep, voffB); PG8_STAGE(PG8_SA(0, 0), a2, voffA);
            PG8_WAIT_V(8); PG8_WAIT_L(0); PG8_BAR; PG8_MMA(1, 0, At, B0); PG8_MMA(1, 1, At, B1); PG8_BAR; PG8_SCHED;
            PG8_LDB(B0, 1, 0); PG8_LDB(B1, 1, 1); PG8_SCHED; PG8_LDA(At, 1, 0); PG8_STAGE(PG8_SA(0, 1), a2 + hstep, voffA);
            PG8_WAIT_V(8); PG8_WAIT_L(0); PG8_BAR; PG8_MMA(0, 0, At, B0); PG8_MMA(0, 1, At, B1); PG8_BAR; PG8_SCHED;
            PG8_LDA(At, 1, 1); PG8_STAGE(PG8_SB(1, 0), b3, voffB); PG8_STAGE(PG8_SB(1, 1), b3 + hstep, voffB); PG8_STAGE(PG8_SA(1, 0), a3, voffA);
            PG8_WAIT_V(8); PG8_WAIT_L(0); PG8_BAR; PG8_MMA(1, 0, At, B0); PG8_MMA(1, 1, At, B1); PG8_BAR; PG8_SCHED;
            } else {
            PG8_LDB(B0, 0, 0); PG8_SCHED; PG8_LDA(At, 0, 0); PG8_STAGE(PG8_SA(1, 1), a1 + hstep, voffA);
            PG8_WAIT_L(8); PG8_BAR; PG8_WAIT_L(0); PG8_MMA(0, 0, At, B0); PG8_BAR; PG8_SCHED;
            PG8_LDB(B1, 0, 1); PG8_STAGE(PG8_SB(0, 0), b2, voffB);
            PG8_BAR; PG8_WAIT_L(0); PG8_MMA(0, 1, At, B1); PG8_BAR;
            PG8_LDA(At, 0, 1); PG8_STAGE(PG8_SA(0, 0), a2, voffA);
            PG8_BAR; PG8_WAIT_L(0); PG8_MMA(1, 0, At, B0); PG8_BAR; PG8_SCHED;
            PG8_STAGE(PG8_SB(0, 1), b2 + hstep, voffB);
            PG8_WAIT_V(6); PG8_BAR; PG8_MMA(1, 1, At, B1); PG8_BAR;
            PG8_LDB(B0, 1, 0); PG8_SCHED; PG8_LDA(At, 1, 0); PG8_STAGE(PG8_SA(0, 1), a2 + hstep, voffA);
            PG8_WAIT_L(8); PG8_BAR; PG8_WAIT_L(0); PG8_MMA(0, 0, At, B0); PG8_BAR; PG8_SCHED;
            PG8_LDB(B1, 1, 1); PG8_STAGE(PG8_SB(1, 0), b3, voffB);
            PG8_BAR; PG8_WAIT_L(0); PG8_MMA(0, 1, At, B1); PG8_BAR;
            PG8_LDA(At, 1, 1); PG8_STAGE(PG8_SA(1, 0), a3, voffA);
            PG8_BAR; PG8_WAIT_L(0); PG8_MMA(1, 0, At, B0); PG8_BAR; PG8_SCHED;
            PG8_STAGE(PG8_SB(1, 1), b3 + hstep, voffB);
            PG8_WAIT_V(6); PG8_BAR; PG8_MMA(1, 1, At, B1); PG8_BAR;
            }
        }
        if constexpr (ALIGN_EPI) { if (wr == 0) PG8_BAR; }
        E(acc, cur, wr, wc, fr, fq); S.done(cur);
        if (!has_next) break;
#pragma unroll
        for (int a = 0; a < 2; ++a)
#pragma unroll
            for (int b = 0; b < 2; ++b)
#pragma unroll
                for (int m = 0; m < 4; ++m)
#pragma unroll
                    for (int n = 0; n < 2; ++n) acc[a][b][m][n] = (f32x4){0.f, 0.f, 0.f, 0.f};
        cur = nxt; cA = nA; cB = nB; ++ui;
        if constexpr (ALIGN_EPI) { if (wr == 1) PG8_BAR; }
    }
    PG8_WAIT_V(0);
    if constexpr (!ALIGN_EPI) { if (wr == 0) PG8_BAR; }
    PG8_BAR;
#undef PG8_SA
#undef PG8_SB
#undef PG8_STAGE
#undef PG8_LDA
#undef PG8_LDB
#undef PG8_MMA
#undef PG8_WAIT_V
#undef PG8_WAIT_L
#undef PG8_BAR
#undef PG8_SCHED
}
}
#ifndef PG8_SP2
#define PG8_SP2 true
#endif
#ifndef PG8_ALIGN
#define PG8_ALIGN true
#endif

struct Params {
    const float* in[21]; float* out; unsigned char* ws; int ph_lo, ph_hi, li, pad;
};
struct Frame {
    LAS unsigned char* lds; volatile LAS unsigned* MISC; unsigned* ctl;
    int tid, lane, wave, vcu, G;
    const Params* P; float* out; unsigned char* ws;
};
enum { IN_XP = 0, IN_XS, IN_CK, IN_CV, IN_SSM, IN_CONVS, IN_META, IN_RELB, IN_PREN, IN_WIN, IN_LQ1, IN_LK1, IN_LQ2, IN_LK2, IN_SUBLN, IN_CONVW, IN_ALOG, IN_DTB, IN_NORMB, IN_WOUT, IN_POSTN };

DI const float* src_row(const Frame& F, int r) {
    if (r < ROW_S0) return F.P->in[IN_XP] + (size_t)r * D_MODEL;
    if (r < ROW_M0) return F.P->in[IN_XS] + (size_t)(r - ROW_S0) * D_MODEL;
    if (r < NROWS) return F.P->in[IN_META] + (size_t)(r - ROW_M0) * D_MODEL;
    return nullptr;
}

DI void p0_transpose_item(const float* W, int K, int N, bf16_t* WT, LAS float* scr, int item, int nblk, int lane) {
    const int kb = item / nblk, nb = item % nblk, k0 = 64 * kb, n0 = 64 * nb;
    const int c4 = (lane & 15) * 4, r0 = lane >> 4;
    f32x4 v[16];
#pragma unroll
    for (int i = 0; i < 16; ++i) { const int kk = 4 * i + r0; v[i] = (n0 + c4 < N) ? *(const f32x4*)(W + (size_t)(k0 + kk) * N + n0 + c4) : (f32x4){0.f, 0.f, 0.f, 0.f}; }
#pragma unroll
    for (int i = 0; i < 16; ++i) { const int kk = 4 * i + r0; LAS float* d = scr + kk * 65 + c4; d[0] = v[i][0]; d[1] = v[i][1]; d[2] = v[i][2]; d[3] = v[i][3]; }
    WAIT_L(0); CFENCE();
    const int c = lane & 7;
#pragma unroll
    for (int j = 0; j < 8; ++j) { const int n = (lane >> 3) + 8 * j; const LAS float* sp = scr + (8 * c) * 65 + n;
        u32x4 o; o.x = cvtpk(sp[0 * 65], sp[1 * 65]); o.y = cvtpk(sp[2 * 65], sp[3 * 65]); o.z = cvtpk(sp[4 * 65], sp[5 * 65]); o.w = cvtpk(sp[6 * 65], sp[7 * 65]);
        *(u32x4*)(WT + (size_t)(n0 + n) * K + k0 + 8 * c) = o; }
    WAIT_L(0); CFENCE();
}
DI int rel_bucket_dev(int rel) {
    const int n = rel < 0 ? -rel : rel;
    int b = n < 8 ? n : 8 + (n >= 15) + (n >= 27) + (n >= 50) + (n >= 91) + (n >= 166) + (n >= 305) + (n >= 559);
    return (rel > 0 ? 16 : 0) + b;
}
DI void p0_prologue(Frame& F) {
    LAS float* scr = (LAS float*)(F.lds + F.wave * 16896);
    const int gw = F.vcu * 8 + F.wave, NGW = F.G * 8;
    bf16_t* WinT = (bf16_t*)(F.ws + WS_WINT); bf16_t* WoutT = (bf16_t*)(F.ws + WS_WOUTT); bf16_t* XN = (bf16_t*)(F.ws + WS_XN);
    constexpr int NB_IN = NP_IN / 64, I_IN = (D_MODEL / 64) * NB_IN, NB_O = D_MODEL / 64, I_O = (D_MODEL / 64) * NB_O;
    for (int it = gw; it < I_IN + I_O; it += NGW) {
        if (it < I_IN) p0_transpose_item(F.P->in[IN_WIN], D_MODEL, IN_COLS, WinT, scr, it, NB_IN, F.lane);
        else p0_transpose_item(F.P->in[IN_WOUT], D_MODEL, D_MODEL, WoutT, scr, it - I_IN, NB_O, F.lane);
    }
    constexpr int NJ = D_MODEL / 256;
    for (int r = gw; r < R; r += NGW) {
        const float* xr = src_row(F, r);
        unsigned long long* o8 = (unsigned long long*)(XN + (size_t)r * D_MODEL) + F.lane;
        if (!xr) {
#pragma unroll
            for (int j = 0; j < NJ; ++j) o8[64 * j] = 0ull;
            continue; }
        f32x4 v[NJ]; float s = 0.f;
#pragma unroll
        for (int j = 0; j < NJ; ++j) { v[j] = ((const f32x4*)xr)[F.lane + 64 * j]; s += (v[j].x * v[j].x + v[j].y * v[j].y) + (v[j].z * v[j].z + v[j].w * v[j].w); }
        const float rs = 1.0f / sqrtf(wave_sum(s) * (1.f / D_MODEL) + EPS);
#pragma unroll
        for (int j = 0; j < NJ; ++j) { const f32x4 w = ((const f32x4*)F.P->in[IN_PREN])[F.lane + 64 * j];
            o8[64 * j] = (unsigned long long)cvtpk(v[j].x * rs * w.x, v[j].y * rs * w.y) | ((unsigned long long)cvtpk(v[j].z * rs * w.z, v[j].w * rs * w.w) << 32); }
    }
    float* TBL = (float*)(F.ws + WS_TB);
    for (int i = F.vcu * 512 + F.tid; i < NH_A * NTB; i += F.G * 512) { const int h = i / NTB, idx = i % NTB; TBL[i] = F.P->in[IN_RELB][rel_bucket_dev(idx - TB_OFF) * NH_A + h] * LOG2E; }
}

struct EpiIn {
    static constexpr bool PERM = true;
    float* out; unsigned char* ws;
    DI void operator()(const f32x4 (&acc)[2][2][4][2], const pg8::Unit& u, int wr, int wc, int fr, int fq) const {
        const int pn = u.pn; const int row0 = u.pm * 256 + wr * 64 + fr;
        int seg, colt;
        if (pn < 4 * TA) { seg = pn / TA; colt = (pn - seg * TA) * 256; }
        else if (pn < 4 * TA + 3 * TB) { seg = 4; colt = (pn - 4 * TA) * 256; }
        else if (pn < 4 * TA + 4 * TB) { seg = 5; colt = (pn - 4 * TA - 3 * TB) * 256; }
        else { seg = 6; colt = 0; }
        const int col0 = colt + wc * 32 + 8 * fq;
#pragma unroll
        for (int ai = 0; ai < 2; ++ai)
#pragma unroll
            for (int m = 0; m < 4; ++m) {
                const int r = row0 + ai * 128 + m * 16;
#pragma unroll
                for (int bj = 0; bj < 2; ++bj) {
                    const f32x4 v0 = acc[ai][bj][m][0], v1 = acc[ai][bj][m][1]; const int col = col0 + bj * 128;
                    if (seg == 0) { u32x4 w; w.x = cvtpk(v0[0] * C2Q, v0[1] * C2Q); w.y = cvtpk(v0[2] * C2Q, v0[3] * C2Q); w.z = cvtpk(v1[0] * C2Q, v1[1] * C2Q); w.w = cvtpk(v1[2] * C2Q, v1[3] * C2Q);
                        *(u32x4*)((bf16_t*)(ws + WS_Q) + (size_t)r * W_A + col) = w; }
                    else if (seg == 1 || seg == 2) {
                        u32x4 w; w.x = cvtpk(v0[0], v0[1]); w.y = cvtpk(v0[2], v0[3]); w.z = cvtpk(v1[0], v1[1]); w.w = cvtpk(v1[2], v1[3]);
                        *(u32x4*)((bf16_t*)(ws + (seg == 1 ? WS_K : WS_V)) + (size_t)r * W_A + col) = w;
                        float* o = nullptr;
                        if (r < ROW_S0) o = out + (seg == 1 ? O_KP : O_VP) + (size_t)(N_META + r) * W_A;
                        else if (r < ROW_M0) o = out + (seg == 1 ? O_KS : O_VS) + (size_t)(r - ROW_S0) * W_A;
                        else if (r < NROWS) o = out + (seg == 1 ? O_KP : O_VP) + (size_t)(r - ROW_M0) * W_A;
                        if (o) { *(f32x4*)(o + col) = v0; *(f32x4*)(o + col + 4) = v1; } }
                    else if (seg == 3 || seg == 5) {
                        u32x4 w; w.x = cvtpk(silu_f(v0[0]), silu_f(v0[1])); w.y = cvtpk(silu_f(v0[2]), silu_f(v0[3])); w.z = cvtpk(silu_f(v1[0]), silu_f(v1[1])); w.w = cvtpk(silu_f(v1[2]), silu_f(v1[3]));
                        *(u32x4*)((bf16_t*)(ws + (seg == 3 ? WS_GA : WS_GB)) + (size_t)r * W_A + col) = w; }
                    else if (seg == 4) {
                        u32x4 w; w.x = cvtpk(v0[0], v0[1]); w.y = cvtpk(v0[2], v0[3]); w.z = cvtpk(v1[0], v1[1]); w.w = cvtpk(v1[2], v1[3]);
                        *(u32x4*)((bf16_t*)(ws + WS_QKVB) + (size_t)r * C3 + col) = w;
                        float* o = nullptr;
                        if (r >= SEQ - 3 && r < SEQ) o = out + O_CP + (size_t)(r - (SEQ - 3)) * C3;
                        else if (r >= ROW_S0 && r < ROW_M0 && ((r - ROW_S0) & 31) >= 29) o = out + O_CS + (size_t)(((r - ROW_S0) >> 5) * 3 + (((r - ROW_S0) & 31) - 29)) * C3;
                        if (o) { *(f32x4*)(o + col) = v0; *(f32x4*)(o + col + 4) = v1; } }
                    else { if (col < 32) { float* o = (float*)(ws + WS_AB) + (size_t)r * 32 + col; *(f32x4*)o = v0; *(f32x4*)(o + 4) = v1; } }
                }
            }
    }
};

struct EpiOut {
    static constexpr bool PERM = true;
    unsigned char* ws;
    DI void operator()(const f32x4 (&acc)[2][2][4][2], const pg8::Unit& u, int wr, int wc, int fr, int fq) const {
        const int row0 = u.pm * 256 + wr * 64 + fr, col0 = u.pn * 256 + wc * 32 + 8 * fq;
        bf16_t* Y = (bf16_t*)(ws + WS_Y); float* SSp = (float*)(ws + WS_SS);
#pragma unroll
        for (int ai = 0; ai < 2; ++ai)
#pragma unroll
            for (int m = 0; m < 4; ++m) {
                const int r = row0 + ai * 128 + m * 16; float s = 0.f;
#pragma unroll
                for (int bj = 0; bj < 2; ++bj) { const f32x4 v0 = acc[ai][bj][m][0], v1 = acc[ai][bj][m][1];
                    s += (v0[0] * v0[0] + v0[1] * v0[1]) + (v0[2] * v0[2] + v0[3] * v0[3]) + (v1[0] * v1[0] + v1[1] * v1[1]) + (v1[2] * v1[2] + v1[3] * v1[3]);
                    u32x4 w; w.x = cvtpk(v0[0], v0[1]); w.y = cvtpk(v0[2], v0[3]); w.z = cvtpk(v1[0], v1[1]); w.w = cvtpk(v1[2], v1[3]);
                    *(u32x4*)(Y + (size_t)r * D_MODEL + col0 + bj * 128) = w; }
                s += __shfl_xor(s, 16); s += __shfl_xor(s, 32);
                if (fq == 0) SSp[(size_t)r * 64 + u.pn * 4 + wc] = s;
            }
    }
};
static_assert(D_MODEL / 256 * 4 <= 64, "SS slots");

constexpr int M_MAIN = (ROW_M0 + 255) / 256 * 256, N_MAIN = 4 * W_A + 4 * W_B;
constexpr int SK_AB_TILES = (NROWS + 31) / 32, SK_META_TILES = (2 * W_A + 3 * W_B) / 32;
#define SK_LOAD(A_, B_, KB_) do { const int kk_ = 64 * ((KB_) < kbe ? (KB_) : kbe - 1); _Pragma("unroll") for (int q = 0; q < 4; ++q) { A_[q] = *(const bf16x8*)(ap + kk_ + 8 * q); B_[q] = *(const bf16x8*)(bp + kk_ + 8 * q); } } while (0)
#define SK_MMA(A_, B_) do { _Pragma("unroll") for (int q = 0; q < 4; ++q) acc = __builtin_amdgcn_mfma_f32_32x32x16_bf16(A_[q], B_[q], acc, 0, 0, 0); } while (0)
DI f32x16 skinny_tile(const bf16_t* Arows, const bf16_t* Brows, int lane, int kb0, int nkb) {
    const int r = lane & 31, h = lane >> 5, kbe = kb0 + nkb;
    const bf16_t* ap = Arows + (size_t)r * D_MODEL + 32 * h; const bf16_t* bp = Brows + (size_t)r * D_MODEL + 32 * h;
    f32x16 acc = {};
    bf16x8 A0[4], B0[4], A1[4], B1[4], A2[4], B2[4], A3[4], B3[4];
    SK_LOAD(A0, B0, kb0); SK_LOAD(A1, B1, kb0 + 1); SK_LOAD(A2, B2, kb0 + 2);
    for (int kb = kb0; kb < kbe; kb += 4) {
        SK_LOAD(A3, B3, kb + 3); SBAR(); SK_MMA(A0, B0); SBAR();
        SK_LOAD(A0, B0, kb + 4); SBAR(); SK_MMA(A1, B1); SBAR();
        SK_LOAD(A1, B1, kb + 5); SBAR(); SK_MMA(A2, B2); SBAR();
        SK_LOAD(A2, B2, kb + 6); SBAR(); SK_MMA(A3, B3); SBAR();
    }
    return acc;
}
static_assert((D_MODEL / 64 / 2) % 4 == 0, "skinny K halves are whole prefetch rings");
DI void p1a_skinny(Frame& F) {
    const int lane = F.lane, j = lane & 31, h = lane >> 5, ws4 = F.wave & 3, kh = F.wave >> 2;
    const bf16_t* XN = (const bf16_t*)(F.ws + WS_XN); const bf16_t* WinT = (const bf16_t*)(F.ws + WS_WINT);
    constexpr int NT = SK_AB_TILES + SK_META_TILES, NKH = D_MODEL / 64 / 2;
    float* xch = (float*)(F.lds) + (size_t)ws4 * 64 * 17;
    const int nit = (NT + F.G * 4 - 1) / (F.G * 4);
    for (int n = 0; n < nit; ++n) {
        const int it = F.vcu + F.G * (ws4 + 4 * n);
        const bool valid = it < NT, isab = it < SK_AB_TILES;
        int seg = 0, colp = 0; const bf16_t* Ar = WinT + (size_t)N_MAIN * D_MODEL; const bf16_t* Br = XN;
        if (valid) {
            if (isab) Br = XN + (size_t)(32 * it) * D_MODEL;
            else {
                const int ct = it - SK_AB_TILES;
                if (ct < W_A / 32) { seg = 0; colp = 32 * ct; } else if (ct < 2 * W_A / 32) { seg = 1; colp = 32 * ct - W_A; } else { seg = 2; colp = 32 * ct - 2 * W_A; }
                const int gcol = seg == 0 ? W_A + colp : (seg == 1 ? 2 * W_A + colp : 4 * W_A + colp);
                Ar = XN + (size_t)ROW_M0 * D_MODEL; Br = WinT + (size_t)gcol * D_MODEL;
            }
        }
        f32x16 acc = {};
        if (valid) acc = skinny_tile(Ar, Br, lane, kh * NKH, NKH);
        if (kh == 1) {
#pragma unroll
            for (int q = 0; q < 16; ++q) xch[lane * 17 + q] = acc[q]; }
        __syncthreads();
        if (kh == 0 && valid) {
#pragma unroll
            for (int q = 0; q < 16; ++q) acc[q] += xch[lane * 17 + q];
            if (isab) {
                float* o = (float*)(F.ws + WS_AB) + (size_t)(32 * it + j) * 32 + 4 * h;
#pragma unroll
                for (int q = 0; q < 4; ++q) *(f32x4*)(o + 8 * q) = (f32x4){acc[4 * q], acc[4 * q + 1], acc[4 * q + 2], acc[4 * q + 3]};
            } else {
#pragma unroll
                for (int r = 0; r < 8; ++r) { const int tok = crow_c(r, h); const float v = acc[r];
                    if (seg == 2) ((bf16_t*)(F.ws + WS_QKVB))[(size_t)(ROW_M0 + tok) * C3 + colp + j] = (bf16_t)f2bf(v);
                    else { ((bf16_t*)(F.ws + (seg == 0 ? WS_K : WS_V)))[(size_t)(ROW_M0 + tok) * W_A + colp + j] = (bf16_t)f2bf(v);
                           F.out[(seg == 0 ? O_KP : O_VP) + (size_t)tok * W_A + colp + j] = v; } }
            }
        }
        __syncthreads();
    }
}
DI int dummy_unused() { return 0; }

DI void p5_final(Frame& F) {
    const int gw = F.vcu * 8 + F.wave, NGW = F.G * 8;
    const bf16_t* Y = (const bf16_t*)(F.ws + WS_Y); const float* SSp = (const float*)(F.ws + WS_SS);
    constexpr int NJ = D_MODEL / 512, NSL = D_MODEL / 256 * 4;
    for (int r = gw; r < ROW_M0; r += NGW) {
        float s = F.lane < NSL ? SSp[(size_t)r * 64 + F.lane] : 0.f; s = wave_sum(s);
        const float rs = 1.0f / sqrtf(s * (1.f / D_MODEL) + EPS);
        const float* h = src_row(F, r); float* o = r < ROW_S0 ? F.out + O_YP + (size_t)r * D_MODEL : F.out + O_YS + (size_t)(r - ROW_S0) * D_MODEL;
#pragma unroll
        for (int j = 0; j < NJ; ++j) { const int c = (F.lane + 64 * j) * 8;
            const u32x4 yv = *(const u32x4*)(Y + (size_t)r * D_MODEL + c);
            const f32x4 h0 = *(const f32x4*)(h + c), h1 = *(const f32x4*)(h + c + 4), w0 = *(const f32x4*)(F.P->in[IN_POSTN] + c), w1 = *(const f32x4*)(F.P->in[IN_POSTN] + c + 4);
            f32x4 o0, o1; o0[0] = h0[0] + lo_bf(yv.x) * rs * w0[0]; o0[1] = h0[1] + hi_bf(yv.x) * rs * w0[1]; o0[2] = h0[2] + lo_bf(yv.y) * rs * w0[2]; o0[3] = h0[3] + hi_bf(yv.y) * rs * w0[3];
            o1[0] = h1[0] + lo_bf(yv.z) * rs * w1[0]; o1[1] = h1[1] + hi_bf(yv.z) * rs * w1[1]; o1[2] = h1[2] + lo_bf(yv.w) * rs * w1[2]; o1[3] = h1[3] + hi_bf(yv.w) * rs * w1[3];
            *(f32x4*)(o + c) = o0; *(f32x4*)(o + c + 4) = o1; }
    }
}

DI void load8_hist(const Frame& F, int r, int i, int cb, float (&x)[8]) {
    const bf16_t* QKVB = (const bf16_t*)(F.ws + WS_QKVB);
    int row = -1; const float* cs = nullptr;
    if (r < ROW_S0) { const int p = r - i; row = p >= 0 ? p : ROW_M0 + N_META + p; }
    else if (r < ROW_M0) { const int s = (r - ROW_S0) & 31, b = (r - ROW_S0) >> 5; if (s - i >= 0) row = r - i; else cs = F.P->in[IN_CONVS] + ((size_t)b * 3 + (3 + s - i)) * C3 + cb; }
    else { const int m = r - ROW_M0; if (m - i >= 0) row = r - i; }
    if (row >= 0) { const u32x4 w = *(const u32x4*)(QKVB + (size_t)row * C3 + cb); x[0] = lo_bf(w.x); x[1] = hi_bf(w.x); x[2] = lo_bf(w.y); x[3] = hi_bf(w.y); x[4] = lo_bf(w.z); x[5] = hi_bf(w.z); x[6] = lo_bf(w.w); x[7] = hi_bf(w.w); }
    else if (cs) { const f32x4 a = *(const f32x4*)cs, b = *(const f32x4*)(cs + 4); x[0] = a[0]; x[1] = a[1]; x[2] = a[2]; x[3] = a[3]; x[4] = b[0]; x[5] = b[1]; x[6] = b[2]; x[7] = b[3]; }
    else {
#pragma unroll
        for (int j = 0; j < 8; ++j) x[j] = 0.f; }
}
DI void p2_conv(Frame& F) {
    const int gw = F.vcu * 8 + F.wave, NGW = F.G * 8, sub = F.lane >> 4, l16 = F.lane & 15;
    bf16_t* QKVN = (bf16_t*)(F.ws + WS_QKVN); const float* AB = (const float*)(F.ws + WS_AB); float* BG = (float*)(F.ws + WS_BG);
    const float* cw = F.P->in[IN_CONVW];
    constexpr int NRB = (NROWS + 63) / 64, NIT = NRB * NH_B * 3;
    for (int it = gw; it < NIT; it += NGW) {
        const int t = it % 3, hb = (it / 3) % NH_B, rb = it / (3 * NH_B), r0 = rb * 64 + sub * 16;
        const float adt = F.P->in[IN_DTB][hb], nea = -expf(F.P->in[IN_ALOG][hb]);
        {
            const int cb = t * W_B + hb * 128 + l16 * 8;
            float w[4][8];
#pragma unroll
            for (int i = 0; i < 4; ++i) { const f32x4 w0 = *(const f32x4*)(cw + (size_t)i * C3 + cb), w1 = *(const f32x4*)(cw + (size_t)i * C3 + cb + 4);
#pragma unroll
                for (int j = 0; j < 4; ++j) { w[i][j] = w0[j]; w[i][4 + j] = w1[j]; } }
            float x0[8], x1[8], x2[8], x3[8];
            if (r0 < NROWS) { load8_hist(F, r0, 3, cb, x0); load8_hist(F, r0, 2, cb, x1); load8_hist(F, r0, 1, cb, x2); }
            else {
#pragma unroll
                for (int j = 0; j < 8; ++j) { x0[j] = 0.f; x1[j] = 0.f; x2[j] = 0.f; } }
            const float post = t == 0 ? 0.08838834764831845f : 1.0f;
            u32x4 raw[16];
            { const bf16_t* QKVB = (const bf16_t*)(F.ws + WS_QKVB);
#pragma unroll
              for (int k = 0; k < 16; ++k) { raw[k] = (u32x4){0u, 0u, 0u, 0u}; if (r0 + k < NROWS) raw[k] = *(const u32x4*)(QKVB + (size_t)(r0 + k) * C3 + cb); } }
#pragma unroll
            for (int k = 0; k < 16; ++k) {
                const int r = r0 + k; const bool valid = r < NROWS;
                { const u32x4 wq = raw[k]; x3[0] = lo_bf(wq.x); x3[1] = hi_bf(wq.x); x3[2] = lo_bf(wq.y); x3[3] = hi_bf(wq.y); x3[4] = lo_bf(wq.z); x3[5] = hi_bf(wq.z); x3[6] = lo_bf(wq.w); x3[7] = hi_bf(wq.w); }
                float y[8]; float ss = 0.f;
#pragma unroll
                for (int j = 0; j < 8; ++j) { y[j] = silu_f(x0[j] * w[0][j] + x1[j] * w[1][j] + x2[j] * w[2][j] + x3[j] * w[3][j]); ss += y[j] * y[j]; x0[j] = x1[j]; x1[j] = x2[j]; x2[j] = x3[j]; }
                float sc = 1.0f;
                if (t < 2) { ss += __shfl_xor(ss, 1); ss += __shfl_xor(ss, 2); ss += __shfl_xor(ss, 4); ss += __shfl_xor(ss, 8); sc = post / sqrtf(ss + EPS); }
                if (valid) { u32x4 o; o.x = cvtpk(y[0] * sc, y[1] * sc); o.y = cvtpk(y[2] * sc, y[3] * sc); o.z = cvtpk(y[4] * sc, y[5] * sc); o.w = cvtpk(y[6] * sc, y[7] * sc);
                    *(u32x4*)(QKVN + (size_t)r * C3 + cb) = o; }
            }
        }
        { const int r = rb * 64 + F.lane;
          if (t == 0 && r < NROWS) { const float braw = AB[(size_t)r * 32 + hb], araw = AB[(size_t)r * 32 + NH_B + hb];
              const float beta = 1.0f / (1.0f + expf(-braw)); const float xx = araw + adt; const float sp = xx > 20.f ? xx : log1pf(expf(xx));
              BG[((size_t)r * NH_B + hb) * 2] = beta; BG[((size_t)r * NH_B + hb) * 2 + 1] = nea * sp; } }
    }
}

constexpr int PK_W = 0, PK_Q = 16384, PK_A = 32768, PK_K = 40960, PK_U = 57344;
DI int crow(int r, int h) { return (r & 3) + 8 * (r >> 2) + 4 * h; }
DI int sc_base_row(int sc) { return sc == 0 ? ROW_M0 : (sc < NCH_P ? (sc - 1) * 64 : ROW_S0 + (sc - NCH_P) * 32); }
DI int sc_len(int sc) { return sc == 0 ? N_META : (sc < NCH_P ? 64 : DEC_SEQ); }
DI float rdlane_f(float v, int lane) { return __builtin_bit_cast(float, __builtin_amdgcn_readlane(__builtin_bit_cast(int, v), lane)); }
DI bf16x8 pack8f(const float* x) { u32x4 w; w.x = cvtpk(x[0], x[1]); w.y = cvtpk(x[2], x[3]); w.z = cvtpk(x[4], x[5]); w.w = cvtpk(x[6], x[7]); return __builtin_bit_cast(bf16x8, w); }
DI bf16x8 pack8v(const f32x16& v, int b, float sc) { u32x4 w; w.x = cvtpk(v[b] * sc, v[b + 1] * sc); w.y = cvtpk(v[b + 2] * sc, v[b + 3] * sc); w.z = cvtpk(v[b + 4] * sc, v[b + 5] * sc); w.w = cvtpk(v[b + 6] * sc, v[b + 7] * sc); return __builtin_bit_cast(bf16x8, w); }
template <int C> struct InvStep {
    static DI void run(float (&T)[64], const LAS float* Al, int lane) {
        float a0 = 0.f, a1 = 0.f;
#pragma unroll
        for (int j4 = ((C + 1) & ~3); j4 < 64; j4 += 4) { const f32x4 a = *(const LAS f32x4*)(Al + C * 64 + j4);
#pragma unroll
            for (int e = 0; e < 4; ++e) { const int j = j4 + e; if (j > C) { if (j & 1) a1 = __builtin_fmaf(-T[j], a[e], a1); else a0 = __builtin_fmaf(-T[j], a[e], a0); } }
            }
        T[C] = (lane == C) ? 1.0f : (a0 + a1);
        PINV(T[C]);
        if constexpr (C > 0) InvStep<C - 1>::run(T, Al, lane);
    }
};
DI void p3_prep(Frame& F) {
    const int gw = F.vcu * 8 + F.wave, NGW = F.G * 8, lane = F.lane, r32 = lane & 31, h = lane >> 5;
    const bf16_t* QKVN = (const bf16_t*)(F.ws + WS_QKVN); const float* BG = (const float*)(F.ws + WS_BG);
    LAS unsigned char* tile = F.lds + F.wave * 17408;
    LAS float* gs = (LAS float*)(F.lds + F.wave * 17408 + 16384);
    for (int rnd = 0; rnd * NGW < NSC * NH_B; ++rnd) {
        const int item = rnd * NGW + (((rnd + 1) * NGW <= NSC * NH_B) ? gw : F.vcu + F.G * F.wave);
        if (item >= NSC * NH_B) break;
        const int sc = item / NH_B, hb = item % NH_B, row0 = sc_base_row(sc), L = sc_len(sc);
        unsigned char* pkg = F.ws + WS_PKG + (size_t)item * PKG_BYTES;
        float g = 0.f, beta = 0.f; if (lane < L) { beta = BG[((size_t)(row0 + lane) * NH_B + hb) * 2]; g = BG[((size_t)(row0 + lane) * NH_B + hb) * 2 + 1]; }
        float G = g;
#pragma unroll
        for (int off = 1; off < 64; off <<= 1) { const float t = __shfl(G, (lane - off) & 63); if (lane >= off) G += t; }
        const float Glast = __shfl(G, 63);
        gs[lane] = G; gs[64 + lane] = fast_exp2((Glast - G) * LOG2E); gs[128 + lane] = beta * fast_exp2(G * LOG2E); gs[192 + lane] = beta;
        if (lane == 0) ((float*)(F.ws + WS_DEC))[item] = fast_exp2(Glast * LOG2E);
        WAIT_L(0); CFENCE();
        bf16x8 kf[2][8], qf[2][8];
#pragma unroll
        for (int tt = 0; tt < 2; ++tt) { const int tok = 32 * tt + r32; const bool ok = tok < L; const bf16_t* rp = QKVN + (size_t)(row0 + tok) * C3 + hb * 128;
#pragma unroll
            for (int ks = 0; ks < 8; ++ks) { const int ch = 16 * ks + 4 * h; u32x2 a = {0u, 0u}, b = {0u, 0u}, c = {0u, 0u}, d = {0u, 0u};
                if (ok) { a = *(const u32x2*)(rp + W_B + ch); b = *(const u32x2*)(rp + W_B + ch + 8); c = *(const u32x2*)(rp + ch); d = *(const u32x2*)(rp + ch + 8); }
                kf[tt][ks] = __builtin_bit_cast(bf16x8, (u32x4){a.x, a.y, b.x, b.y}); qf[tt][ks] = __builtin_bit_cast(bf16x8, (u32x4){c.x, c.y, d.x, d.y}); } }
        const float Gi0 = __shfl(G, r32), Gi1 = __shfl(G, 32 + r32);
#pragma unroll
        for (int tl = 0; tl < 3; ++tl) {
            const int jt = tl >> 1, it = (tl + 1) >> 1; f32x16 Sx = {};
#pragma unroll
            for (int ks = 0; ks < 8; ++ks) Sx = __builtin_amdgcn_mfma_f32_32x32x16_bf16(kf[jt][ks], qf[it][ks], Sx, 0, 0, 0);
            const float Gi = it ? Gi1 : Gi0;
#pragma unroll
            for (int q4 = 0; q4 < 4; ++q4) { const f32x4 gj = *(const LAS f32x4*)(gs + 32 * jt + 8 * q4 + 4 * h);
#pragma unroll
                for (int e = 0; e < 4; ++e) { const int r = 4 * q4 + e, j0 = 8 * q4 + 4 * h + e; const float v = Sx[r] * fast_exp2((Gi - gj[e]) * LOG2E); Sx[r] = (jt != it || j0 <= r32) ? v : 0.f; } }
#pragma unroll
            for (int s2 = 0; s2 < 2; ++s2) *(bf16x8*)(pkg + PK_A + (it * 4 + jt * 2 + s2) * 1024 + lane * 16) = pack8v(Sx, 8 * s2, 1.f);
            SBAR();
        }
        { bf16x8 z = {}; *(bf16x8*)(pkg + PK_A + (0 * 4 + 1 * 2 + 0) * 1024 + lane * 16) = z; *(bf16x8*)(pkg + PK_A + (0 * 4 + 1 * 2 + 1) * 1024 + lane * 16) = z; }
        {
            const float e0 = fast_exp2(Gi0 * LOG2E), e1 = fast_exp2(Gi1 * LOG2E);
#pragma unroll
            for (int tt = 0; tt < 2; ++tt)
#pragma unroll
                for (int ks = 0; ks < 8; ++ks) { const u32x4 w = __builtin_bit_cast(u32x4, qf[tt][ks]); const float e = tt ? e1 : e0;
                    u32x4 o; o.x = cvtpk(lo_bf(w.x) * e, hi_bf(w.x) * e); o.y = cvtpk(lo_bf(w.y) * e, hi_bf(w.y) * e); o.z = cvtpk(lo_bf(w.z) * e, hi_bf(w.z) * e); o.w = cvtpk(lo_bf(w.w) * e, hi_bf(w.w) * e);
                    *(u32x4*)(pkg + PK_Q + (tt * 8 + ks) * 1024 + lane * 16) = o; }
        }
        {
            const float b0 = __shfl(beta, r32), b1 = __shfl(beta, 32 + r32);
            LAS float* Al = (LAS float*)tile;
#pragma unroll
            for (int tl = 0; tl < 3; ++tl) {
                const int ct = tl >> 1, jt = (tl + 1) >> 1; f32x16 Kx = {};
#pragma unroll
                for (int ks = 0; ks < 8; ++ks) Kx = __builtin_amdgcn_mfma_f32_32x32x16_bf16(kf[ct][ks], kf[jt][ks], Kx, 0, 0, 0);
                const float Gj = jt ? Gi1 : Gi0, bj = jt ? b1 : b0;
#pragma unroll
                for (int q4 = 0; q4 < 4; ++q4) { const f32x4 gc = *(const LAS f32x4*)(gs + 32 * ct + 8 * q4 + 4 * h);
#pragma unroll
                    for (int e = 0; e < 4; ++e) { const int r = 4 * q4 + e; Al[(32 * ct + crow(r, h)) * 64 + 32 * jt + r32] = Kx[r] * bj * fast_exp2(fminf(Gj - gc[e], 0.f) * LOG2E); } }
                SBAR();
            }
        }
        WAIT_L(0); CFENCE();
        float T[64];
#pragma unroll
        for (int j = 0; j < 64; ++j) T[j] = (lane == j) ? 1.f : 0.f;
        InvStep<62>::run(T, (const LAS float*)tile, lane);
        WAIT_L(0); CFENCE();
#pragma unroll
        for (int tt = 0; tt < 2; ++tt) { const int tok = 32 * tt + r32; const bool ok = tok < L; const bf16_t* rp = QKVN + (size_t)(row0 + tok) * C3 + hb * 128;
#pragma unroll
            for (int ks = 0; ks < 8; ++ks) { const int ch = 16 * ks + 4 * h; u32x2 a = {0u, 0u}, b = {0u, 0u};
                if (ok) { a = *(const u32x2*)(rp + W_B + ch); b = *(const u32x2*)(rp + W_B + ch + 8); }
                kf[tt][ks] = __builtin_bit_cast(bf16x8, (u32x4){a.x, a.y, b.x, b.y}); } }
#pragma unroll
        for (int tt = 0; tt < 2; ++tt)
#pragma unroll
            for (int ks = 0; ks < 8; ++ks) { const u32x4 w = __builtin_bit_cast(u32x4, kf[tt][ks]); LAS unsigned char* p = tile + (32 * tt + r32) * 256 + (16 * ks + 4 * h) * 2;
                *(LAS u32x2*)p = (u32x2){w.x, w.y}; *(LAS u32x2*)(p + 16) = (u32x2){w.z, w.w}; }
        bf16x8 TW[2][4], TU[2][4];
#pragma unroll
        for (int ks = 0; ks < 4; ++ks) {
            float xa[8], xb[8], ya[8], yb[8];
#pragma unroll
            for (int q = 0; q < 2; ++q) { const f32x4 w0 = *(const LAS f32x4*)(gs + 128 + 16 * ks + 4 * q), w1 = *(const LAS f32x4*)(gs + 128 + 16 * ks + 8 + 4 * q), u0 = *(const LAS f32x4*)(gs + 192 + 16 * ks + 4 * q), u1 = *(const LAS f32x4*)(gs + 192 + 16 * ks + 8 + 4 * q);
#pragma unroll
                for (int e = 0; e < 4; ++e) { const int jj = 4 * q + e; xa[jj] = T[16 * ks + jj] * w0[e]; xb[jj] = T[16 * ks + 8 + jj] * w1[e]; ya[jj] = T[16 * ks + jj] * u0[e]; yb[jj] = T[16 * ks + 8 + jj] * u1[e]; } }
            const u32x4 a = __builtin_bit_cast(u32x4, pack8f(xa)), b = __builtin_bit_cast(u32x4, pack8f(xb)), c = __builtin_bit_cast(u32x4, pack8f(ya)), d = __builtin_bit_cast(u32x4, pack8f(yb));
            u32x4 t0, t1, u0v, u1v;
#pragma unroll
            for (int e = 0; e < 4; ++e) { auto rr = __builtin_amdgcn_permlane32_swap(a[e], b[e], false, false); t0[e] = rr[0]; t1[e] = rr[1];
                auto r2 = __builtin_amdgcn_permlane32_swap(c[e], d[e], false, false); u0v[e] = r2[0]; u1v[e] = r2[1]; }
            TW[0][ks] = __builtin_bit_cast(bf16x8, t0); TW[1][ks] = __builtin_bit_cast(bf16x8, t1); TU[0][ks] = __builtin_bit_cast(bf16x8, u0v); TU[1][ks] = __builtin_bit_cast(bf16x8, u1v);
        }
        WAIT_L(0); CFENCE();
        const int tr_off = ((lane >> 2) & 3) * 256 + (16 * ((lane >> 4) & 1) + 4 * (lane & 3)) * 2;
#define TRF(tok0, ch0) ({ const s16x4 lo_ = tr16(tile + tr_off + (tok0) * 256 + (ch0) * 2), hi_ = tr16(tile + tr_off + ((tok0) + 4) * 256 + (ch0) * 2); (bf16x8){lo_[0], lo_[1], lo_[2], lo_[3], hi_[0], hi_[1], hi_[2], hi_[3]}; })
#pragma unroll
        for (int it = 0; it < 2; ++it) {
            f32x16 acc[4] = {};
#pragma unroll
            for (int ks = 0; ks < 4; ++ks)
#pragma unroll
                for (int ct = 0; ct < 4; ++ct) { const bf16x8 a = TRF(16 * ks + 8 * h, 32 * ct); acc[ct] = __builtin_amdgcn_mfma_f32_32x32x16_bf16(a, TW[it][ks], acc[ct], 0, 0, 0); }
#pragma unroll
            for (int ct = 0; ct < 4; ++ct)
#pragma unroll
                for (int s = 0; s < 2; ++s) *(bf16x8*)(pkg + PK_W + (it * 8 + ct * 2 + s) * 1024 + lane * 16) = pack8v(acc[ct], 8 * s, -1.f);
        }
#pragma unroll
        for (int ct = 0; ct < 4; ++ct)
#pragma unroll
            for (int ts = 0; ts < 4; ++ts) { const int tb = 16 * ts + 4 * h;
                const s16x4 lo_ = tr16(tile + tr_off + tb * 256 + (32 * ct) * 2), hi_ = tr16(tile + tr_off + (tb + 8) * 256 + (32 * ct) * 2);
                const f32x4 e0 = *(const LAS f32x4*)(gs + 64 + tb), e1 = *(const LAS f32x4*)(gs + 64 + tb + 8);
                float x[8];
#pragma unroll
                for (int e = 0; e < 4; ++e) { x[e] = bf2f((unsigned short)lo_[e]) * e0[e]; x[4 + e] = bf2f((unsigned short)hi_[e]) * e1[e]; }
                *(bf16x8*)(pkg + PK_K + (ct * 4 + ts) * 1024 + lane * 16) = pack8f(x); }
        WAIT_L(0); CFENCE();
#pragma unroll
        for (int tt = 0; tt < 2; ++tt) { const int tok = 32 * tt + r32; const bool ok = tok < L; const bf16_t* rp = QKVN + (size_t)(row0 + tok) * C3 + 2 * W_B + hb * 128;
#pragma unroll
            for (int cs = 0; cs < 8; ++cs) { u32x4 w = {0u, 0u, 0u, 0u}; if (ok) w = *(const u32x4*)(rp + 16 * cs + 8 * h); *(LAS u32x4*)(tile + tok * 256 + (16 * cs + 8 * h) * 2) = w; } }
        WAIT_L(0); CFENCE();
#pragma unroll
        for (int it = 0; it < 2; ++it) {
            f32x16 acc[4] = {};
#pragma unroll
            for (int ks = 0; ks < 4; ++ks)
#pragma unroll
                for (int ct = 0; ct < 4; ++ct) { const bf16x8 b = TRF(16 * ks + 8 * h, 32 * ct); acc[ct] = __builtin_amdgcn_mfma_f32_32x32x16_bf16(TU[it][ks], b, acc[ct], 0, 0, 0); }
#pragma unroll
            for (int ct = 0; ct < 4; ++ct) { unsigned char* up = pkg + PK_U + (ct * 2 + it) * 2048 + lane * 32; *(bf16x8*)up = pack8v(acc[ct], 0, 1.f); *(bf16x8*)(up + 16) = pack8v(acc[ct], 8, 1.f); }
        }
#undef TRF
        WAIT_L(0); CFENCE();
    }
}
constexpr int SC_FRAG = 57344, SC_OEX = 2 * SC_FRAG, SC_OEXB = 16384;
constexpr int SG = 4;
constexpr int N_SCAN_P = NH_B, N_SCAN_S = (DEC_BATCH * NH_B + SG - 1) / SG;
DI void scan_unit(Frame& F, int kind, int idx) {
    const int lane = F.lane, w = F.wave, r32 = lane & 31, h = lane >> 5;
    const int n = kind == 0 ? NCH_P : ((DEC_BATCH * NH_B - idx * SG) < SG ? (DEC_BATCH * NH_B - idx * SG) : SG);
    const float* DEC = (const float*)(F.ws + WS_DEC);
    bf16_t* YCAT = (bf16_t*)(F.ws + WS_YCAT); const bf16_t* GB = (const bf16_t*)(F.ws + WS_GB);
#define SC_ITEM(k) (kind == 0 ? (k) * NH_B + idx : (NCH_P + (idx * SG + (k)) / NH_B) * NH_B + (idx * SG + (k)) % NH_B)
    f32x16 S[4] = {};
    if (w >= 4) {
        const unsigned char* src = F.ws + WS_PKG + (size_t)SC_ITEM(0) * PKG_BYTES;
        for (int b = w - 4; b < 56; b += 4) __builtin_amdgcn_global_load_lds((const unsigned*)(src + b * 1024 + lane * 16), (LAS unsigned*)(F.lds + b * 1024), 16, 0, 0);
    }
    WAIT_V(0); __syncthreads();
    for (int k = 0; k < n; ++k) {
        const int item = SC_ITEM(k), sc = item / NH_B, hb = item % NH_B;
        LAS unsigned char* buf = F.lds + (k & 1) * SC_FRAG;
        if (w >= 4) {
            if (k + 1 < n) { const unsigned char* src = F.ws + WS_PKG + (size_t)SC_ITEM(k + 1) * PKG_BYTES; LAS unsigned char* dst = F.lds + ((k + 1) & 1) * SC_FRAG;
                for (int b = w - 4; b < 56; b += 4) __builtin_amdgcn_global_load_lds((const unsigned*)(src + b * 1024 + lane * 16), (LAS unsigned*)(dst + b * 1024), 16, 0, 0); }
        }
        if (w >= 4 && k > 0) {
            const int pit = SC_ITEM(k - 1), psc = pit / NH_B, phb = pit % NH_B, prow0 = sc_base_row(psc), pL = sc_len(psc);
            const LAS unsigned char* ox = F.lds + SC_OEX + ((k - 1) & 1) * SC_OEXB;
            if (psc != 0) {
#pragma unroll
                for (int ps = 0; ps < 4; ++ps) { const int t = (w - 4) * 16 + ps * 4 + (lane >> 4), ch = (lane & 15) * 8;
                    const u32x4 xv = *(const LAS u32x4*)(ox + t * 256 + ch * 2);
                    float x[8] = {lo_bf(xv.x), hi_bf(xv.x), lo_bf(xv.y), hi_bf(xv.y), lo_bf(xv.z), hi_bf(xv.z), lo_bf(xv.w), hi_bf(xv.w)};
                    float ss = 0.f;
#pragma unroll
                    for (int j = 0; j < 8; ++j) ss += x[j] * x[j];
                    { int lq = F.lane; OPAQUE(lq); ss += shfl_xor_l(ss, 1, lq); ss += shfl_xor_l(ss, 2, lq); ss += shfl_xor_l(ss, 4, lq); ss += shfl_xor_l(ss, 8, lq); }
                    const float rs = 1.0f / sqrtf(ss * (1.f / 128.f) + EPS);
                    if (t < pL) { const int row = prow0 + t; const u32x4 gv = *(const u32x4*)(GB + (size_t)row * W_B + phb * 128 + ch);
                        const f32x4 n0 = *(const f32x4*)(F.P->in[IN_NORMB] + ch), n1 = *(const f32x4*)(F.P->in[IN_NORMB] + ch + 4);
                        u32x4 o; o.x = cvtpk(x[0] * rs * n0[0] * lo_bf(gv.x), x[1] * rs * n0[1] * hi_bf(gv.x)); o.y = cvtpk(x[2] * rs * n0[2] * lo_bf(gv.y), x[3] * rs * n0[3] * hi_bf(gv.y));
                        o.z = cvtpk(x[4] * rs * n1[0] * lo_bf(gv.z), x[5] * rs * n1[1] * hi_bf(gv.z)); o.w = cvtpk(x[6] * rs * n1[2] * lo_bf(gv.w), x[7] * rs * n1[3] * hi_bf(gv.w));
                        *(u32x4*)(YCAT + (size_t)row * D_MODEL + W_A + phb * 128 + ch) = o; } }
            }
        }
        if (w < 4) {
            const unsigned char* pkg = F.ws + WS_PKG + (size_t)item * PKG_BYTES;
            if (kind == 1) {
                const float* sp = F.P->in[IN_SSM] + (size_t)((sc - NCH_P) * NH_B + hb) * 16384 + (size_t)(4 * h) * 128 + 32 * w + r32;
#pragma unroll
                for (int T = 0; T < 4; ++T) {
#pragma unroll
                    for (int r = 0; r < 16; ++r) S[T][r] = sp[(32 * T + (r & 3) + 8 * (r >> 2)) * 128];
                    SBAR(); }
            }
            const float d = DEC[item];
            f32x16 vn[2], o[2] = {};
#pragma unroll
            for (int rt = 0; rt < 2; ++rt) { const u32x4 a = *(const u32x4*)(pkg + PK_U + (w * 2 + rt) * 2048 + lane * 32), b = *(const u32x4*)(pkg + PK_U + (w * 2 + rt) * 2048 + lane * 32 + 16);
                vn[rt][0] = lo_bf(a.x); vn[rt][1] = hi_bf(a.x); vn[rt][2] = lo_bf(a.y); vn[rt][3] = hi_bf(a.y); vn[rt][4] = lo_bf(a.z); vn[rt][5] = hi_bf(a.z); vn[rt][6] = lo_bf(a.w); vn[rt][7] = hi_bf(a.w);
                vn[rt][8] = lo_bf(b.x); vn[rt][9] = hi_bf(b.x); vn[rt][10] = lo_bf(b.y); vn[rt][11] = hi_bf(b.y); vn[rt][12] = lo_bf(b.z); vn[rt][13] = hi_bf(b.z); vn[rt][14] = lo_bf(b.w); vn[rt][15] = hi_bf(b.w); }
            SBAR();
#define FRAG(off, blk) (*(const LAS bf16x8*)(buf + (off) + (blk) * 1024 + lane * 16))
#pragma unroll
            for (int T = 0; T < 4; ++T)
#pragma unroll
                for (int s = 0; s < 2; ++s) { const bf16x8 sb = pack8v(S[T], 8 * s, 1.f);
#pragma unroll
                    for (int rt = 0; rt < 2; ++rt) { vn[rt] = __builtin_amdgcn_mfma_f32_32x32x16_bf16(FRAG(PK_W, rt * 8 + T * 2 + s), sb, vn[rt], 0, 0, 0);
                        o[rt] = __builtin_amdgcn_mfma_f32_32x32x16_bf16(FRAG(PK_Q, rt * 8 + T * 2 + s), sb, o[rt], 0, 0, 0); }
                    SBAR(); }
#pragma unroll
            for (int T = 0; T < 4; ++T) S[T] *= d;
#pragma unroll
            for (int Tt = 0; Tt < 2; ++Tt)
#pragma unroll
                for (int s = 0; s < 2; ++s) { const bf16x8 vb = pack8v(vn[Tt], 8 * s, 1.f);
#pragma unroll
                    for (int rt = 0; rt < 2; ++rt) o[rt] = __builtin_amdgcn_mfma_f32_32x32x16_bf16(FRAG(PK_A, rt * 4 + Tt * 2 + s), vb, o[rt], 0, 0, 0);
                    SBAR();
#pragma unroll
                    for (int T = 0; T < 4; ++T) S[T] = __builtin_amdgcn_mfma_f32_32x32x16_bf16(FRAG(PK_K, T * 4 + Tt * 2 + s), vb, S[T], 0, 0, 0);
                    SBAR(); }
#undef FRAG
            LAS unsigned short* ox = (LAS unsigned short*)(F.lds + SC_OEX + (k & 1) * SC_OEXB);
#pragma unroll
            for (int rt = 0; rt < 2; ++rt)
#pragma unroll
                for (int r = 0; r < 16; ++r) ox[(32 * rt + crow(r, h)) * 128 + 32 * w + r32] = (unsigned short)f2bf(o[rt][r]);
            if (kind == 1 || k == n - 1) {
                float* dp = (kind == 1 ? F.out + O_SS + (size_t)((sc - NCH_P) * NH_B + hb) * 16384 : F.out + O_SP + (size_t)hb * 16384) + (size_t)(4 * h) * 128 + 32 * w + r32;
#pragma unroll
                for (int T = 0; T < 4; ++T) {
#pragma unroll
                    for (int r = 0; r < 16; ++r) dp[(32 * T + (r & 3) + 8 * (r >> 2)) * 128] = S[T][r];
                    SBAR(); }
            }
        }
        WAIT_VL0(); __syncthreads();
    }
    if (w >= 4) {
        const int pit = SC_ITEM(n - 1), psc = pit / NH_B, phb = pit % NH_B, prow0 = sc_base_row(psc), pL = sc_len(psc);
        const LAS unsigned char* ox = F.lds + SC_OEX + ((n - 1) & 1) * SC_OEXB;
        if (psc != 0) {
#pragma unroll
            for (int ps = 0; ps < 4; ++ps) { const int t = (w - 4) * 16 + ps * 4 + (lane >> 4), ch = (lane & 15) * 8;
                const u32x4 xv = *(const LAS u32x4*)(ox + t * 256 + ch * 2);
                float x[8] = {lo_bf(xv.x), hi_bf(xv.x), lo_bf(xv.y), hi_bf(xv.y), lo_bf(xv.z), hi_bf(xv.z), lo_bf(xv.w), hi_bf(xv.w)};
                float ss = 0.f;
#pragma unroll
                for (int j = 0; j < 8; ++j) ss += x[j] * x[j];
                { int lq = F.lane; OPAQUE(lq); ss += shfl_xor_l(ss, 1, lq); ss += shfl_xor_l(ss, 2, lq); ss += shfl_xor_l(ss, 4, lq); ss += shfl_xor_l(ss, 8, lq); }
                const float rs = 1.0f / sqrtf(ss * (1.f / 128.f) + EPS);
                if (t < pL) { const int row = prow0 + t; const u32x4 gv = *(const u32x4*)(GB + (size_t)row * W_B + phb * 128 + ch);
                    const f32x4 n0 = *(const f32x4*)(F.P->in[IN_NORMB] + ch), n1 = *(const f32x4*)(F.P->in[IN_NORMB] + ch + 4);
                    u32x4 o; o.x = cvtpk(x[0] * rs * n0[0] * lo_bf(gv.x), x[1] * rs * n0[1] * hi_bf(gv.x)); o.y = cvtpk(x[2] * rs * n0[2] * lo_bf(gv.y), x[3] * rs * n0[3] * hi_bf(gv.y));
                    o.z = cvtpk(x[4] * rs * n1[0] * lo_bf(gv.z), x[5] * rs * n1[1] * hi_bf(gv.z)); o.w = cvtpk(x[6] * rs * n1[2] * lo_bf(gv.w), x[7] * rs * n1[3] * hi_bf(gv.w));
                    *(u32x4*)(YCAT + (size_t)row * D_MODEL + W_A + phb * 128 + ch) = o; } }
        }
    }
    __syncthreads();
#undef SC_ITEM
}
constexpr int AT_KB = 32768, AT_K = 0, AT_V = 2 * AT_KB, AT_TB = 4 * AT_KB, AT_WS = AT_TB + NTB * 4, AT_END = AT_WS + 8 * 256;
static_assert(AT_END <= RING_BYTES, "attention LDS");
constexpr float THR_L2 = 11.5f;
DI int v_rd_base(int lane) { return ((lane & 3) << 3) | (((lane >> 2) & 3) << 6) | (((lane >> 4) & 1) << 5) | (((lane >> 5) & 1) << 8); }
struct AttnW { bf16x8 qr[8]; f32x16 o[8]; float m, l; };
DI void attn_tile(AttnW& A, const LAS unsigned char* Kc, const LAS unsigned char* Vt, const LAS float* tbl, LAS float* wsf, int lane, int tbi, float bu, int nvalid) {
    const int r32 = lane & 31, hi = lane >> 5;
    const float ub = tbi >= 0 ? 0.f : bu;
    const LAS unsigned char* vb0 = Vt + v_rd_base(lane);
#pragma unroll
    for (int hf = 0; hf < 2; ++hf) {
        f32x16 p = {};
        {
            const LAS unsigned char* kb[4];
#pragma unroll
            for (int dd = 0; dd < 4; ++dd) kb[dd] = Kc + hf * 8192 + r32 * 256 + (((dd * 16 + hi * 8) * 2) ^ ((r32 & 7) << 4));
#pragma unroll
            for (int d0 = 0; d0 < 8; ++d0) { const bf16x8 b0 = *(const LAS bf16x8*)(kb[d0 & 3] + (d0 >> 2) * 128); p = __builtin_amdgcn_mfma_f32_32x32x16_bf16(b0, A.qr[d0], p, 0, 0, 0); }
        }
        SBAR();
        if (tbi >= 0) {
            const LAS float* tp = tbl + tbi + 4 * hi + 32 * hf;
#pragma unroll
            for (int r = 0; r < 16; ++r) p[r] += tp[(r & 3) + 8 * (r >> 2)];
        }
        if (nvalid < 64) {
            const float NEG = -__builtin_inff();
#pragma unroll
            for (int r = 0; r < 16; ++r) { if ((r & 3) + 8 * (r >> 2) + 4 * hi + 32 * hf >= nvalid) p[r] = NEG; }
        }
        float pmax = p[0];
#pragma unroll
        for (int r = 1; r < 16; ++r) pmax = fmaxf(pmax, p[r]);
        { auto rr = __builtin_amdgcn_permlane32_swap(__float_as_uint(pmax), __float_as_uint(pmax), false, false); pmax = fmaxf(__uint_as_float(rr[0]), __uint_as_float(rr[1])); }
        pmax += ub;
        float mn, alpha;
        if (__all(pmax - A.m <= THR_L2)) { mn = A.m; alpha = 1.f; }
        else { mn = fmaxf(A.m, pmax); alpha = fast_exp2(A.m - mn); A.m = mn; }
        const float sh = ub - mn;
        float ps = 0.f;
#pragma unroll
        for (int r = 0; r < 16; ++r) { p[r] = fast_exp2(p[r] + sh); ps += p[r]; }
        { auto rr = __builtin_amdgcn_permlane32_swap(__float_as_uint(ps), __float_as_uint(ps), false, false); ps = __uint_as_float(rr[0]) + __uint_as_float(rr[1]); }
        A.l = A.l * alpha + ps;
        if (__any(alpha < 1.f)) {
            if (hi == 0) wsf[r32] = alpha;
            WAIT_L(0); CFENCE();
#pragma unroll
            for (int r = 0; r < 16; ++r) { const float al = wsf[crow(r, hi)];
#pragma unroll
                for (int d = 0; d < 8; ++d) A.o[d][r] *= al; }
            WAIT_L(0); CFENCE();
        }
        bf16x8 pa[2];
#define PK4(P, B_, OUT) do { const unsigned a0 = cvtpk(P[B_ + 0], P[B_ + 1]), a1 = cvtpk(P[B_ + 2], P[B_ + 3]), b0_ = cvtpk(P[B_ + 4], P[B_ + 5]), b1_ = cvtpk(P[B_ + 6], P[B_ + 7]); \
            auto r0 = __builtin_amdgcn_permlane32_swap(a0, b0_, false, false); auto r1 = __builtin_amdgcn_permlane32_swap(a1, b1_, false, false); \
            u32x4 w_ = {r0[0], r1[0], r0[1], r1[1]}; OUT = __builtin_bit_cast(bf16x8, w_); } while (0)
        PK4(p, 0, pa[0]); PK4(p, 8, pa[1]);
#undef PK4
        SBAR();
#pragma unroll
        for (int d0 = 0; d0 < 8; ++d0) {
#pragma unroll
            for (int k2 = 0; k2 < 2; ++k2) { const int ks = 2 * hf + k2; const s16x4 lo_ = tr16(vb0 + d0 * 512 + ks * 8192), hi_ = tr16(vb0 + d0 * 512 + ks * 8192 + 4096);
                const bf16x8 vf = {lo_[0], lo_[1], lo_[2], lo_[3], hi_[0], hi_[1], hi_[2], hi_[3]};
                A.o[d0] = __builtin_amdgcn_mfma_f32_32x32x16_bf16(pa[k2], vf, A.o[d0], 0, 0, 0); }
            if (d0 & 1) SBAR();
        }
    }
}
DI void attn_dma_k(const Frame& F, int kr0, int h, int bufi, int l) {
    const unsigned char* Kg = F.ws + WS_K + ((size_t)kr0 * W_A + h * 256) * 2; const int w = F.wave;
#pragma unroll
    for (int i = 0; i < 4; ++i) { const int cc = w >> 2, m = 4 * (w & 3) + i, row = 4 * m + (l >> 4), ch = (l & 15) ^ (row & 7); const unsigned off = (unsigned)(row * W_A + cc * 128 + ch * 8) * 2u;
        glds16(Kg + off, LDS_A(F.lds) + (unsigned)__builtin_amdgcn_readfirstlane(AT_K + bufi * AT_KB + cc * 16384 + m * 1024)); }
}
DI void attn_dma_v(const Frame& F, int kr0, int h, int bufi, int l) {
    const unsigned char* Vg = F.ws + WS_V + ((size_t)kr0 * W_A + h * 256) * 2; const int w = F.wave;
#pragma unroll
    for (int i = 0; i < 4; ++i) { const int j = 4 * w + i, key = 2 * j + (l >> 5); const unsigned off = (unsigned)(key * W_A * 2) + (unsigned)((16 * (l & 31)) ^ ((key & 3) << 6));
        glds16(Vg + off, LDS_A(F.lds) + (unsigned)__builtin_amdgcn_readfirstlane(AT_V + bufi * AT_KB + j * 1024)); }
}
DI void attn_QK(const AttnW& A, f32x16& p0, f32x16& p1, const LAS unsigned char* Kc, int lane, float init) {
    const int r32 = lane & 31, hi = lane >> 5;
#pragma unroll
    for (int r = 0; r < 16; ++r) { p0[r] = init; p1[r] = init; }
    lds_a kb[4];
#pragma unroll
    for (int dd = 0; dd < 4; ++dd) kb[dd] = LDS_A(Kc) + (unsigned)(r32 * 256 + (((dd * 16 + hi * 8) * 2) ^ ((r32 & 7) << 4)));
    bf16x8 x0, x1, y0, y1;
#define KBATCH(d0, a0, a1) do { LDRD128(a0, kb[(d0) & 3], ((d0) >> 2) * 128); LDRD128(a1, kb[(d0) & 3], ((d0) >> 2) * 128 + 8192); } while (0)
#define KMMA(d0, a0, a1) do { p0 = __builtin_amdgcn_mfma_f32_32x32x16_bf16(a0, A.qr[d0], p0, 0, 0, 0); p1 = __builtin_amdgcn_mfma_f32_32x32x16_bf16(a1, A.qr[d0], p1, 0, 0, 0); } while (0)
#define LWAIT2(a, b) do { asm_lwait2(a, b); } while (0)
    KBATCH(0, x0, x1); LWAIT2(x0, x1);
    KBATCH(1, y0, y1); KMMA(0, x0, x1); LWAIT2(y0, y1);
    KBATCH(2, x0, x1); KMMA(1, y0, y1); LWAIT2(x0, x1);
    KBATCH(3, y0, y1); KMMA(2, x0, x1); LWAIT2(y0, y1);
    KBATCH(4, x0, x1); KMMA(3, y0, y1); LWAIT2(x0, x1);
    KBATCH(5, y0, y1); KMMA(4, x0, x1); LWAIT2(y0, y1);
    KBATCH(6, x0, x1); KMMA(5, y0, y1); LWAIT2(x0, x1);
    KBATCH(7, y0, y1); KMMA(6, x0, x1); LWAIT2(y0, y1);
    KMMA(7, y0, y1);
    PIN2(p0, p1);
#undef KBATCH
#undef KMMA
#undef LWAIT2
}
DI bool attn_SM(AttnW& A, f32x16& p0, f32x16& p1, bf16x8 (&pa)[4], const LAS float* tbl, LAS float* wsf, int lane, int tbi, int nvalid, bool first) {
    const int r32 = lane & 31, hi = lane >> 5;
    if (tbi >= 0) {
        const LAS float* tp = tbl + tbi + 4 * hi;
#pragma unroll
        for (int r = 0; r < 16; ++r) { const int c = (r & 3) + 8 * (r >> 2); p0[r] += tp[c]; p1[r] += tp[c + 32]; }
    }
    if (nvalid < 64) {
        const float NEG = -__builtin_inff();
#pragma unroll
        for (int r = 0; r < 16; ++r) { const int c = (r & 3) + 8 * (r >> 2) + 4 * hi; if (c >= nvalid) p0[r] = NEG; if (c + 32 >= nvalid) p1[r] = NEG; }
    }
    MFMA_PAD2(p0, p1);
    float pmax;
    { float a = max3f(p0[0], p0[1], p1[0]), b = max3f(p0[2], p0[3], p1[1]); a = max3f(a, p1[2], p1[3]);
#pragma unroll
      for (int r = 4; r < 16; r += 4) { a = max3f(a, p0[r], p0[r + 1]); b = max3f(b, p0[r + 2], p0[r + 3]); a = max3f(a, p1[r], p1[r + 1]); b = max3f(b, p1[r + 2], p1[r + 3]); }
      pmax = max2f(a, b); }
    VALU_PAD(pmax);
    { auto rr = __builtin_amdgcn_permlane32_swap(__float_as_uint(pmax), __float_as_uint(pmax), false, false); pmax = fmaxf(__uint_as_float(rr[0]), __uint_as_float(rr[1])); }
    bool resc = false;
    if (first || !__all(pmax <= THR_L2)) {
        const float delta = first ? pmax : fmaxf(pmax, 0.f);
#pragma unroll
        for (int r = 0; r < 16; ++r) { p0[r] -= delta; p1[r] -= delta; }
        const float alpha = first ? 0.f : fast_exp2(-delta);
        A.m += delta; A.l *= alpha; resc = !first; if (hi == 0) wsf[r32] = alpha;
    }
#pragma unroll
    for (int r = 0; r < 16; ++r) { p0[r] = fast_exp2(p0[r]); p1[r] = fast_exp2(p1[r]); }
    TRANS_PAD2(p0, p1);
    { float a = fadd_s(p0[0], p1[0]), b = fadd_s(p0[1], p1[1]);
#pragma unroll
      for (int r = 2; r < 16; r += 2) { a = fadd_s(a, p0[r]); b = fadd_s(b, p0[r + 1]); a = fadd_s(a, p1[r]); b = fadd_s(b, p1[r + 1]); }
      A.l += fadd_s(a, b); }
    pa[0] = pack8v(p0, 0, 1.f); pa[1] = pack8v(p0, 8, 1.f); pa[2] = pack8v(p1, 0, 1.f); pa[3] = pack8v(p1, 8, 1.f);
    PIN4(pa[0], pa[1], pa[2], pa[3]);
    return resc;
}
DI void attn_PV(AttnW& A, const bf16x8 (&pa)[4], const LAS unsigned char* Vt, const LAS float* wsf, int lane, bool resc) {
    const int hi = lane >> 5;
    if (resc) {
#pragma unroll
        for (int r = 0; r < 16; ++r) { const float al = wsf[crow(r, hi)];
#pragma unroll
            for (int d = 0; d < 8; ++d) A.o[d][r] *= al; }
    }
    lds_a vb[4];
    { const int q = (lane >> 2) & 3, pp = lane & 3, ch = (lane >> 4) & 1;
#pragma unroll
      for (int dd = 0; dd < 4; ++dd) vb[dd] = LDS_A(Vt) + (unsigned)((4 * hi + q) * 512 + ((64 * dd + 32 * ch + 8 * pp) ^ (q << 6))); }
    s16x4 xl0, xh0, xl1, xh1, yl0, yh0, yl1, yh1;
#define VBATCH(hb, l0, h0, l1, h1) do { TRRD(l0, vb[((hb) >> 1) & 3], ((hb) >> 3) * 256 + ((hb) & 1) * 16384); TRRD(h0, vb[((hb) >> 1) & 3], ((hb) >> 3) * 256 + ((hb) & 1) * 16384 + 4096); \
        TRRD(l1, vb[((hb) >> 1) & 3], ((hb) >> 3) * 256 + ((hb) & 1) * 16384 + 8192); TRRD(h1, vb[((hb) >> 1) & 3], ((hb) >> 3) * 256 + ((hb) & 1) * 16384 + 12288); } while (0)
#define VF(l, h) ((bf16x8){l[0], l[1], l[2], l[3], h[0], h[1], h[2], h[3]})
#define VMMA(hb, l0, h0, l1, h1) do { A.o[(hb) >> 1] = __builtin_amdgcn_mfma_f32_32x32x16_bf16(pa[2 * ((hb) & 1)], VF(l0, h0), A.o[(hb) >> 1], 0, 0, 0); \
        A.o[(hb) >> 1] = __builtin_amdgcn_mfma_f32_32x32x16_bf16(pa[2 * ((hb) & 1) + 1], VF(l1, h1), A.o[(hb) >> 1], 0, 0, 0); } while (0)
#define VSTEP2(hb) do { VBATCH((hb) + 1, yl0, yh0, yl1, yh1); VMMA(hb, xl0, xh0, xl1, xh1); LWAIT4(yl0, yh0, yl1, yh1); \
        VBATCH((hb) + 2, xl0, xh0, xl1, xh1); VMMA((hb) + 1, yl0, yh0, yl1, yh1); LWAIT4(xl0, xh0, xl1, xh1); } while (0)
    VBATCH(0, xl0, xh0, xl1, xh1); LWAIT4(xl0, xh0, xl1, xh1);
    VSTEP2(0); VSTEP2(2); VSTEP2(4); VSTEP2(6); VSTEP2(8); VSTEP2(10); VSTEP2(12);
    VBATCH(15, yl0, yh0, yl1, yh1); VMMA(14, xl0, xh0, xl1, xh1); LWAIT4(yl0, yh0, yl1, yh1);
    VMMA(15, yl0, yh0, yl1, yh1);
#undef VBATCH
#undef VF
#undef VMMA
#undef VSTEP2
}
DI void attn_epilogue(Frame& F, AttnW& A, int h, int row0, bool act, float lam, bool half_l) {
    int lane = F.lane; OPAQUE(lane);
    const int r32 = lane & 31, hi = lane >> 5, rg = F.wave & 3, c = F.wave >> 2;
    LAS float* wsf = (LAS float*)(F.lds + AT_WS + F.wave * 256);
    LAS float* ex = (LAS float*)(F.lds + rg * 32768);
    { float lt = A.l; if (half_l) lt += shfl_xor_l(lt, 32, lane); if (hi == 0) wsf[32 + r32] = lt; }
    WAIT_L(0); CFENCE();
    float rl[16];
#pragma unroll
    for (int r = 0; r < 16; ++r) rl[r] = fast_rcp(wsf[32 + crow(r, hi)]);
    if (c == 1 && act) {
#pragma unroll
        for (int d = 0; d < 8; ++d)
#pragma unroll
            for (int r = 0; r < 16; ++r) ex[crow(r, hi) * 256 + d * 32 + r32] = A.o[d][r] * rl[r] * lam;
    }
    WAIT_L(0); __syncthreads();
    if (c == 0 && act) {
        float sw[8];
#pragma unroll
        for (int d = 0; d < 8; ++d) sw[d] = F.P->in[IN_SUBLN][d * 32 + r32] * (1.0f - LAM_INIT);
#pragma unroll
        for (int r = 0; r < 16; ++r) { const int rr = (r & 3) + 8 * (r >> 2); float s = 0.f; float v[8];
#pragma unroll
            for (int d = 0; d < 8; ++d) { v[d] = A.o[d][r] * rl[r] - ex[(rr + 4 * hi) * 256 + d * 32 + r32]; s += v[d] * v[d]; }
            s += shfl_xor_l(s, 1, lane); s += shfl_xor_l(s, 2, lane); s += shfl_xor_l(s, 4, lane); s += shfl_xor_l(s, 8, lane); s += shfl_xor_l(s, 16, lane);
            const float rs = 1.0f / sqrtf(s * (1.f / 256.f) + EPS);
#pragma unroll
            for (int d = 0; d < 8; ++d) ex[(rr + 4 * hi) * 256 + d * 32 + r32] = v[d] * rs * sw[d];
            SBAR(); }
        WAIT_L(0); CFENCE();
        const bf16_t* GA = (const bf16_t*)(F.ws + WS_GA) + (size_t)(row0 + rg * 32 + hi) * W_A + (size_t)h * 256 + r32 * 8;
        bf16_t* YC = (bf16_t*)(F.ws + WS_YCAT) + (size_t)(row0 + rg * 32 + hi) * D_MODEL + (size_t)h * 256 + r32 * 8;
#pragma unroll 4
        for (int it = 0; it < 16; ++it) { const int row = 2 * it + hi;
            const f32x4 a = *(const LAS f32x4*)(ex + row * 256 + r32 * 8), b = *(const LAS f32x4*)(ex + row * 256 + r32 * 8 + 4);
            const u32x4 g = *(const u32x4*)(GA + (size_t)(2 * it) * W_A);
            u32x4 o; o.x = cvtpk(a[0] * lo_bf(g.x), a[1] * hi_bf(g.x)); o.y = cvtpk(a[2] * lo_bf(g.y), a[3] * hi_bf(g.y)); o.z = cvtpk(b[0] * lo_bf(g.z), b[1] * hi_bf(g.z)); o.w = cvtpk(b[2] * lo_bf(g.w), b[3] * hi_bf(g.w));
            *(u32x4*)(YC + (size_t)(2 * it) * D_MODEL) = o; }
        WAIT_L(0); CFENCE();
    }
    __syncthreads();
}
DI float diff_lambda(const Frame& F) {
    int l = F.lane; OPAQUE(l);
    float a = F.P->in[IN_LQ1][l] * F.P->in[IN_LK1][l] + F.P->in[IN_LQ1][l + 64] * F.P->in[IN_LK1][l + 64], b = F.P->in[IN_LQ2][l] * F.P->in[IN_LK2][l] + F.P->in[IN_LQ2][l + 64] * F.P->in[IN_LK2][l + 64];
#pragma unroll
    for (int o = 1; o < 64; o <<= 1) { a += shfl_xor_l(a, o, l); b += shfl_xor_l(b, o, l); }
    return __builtin_expf(a) - __builtin_expf(b) + LAM_INIT;
}
DI void attn_init(const Frame& F, AttnW& A, int h, int c, int qrow0) {
    int ln = F.lane; OPAQUE(ln);
    const bf16_t* Qg = (const bf16_t*)(F.ws + WS_Q) + (size_t)(qrow0 + (ln & 31)) * W_A + h * 256 + c * 128 + (ln >> 5) * 8;
#pragma unroll
    for (int d0 = 0; d0 < 8; ++d0) A.qr[d0] = *(const bf16x8*)(Qg + d0 * 16);
#pragma unroll
    for (int d = 0; d < 8; ++d) A.o[d] = (f32x16){};
    A.m = 0.f; A.l = 0.f;
}
DI void attn_load_table(const Frame& F, int h) { const float* T = (const float*)(F.ws + WS_TB) + (size_t)h * NTB; LAS float* t = (LAS float*)(F.lds + AT_TB); int t0 = F.tid; OPAQUE(t0); for (int i = t0; i < NTB; i += 512) t[i] = T[i]; }
DI void attn_prompt_unit(Frame& F, int h, int qb, float lam) {
    const int w = F.wave, rg = w & 3, c = w >> 2;
    const LAS float* tbl = (const LAS float*)(F.lds + AT_TB); LAS float* wsf = (LAS float*)(F.lds + AT_WS + w * 256);
    AttnW A; attn_init(F, A, h, c, qb * 128 + rg * 32);
    attn_load_table(F, h);
    const int q0w = qb * 128 + rg * 32, qc = q0w >> 6;
    const int NT = 2 * qb + 3;
    const int NTW = (qc + 2) < NT ? (qc + 2) : NT;
#define KROW(t) ((t) == 0 ? ROW_M0 : ((t) - 1) * 64)
    { int ln = F.lane; OPAQUE(ln); attn_dma_k(F, KROW(0), h, 0, ln); attn_dma_v(F, KROW(0), h, 0, ln); attn_dma_k(F, KROW(1), h, 1, ln); }
    WAIT_V(0); WAIT_L(0); __builtin_amdgcn_s_barrier();
    const float bu = tbl[0];
    bf16x8 pa[4]; f32x16 p0, p1; bool resc = false;
#define KPOS0(t) ((t) == 0 ? -N_META : ((t) - 1) * 64)
#define NEAR(t) (KPOS0(t) + 63 - q0w > -559)
#define DO_QK(t) do { int ln = F.lane; OPAQUE(ln); attn_QK(A, p0, p1, F.lds + AT_K + ((t) & 1) * AT_KB + c * 16384, ln, (NEAR(t) ? 0.f : bu) - A.m); } while (0)
#define DO_SM(t) do { int ln = F.lane; OPAQUE(ln); resc = attn_SM(A, p0, p1, pa, tbl, wsf, ln, NEAR(t) ? KPOS0(t) - (q0w + (ln & 31)) + TB_OFF : -1, (t) == 0 ? N_META : 64, (t) == 0); } while (0)
#define DO_PV(t) do { int ln = F.lane; OPAQUE(ln); attn_PV(A, pa, F.lds + AT_V + ((t) & 1) * AT_KB, wsf, ln, resc); } while (0)
#define END_SUB(issued) do { if (issued) { WAIT_V(4); } else { WAIT_V(0); } WAIT_L(0); __builtin_amdgcn_s_barrier(); } while (0)
#define DMA_K2(u) do { if ((u) < NT) { int ln = F.lane; OPAQUE(ln); attn_dma_k(F, KROW(u), h, (u) & 1, ln); } } while (0)
#define DMA_V2(u) do { if ((u) < NT) { int ln = F.lane; OPAQUE(ln); attn_dma_v(F, KROW(u), h, (u) & 1, ln); } } while (0)
    if (c == 0) {
        DO_QK(0); END_SUB(false);
        for (int t = 0; t < NT; ++t) {
            DMA_K2(t + 2); if (t < NTW) { DO_SM(t); if (t + 1 < NTW) DO_QK(t + 1); } END_SUB(t + 2 < NT);
            DMA_V2(t + 1); if (t < NTW) DO_PV(t); END_SUB(t + 1 < NT);
        }
        END_SUB(false);
    } else {
        DO_QK(0); END_SUB(false);
        DMA_K2(2); END_SUB(2 < NT);
        for (int t = 0; t < NT; ++t) {
            DMA_V2(t + 1); if (t < NTW) { DO_SM(t); if (t + 1 < NTW) DO_QK(t + 1); } END_SUB(t + 1 < NT);
            DMA_K2(t + 3); if (t < NTW) DO_PV(t); END_SUB(t + 3 < NT);
        }
    }
#undef KROW
#undef KPOS0
#undef NEAR
#undef DO_QK
#undef DO_SM
#undef DO_PV
#undef END_SUB
#undef DMA_K2
#undef DMA_V2
    attn_epilogue(F, A, h, qb * 128, true, lam, true);
}
DI void attn_sample_unit(Frame& F, int b, int h, float lam) {
    const int w = F.wave, rg = w & 3, c = w >> 2;
    const LAS float* tbl = (const LAS float*)(F.lds + AT_TB); LAS float* wsf = (LAS float*)(F.lds + AT_WS + w * 256);
    const bool act = rg == 0;
    AttnW A; attn_init(F, A, h, c, ROW_S0 + b * 32); A.m = -1e30f;
    attn_load_table(F, h);
    constexpr int NKEY = LCACHE + DEC_SEQ, NT = (NKEY + 63) / 64;
    const float* CK = F.P->in[IN_CK] + (size_t)b * LCACHE * W_A + h * 256; const float* CV = F.P->in[IN_CV] + (size_t)b * LCACHE * W_A + h * 256;
    const bf16_t* Kn = (const bf16_t*)(F.ws + WS_K) + (size_t)(ROW_S0 + b * 32) * W_A + h * 256; const bf16_t* Vn = (const bf16_t*)(F.ws + WS_V) + (size_t)(ROW_S0 + b * 32) * W_A + h * 256;
    __syncthreads();
    for (int t = 0; t < NT; ++t) {
        int tid = F.tid; OPAQUE(tid); const int lane = tid & 63, r32 = lane & 31;
        const int qpos = PAST_LEN + r32;
        const int key = tid >> 3, j = t * 64 + key, g8 = tid & 7;
#pragma unroll
        for (int kv = 0; kv < 2; ++kv) {
#pragma unroll
            for (int q4 = 0; q4 < 4; ++q4) { const int col = g8 * 32 + q4 * 8; u32x4 wv = {0u, 0u, 0u, 0u};
                if (j < LCACHE) { const float* sp = (kv ? CV : CK) + (size_t)j * W_A + col; const f32x4 a = *(const f32x4*)sp, bq = *(const f32x4*)(sp + 4);
                    wv.x = cvtpk(a[0], a[1]); wv.y = cvtpk(a[2], a[3]); wv.z = cvtpk(bq[0], bq[1]); wv.w = cvtpk(bq[2], bq[3]); }
                else if (j < NKEY) wv = *(const u32x4*)((kv ? Vn : Kn) + (size_t)(j - LCACHE) * W_A + col);
                if (kv == 0) { const int cc = col >> 7, chk = (col & 127) >> 3; *(LAS u32x4*)(F.lds + AT_K + cc * 16384 + key * 256 + ((chk ^ (key & 7)) << 4)) = wv; }
                else { const int kk = (key & ~0xC) | ((key & 4) << 1) | ((key & 8) >> 1); *(LAS u32x4*)(F.lds + AT_V + ((kk >> 3) * 8 + (col >> 5)) * 512 + ((kk & 7) * 32 + (col & 31)) * 2) = wv; } }
        }
        WAIT_VL0(); __syncthreads();
        if (act) { const int kpos0 = t * 64 - N_META; const int nv = NKEY - t * 64;
            attn_tile(A, F.lds + AT_K + c * 16384, F.lds + AT_V, tbl, wsf, lane, kpos0 - qpos + TB_OFF, 0.f, nv < 64 ? nv : 64); }
        WAIT_VL0(); __syncthreads();
    }
    attn_epilogue(F, A, h, ROW_S0 + b * 32, act, lam, false);
}
template <int MIXM, int QB = 0> DI void p4_mixer(Frame& F) {
    constexpr int NAP = NH_A * (SEQ / 128), NAS = DEC_BATCH * NH_A;
    const float lam = diff_lambda(F);
    if (MIXM & 1) { for (int u = F.vcu; u < N_SCAN_P; u += F.G) scan_unit(F, 0, u); }
#define DEQ(qi, uvar) do { __syncthreads(); if (F.tid == 0) F.MISC[16] = __hip_atomic_fetch_add(F.ctl + CW_QUEUE + 64 * (qi), 1u, __ATOMIC_RELAXED, __HIP_MEMORY_SCOPE_AGENT); __syncthreads(); uvar = (int)F.MISC[16]; uvar = __builtin_amdgcn_readfirstlane(uvar); } while (0)
    if (MIXM & 2) {
        const int h0 = (int)(xb_xcc_id() % (unsigned)NH_A);
        for (int hs = 0; hs < NH_A; ++hs) { const int hh = (h0 + hs) % NH_A;
            for (;;) { int a; DEQ(QB + 8 + hh, a); if (a >= SEQ / 128) break; attn_prompt_unit(F, hh, (SEQ / 128 - 1) - a, lam); } }
    }
    if (MIXM & 4) { for (;;) { int a; DEQ(QB + 1, a); if (a >= NAS) break; attn_sample_unit(F, a / NH_A, a % NH_A, lam); } }
    if (MIXM & 1) { for (;;) { int a; DEQ(QB + 2, a); if (a >= N_SCAN_S) break; scan_unit(F, 1, a); } }
#undef DEQ
}

constexpr int N_PHASES = 7;
#ifndef MK_N_LAUNCHES
#define MK_N_LAUNCHES 1
#endif
__global__ void __launch_bounds__(512, 2) hymba_fwd(Params p) {
#ifdef EMU
    unsigned char* lds_raw = emu::cur->block->lds;
#else
    extern __shared__ __attribute__((aligned(16))) unsigned char lds_raw[];
#endif
    Frame F;
    F.lds = (LAS unsigned char*)lds_raw; F.MISC = (volatile LAS unsigned*)(F.lds + MISC_OFF);
    F.wave = __builtin_amdgcn_readfirstlane((int)threadIdx.x >> 6); F.lane = lane_id(); F.tid = F.wave * 64 + F.lane;
    F.G = gridDim.x; { const int bx = blockIdx.x; F.vcu = (F.G % 8 == 0) ? (bx % 8) * (F.G / 8) + bx / 8 : bx; }
    F.P = &p; F.out = p.out; F.ws = p.ws; F.ctl = (unsigned*)(p.ws + WS_CTL);
    for (int u = F.tid; u < (LDS_BYTES - MISC_OFF) / 4; u += 512) ((LAS unsigned*)(F.lds + MISC_OFF))[u] = 0u;
    __syncthreads();
    const bool use_bar = (p.ph_hi - p.ph_lo) > 1;
    XcdBarrier bar; bar.bar = F.ctl + CW_BAR + p.li * XCD_BAR_WORDS; bar.x = 0; bar.st = nullptr; bar.wave = F.wave;
    if (use_bar) bar = xcd_barrier_post(F.ctl + CW_BAR + p.li * XCD_BAR_WORDS, F.MISC + 8, F.wave);
    const int lo = p.ph_lo, hi = p.ph_hi;
#ifdef ONLY_PHASE
#define IN(k) ((k) == ONLY_PHASE && lo <= (k) && (k) < hi)
#else
#define IN(k) (lo <= (k) && (k) < hi)
#endif
#ifdef EMU
#define PHMARK(k) ((void)0)
#else
#define PHMARK(k) asm volatile("; PHASE_MARK " #k ::: "memory")
#endif
#define SEAM(k) do { PHMARK(k); if (IN(k) && IN((k) + 1)) xcd_barrier(bar); F.lane = lane_id(); F.tid = F.wave * 64 + F.lane; } while (0)
#ifndef REPEAT_MASK
#define REPEAT_MASK 0
#endif
#define RBIT(k) ((((REPEAT_MASK) >> (k)) & 1) != 0)
#define P1BODY() do { p1a_skinny(F); __syncthreads(); pg8::Gemm g{(const bf16_t*)(F.ws + WS_XN), (const bf16_t*)(F.ws + WS_WINT), M_MAIN, N_MAIN, D_MODEL}; pg8::AlignedOrder S; S.init(M_MAIN, N_MAIN, F.G, (int)blockIdx.x); \
        EpiIn E{F.out, F.ws}; pg8::gemm_phase<EpiIn, pg8::AlignedOrder, PG8_ALIGN, PG8_SP2>(F.lds, g, S, E, F.wave); } while (0)
#define P5BODY() do { pg8::Gemm g{(const bf16_t*)(F.ws + WS_YCAT), (const bf16_t*)(F.ws + WS_WOUTT), R, D_MODEL, D_MODEL}; pg8::StaticOrder S; S.init(R, D_MODEL, F.G, (int)blockIdx.x); \
        EpiOut E{F.ws}; pg8::gemm_phase<EpiOut, pg8::StaticOrder, PG8_ALIGN, PG8_SP2>(F.lds, g, S, E, F.wave); } while (0)
    if (IN(0)) { p0_prologue(F); if constexpr (RBIT(0)) { __syncthreads(); p0_prologue(F); } } SEAM(0);
    if (IN(1)) { P1BODY(); if constexpr (RBIT(1)) { P1BODY(); } } SEAM(1);
    if (IN(2)) { p2_conv(F); if constexpr (RBIT(2)) { p2_conv(F); } } SEAM(2);
    if (IN(3)) { p3_prep(F); if constexpr (RBIT(3)) { p3_prep(F); } } SEAM(3);
#ifndef MIX_MAIN
#define MIX_MAIN 7
#endif
#ifndef MIX_REP
#define MIX_REP 7
#endif
    if (IN(4)) { p4_mixer<MIX_MAIN>(F); if constexpr (RBIT(4)) { __syncthreads(); p4_mixer<MIX_REP, 32>(F); } } SEAM(4);
    if (IN(5)) { P5BODY(); if constexpr (RBIT(5)) { P5BODY(); } } SEAM(5);
    if (IN(6)) { p5_final(F); if constexpr (RBIT(6)) { p5_final(F); } }
#undef IN
#undef SEAM
}

extern "C" void kernel_launch(void* const* d_in, const int* in_sizes, int n_in, void* d_out, int out_size, void* d_ws, size_t ws_size, hipStream_t stream) {
    static int grid = 0;
    if (grid == 0) {
        if (n_in != 21 || (size_t)out_size != O_END || ws_size < WS_END) { fprintf(stderr, "kernel_launch: shape/workspace mismatch (n_in %d out %d ws %zu need %zu)\n", n_in, out_size, ws_size, (size_t)WS_END); grid = -1; return; }
        int dev = 0, cus = 0;
        if (hipGetDevice(&dev) != hipSuccess || hipDeviceGetAttribute(&cus, hipDeviceAttributeMultiprocessorCount, dev) != hipSuccess) { grid = -1; return; }
        if (hipFuncSetAttribute((const void*)hymba_fwd, hipFuncAttributeMaxDynamicSharedMemorySize, LDS_BYTES) != hipSuccess) { fprintf(stderr, "kernel_launch: hipFuncSetAttribute failed\n"); grid = -1; return; }
        int per_cu = 0; (void)hipOccupancyMaxActiveBlocksPerMultiprocessor(&per_cu, (const void*)hymba_fwd, 512, LDS_BYTES); (void)hipGetLastError();
        grid = cus;
    }
    if (grid < 0) return;
    (void)hipMemsetAsync((char*)d_ws + WS_CTL, 0, CTL_ZERO_BYTES, stream);
    Params p{};
    for (int i = 0; i < 21; ++i) p.in[i] = (const float*)d_in[i];
    p.out = (float*)d_out; p.ws = (unsigned char*)d_ws; p.pad = 0;
#if MK_N_LAUNCHES == 1
    p.ph_lo = 0; p.ph_hi = N_PHASES; p.li = 0;
    hipLaunchKernelGGL(hymba_fwd, dim3(grid), dim3(512), LDS_BYTES, stream, p);
#else
    for (int k = 0; k < N_PHASES; ++k) { p.ph_lo = k; p.ph_hi = k + 1; p.li = 0; hipLaunchKernelGGL(hymba_fwd, dim3(grid), dim3(512), LDS_BYTES, stream, p); }
#endif
}
```

```cpp
#ifndef EMU
#include <hip/hip_runtime.h>
#endif
#include <cstdio>
#include <cstdint>

#define DI __device__ __forceinline__
#ifdef EMU
#define LAS
#define GAS
#define WAIT_V(n) emu::wave_op(emu::op_nop)
#define WAIT_L(n) emu::wave_op(emu::op_nop)
#define WAIT_VL0() emu::wave_op(emu::op_nop)
#define WAIT_V1(n) ((void)0)
#define CFENCE() ((void)0)
#define PINV(x) ((void)0)
#define OPAQUE(x) ((void)0)
#define PIN4(a, b, c, d) ((void)0)
#define PIN2(a, b) ((void)0)
#else
#define LAS __attribute__((address_space(3)))
#define GAS __attribute__((address_space(1)))
#define WAIT_V(n) asm volatile("s_waitcnt vmcnt(" #n ")" ::: "memory")
#define WAIT_L(n) asm volatile("s_waitcnt lgkmcnt(" #n ")" ::: "memory")
#define WAIT_VL0() asm volatile("s_waitcnt vmcnt(0) lgkmcnt(0)" ::: "memory")
#define WAIT_V1(n) asm volatile("s_waitcnt vmcnt(" #n ")" ::: "memory")
#define CFENCE() asm volatile("" ::: "memory")
#define OPAQUE(x) asm volatile("" : "+v"(x))
#define PIN4(a, b, c, d) asm volatile("" : "+v"(a), "+v"(b), "+v"(c), "+v"(d) :: "memory")
#define PIN2(a, b) asm volatile("" : "+v"(a), "+v"(b) :: "memory")
#define PINV(x) asm volatile("" : "+v"(x) :: "memory")
#endif
#define SBAR() __builtin_amdgcn_sched_barrier(0)

#if defined(MIDCFG)
constexpr int D_MODEL = 512, SEQ = 2048, DEC_BATCH = 2, PAST_LEN = 1024;
#elif defined(SMALLCFG)
constexpr int D_MODEL = 512, SEQ = 512, DEC_BATCH = 2, PAST_LEN = 128;
#else
constexpr int D_MODEL = 4096, SEQ = 16384, DEC_BATCH = 32, PAST_LEN = 1024;
#endif
constexpr int DEC_SEQ = 32, N_META = 16, CHUNK = 64;
constexpr int W_A = D_MODEL / 2, NH_A = W_A / 256, W_B = D_MODEL / 2, NH_B = W_B / 128, C3 = 3 * W_B;
constexpr int IN_COLS = 4 * W_A + 4 * W_B + 2 * NH_B;
constexpr int NS = DEC_BATCH * DEC_SEQ;
constexpr int ROW_S0 = SEQ, ROW_M0 = SEQ + NS, NROWS = ROW_M0 + N_META;
constexpr int R = (NROWS + 255) / 256 * 256;
constexpr int NP_IN = (IN_COLS + 255) / 256 * 256;
constexpr int LCACHE = N_META + PAST_LEN;
constexpr int TA = W_A / 256, TB = W_B / 256;
constexpr int NCH_P = SEQ / CHUNK + 1;
constexpr int NSC = NCH_P + DEC_BATCH;
constexpr float EPS = 1e-6f;
constexpr float LOG2E = 1.4426950408889634f;
constexpr float C2Q = 0.08838834764831845f * LOG2E;
constexpr float LAM_INIT = 0.2f;
constexpr size_t O_YP = 0, O_YS = O_YP + (size_t)SEQ * D_MODEL, O_KP = O_YS + (size_t)NS * D_MODEL, O_VP = O_KP + (size_t)(N_META + SEQ) * W_A,
                 O_SP = O_VP + (size_t)(N_META + SEQ) * W_A, O_CP = O_SP + (size_t)NH_B * 16384, O_KS = O_CP + (size_t)3 * C3, O_VS = O_KS + (size_t)NS * W_A,
                 O_SS = O_VS + (size_t)NS * W_A, O_CS = O_SS + (size_t)DEC_BATCH * NH_B * 16384, O_END = O_CS + (size_t)DEC_BATCH * 3 * C3;

typedef unsigned short bf16_t;
typedef short bf16x8 __attribute__((ext_vector_type(8)));
typedef short s16x4 __attribute__((ext_vector_type(4)));
typedef float f32x4 __attribute__((ext_vector_type(4)));
typedef float f32x2 __attribute__((ext_vector_type(2)));
typedef float f32x16 __attribute__((ext_vector_type(16)));
typedef unsigned u32x4 __attribute__((ext_vector_type(4)));
typedef unsigned u32x2 __attribute__((ext_vector_type(2)));

constexpr size_t al256(size_t x) { return (x + 255) / 256 * 256; }
constexpr size_t WS_CTL = 0, CTL_ZERO_BYTES = 1u << 20;
constexpr size_t SZ_WINT = (size_t)NP_IN * D_MODEL * 2, SZ_XN = (size_t)R * D_MODEL * 2, SZ_RA = (size_t)R * W_A * 2, SZ_QKVB = (size_t)R * C3 * 2;
constexpr int PKG_BYTES = 73728;
constexpr size_t SZ_PKG = (size_t)NSC * NH_B * PKG_BYTES;
constexpr size_t WS_WINT = al256(WS_CTL + CTL_ZERO_BYTES);
constexpr size_t WS_XN = WS_WINT + SZ_WINT;
constexpr size_t WS_QKVN = WS_WINT;
constexpr size_t WS_YCAT = WS_WINT;
constexpr size_t WS_WOUTT = al256(WS_XN + SZ_XN);
constexpr size_t WS_Q = al256(WS_WOUTT + (size_t)D_MODEL * D_MODEL * 2), WS_K = WS_Q + SZ_RA, WS_V = WS_K + SZ_RA, WS_GA = WS_V + SZ_RA, WS_GB = WS_GA + SZ_RA;
constexpr size_t WS_QKVB = al256(WS_GB + SZ_RA);
constexpr size_t WS_PKG = WS_QKVB, WS_Y = WS_QKVB;
constexpr size_t SZ_BIG = SZ_PKG > SZ_QKVB ? SZ_PKG : SZ_QKVB;
constexpr size_t WS_AB = al256(WS_QKVB + SZ_BIG);
constexpr size_t WS_BG = al256(WS_AB + (size_t)R * 32 * 4);
constexpr size_t WS_SS = al256(WS_BG + (size_t)R * NH_B * 8);
constexpr int NTB = 1280, TB_OFF = 1216;
constexpr size_t WS_TB = al256(WS_SS + (size_t)R * 64 * 4);
constexpr size_t WS_DEC = al256(WS_TB + (size_t)NH_A * NTB * 4);
constexpr size_t WS_END = al256(WS_DEC + (size_t)NSC * NH_B * 4);
static_assert(SZ_WINT + SZ_XN >= SZ_QKVB && SZ_WINT + SZ_XN >= SZ_XN, "overlay sizes");
static_assert((size_t)R * D_MODEL * 2 <= SZ_BIG, "Y fits the PKG region");

constexpr int CW_TMO = 0, CW_BAR = 4096, CW_QUEUE = 8192;
constexpr int RING_BYTES = 147456;
constexpr int MISC_OFF = RING_BYTES, LDS_BYTES = RING_BYTES + 512;

DI unsigned f2bf(float f) { unsigned u = __builtin_bit_cast(unsigned, f); return (u + 0x7fffu + ((u >> 16) & 1u)) >> 16; }
DI float bf2f(unsigned short b) { return __builtin_bit_cast(float, ((unsigned)b) << 16); }
#ifdef EMU
DI unsigned cvtpk(float lo, float hi) { return f2bf(lo) | (f2bf(hi) << 16); }
DI s16x4 tr16(const LAS void* p) { return emu_tr16((const void*)p); }
#else
typedef __bf16 bf16x2_t __attribute__((ext_vector_type(2)));
typedef short v4i16_t __attribute__((ext_vector_type(4)));
DI unsigned cvtpk(float lo, float hi) { f32x2 v = {lo, hi}; bf16x2_t b = __builtin_convertvector(v, bf16x2_t); return __builtin_bit_cast(unsigned, b); }
DI s16x4 tr16(const LAS void* p) { return __builtin_bit_cast(s16x4, __builtin_amdgcn_ds_read_tr16_b64_v4i16((LAS v4i16_t*)p)); }
#endif
DI int crow_c(int r, int h) { return (r & 3) + 8 * (r >> 2) + 4 * h; }
DI float lo_bf(unsigned w) { return __builtin_bit_cast(float, w << 16); }
DI float hi_bf(unsigned w) { return __builtin_bit_cast(float, w & 0xffff0000u); }
DI float fast_exp2(float x) { return __builtin_amdgcn_exp2f(x); }
DI float fast_rcp(float x) { return __builtin_amdgcn_rcpf(x); }
DI float silu_f(float x) { return x * fast_rcp(1.0f + fast_exp2(-x * LOG2E)); }
#ifdef EMU
DI int lane_id() { return emu::cur->lane; }
#else
DI int lane_id() { return (int)__builtin_amdgcn_mbcnt_hi(~0u, __builtin_amdgcn_mbcnt_lo(~0u, 0u)); }
#endif
#ifdef EMU
DI float shfl_xor_l(float v, int k, int lane) { (void)lane; return __shfl_xor(v, k); }
#else
DI float shfl_xor_l(float v, int k, int lane) { return __builtin_bit_cast(float, __builtin_amdgcn_ds_bpermute((lane ^ k) << 2, __builtin_bit_cast(int, v))); }
#endif
DI float wave_sum(float v) {
#pragma unroll
    for (int o = 1; o < 64; o <<= 1) v += __shfl_xor(v, o);
    return v;
}

#ifdef EMU
typedef const unsigned char* lds_a;
#define LDS_A(p) ((const unsigned char*)(p))
#define TRRD(dst, base, off) dst = tr16((base) + (off))
#define LDRD128(dst, base, off) dst = *(const bf16x8*)((base) + (off))
#define LWAIT8(a, b, c, d, e, f, g, h) WAIT_L(0)
#define LWAIT4(a, b, c, d) WAIT_L(0)
DI void glds16(const void* g, const unsigned char* l) { emu_glds16(g, (void*)l); }
template <class T> DI void asm_lwait2(T&, T&) { WAIT_L(0); }
#else
typedef unsigned lds_a;
#define LDS_A(p) ((unsigned)(size_t)(p))
#define TRRD(dst, base, off) asm volatile("ds_read_b64_tr_b16 %0, %1 offset:%2" : "=&v"(dst) : "v"(base), "i"(off) : "memory")
#define LDRD128(dst, base, off) asm volatile("ds_read_b128 %0, %1 offset:%2" : "=&v"(dst) : "v"(base), "i"(off) : "memory")
#define LWAIT8(a, b, c, d, e, f, g, h) do { asm volatile("s_waitcnt lgkmcnt(0)" : "+v"(a), "+v"(b), "+v"(c), "+v"(d), "+v"(e), "+v"(f), "+v"(g), "+v"(h) :: "memory"); SBAR(); } while (0)
#define LWAIT4(a, b, c, d) do { asm volatile("s_waitcnt lgkmcnt(0)" : "+v"(a), "+v"(b), "+v"(c), "+v"(d) :: "memory"); SBAR(); } while (0)
template <class T> DI void asm_lwait2(T& a, T& b) { asm volatile("s_waitcnt lgkmcnt(0)" : "+v"(a), "+v"(b) :: "memory"); SBAR(); }
DI void glds16(const void* gsrc, unsigned lds_dst) { unsigned keep;
    asm volatile("s_mov_b32 %0, m0\n\ts_mov_b32 m0, %2\n\ts_nop 0\n\tglobal_load_lds_dwordx4 %1, off\n\ts_mov_b32 m0, %0" : "=&s"(keep) : "v"(gsrc), "s"(lds_dst) : "memory"); }
#endif

#ifdef EMU
DI float max3f(float a, float b, float c) { return fmaxf(fmaxf(a, b), c); }
DI float max2f(float a, float b) { return fmaxf(a, b); }
DI float fadd_s(float a, float b) { return a + b; }
#define MFMA_PAD2(a, b) ((void)0)
#define VALU_PAD(x) ((void)0)
#define TRANS_PAD2(a, b) ((void)0)
#else
DI float max3f(float a, float b, float c) { float r; asm("v_max3_f32 %0, %1, %2, %3" : "=v"(r) : "v"(a), "v"(b), "v"(c)); return r; }
DI float max2f(float a, float b) { float r; asm("v_max_f32_e32 %0, %1, %2" : "=v"(r) : "v"(a), "v"(b)); return r; }
DI float fadd_s(float a, float b) { float r; asm("v_add_f32_e32 %0, %1, %2" : "=v"(r) : "v"(a), "v"(b)); return r; }
#define VALU_PAD(x) asm volatile("s_nop 1" : "+v"(x))
#define TRANS_PAD2(a, b) asm volatile("s_nop 3" : "+v"(a), "+v"(b))
#define MFMA_PAD2(a, b) asm volatile("s_nop 15\n\ts_nop 7" : "+v"(a), "+v"(b))
#endif
#define RLX_AGENT __ATOMIC_RELAXED, __HIP_MEMORY_SCOPE_AGENT

#define XB_TMO      128
#define XB_XCNT(j)  (256  + 64 * (j))
#define XB_XSUB(j)  (1280 + 64 * (j))
#define XB_XGEN(j)  (2304 + 64 * (j))
#define XB_TOP      3328
#define XB_TOPGEN   3392
#define XCD_BAR_WORDS 3456
#define XB_SPIN_CAP (1u << 18)
DI unsigned xb_ld(unsigned* p)              { return __hip_atomic_load(p, __ATOMIC_RELAXED, __HIP_MEMORY_SCOPE_AGENT); }
DI unsigned xb_add(unsigned* p, unsigned v) { return __hip_atomic_fetch_add(p, v, __ATOMIC_RELAXED, __HIP_MEMORY_SCOPE_AGENT); }
DI unsigned xb_xcc_id() { return (unsigned)__builtin_amdgcn_s_getreg((3 << 11) | 20) & 0xFu; }
#define XB_SPIN(cond, bar) do { unsigned _sp = 0; while (cond) { __builtin_amdgcn_s_sleep(1); \
    if ((++_sp & 255u) == 0u) { if (xb_ld(&(bar)[XB_TMO])) break; if (_sp > XB_SPIN_CAP) { atomicAdd(&(bar)[XB_TMO], 1u); break; } } } } while (0)
struct XcdBarrier { unsigned* bar; unsigned x; volatile LAS unsigned* st; int wave; };
DI XcdBarrier xcd_barrier_post(unsigned* bar, volatile LAS unsigned* st, int wave) {
    XcdBarrier b; b.bar = bar; b.x = xb_xcc_id(); b.st = st; b.wave = wave;
    if (wave == 0 && lane_id() == 0) (void)xb_add(&bar[XB_XCNT(b.x)], 1u);
    return b;
}
DI void xcd_barrier_complete(unsigned* bar, unsigned x, unsigned& nloc, unsigned& nx) {
    const unsigned G = gridDim.x * gridDim.y * gridDim.z;
    unsigned sum, cnt, mine, sp = 0u;
    for (;;) {
        sum = 0u; cnt = 0u; mine = 0u;
#pragma unroll
        for (unsigned j = 0; j < 16; ++j) { const unsigned c = xb_ld(&bar[XB_XCNT(j)]); sum += c; cnt += (c > 0u) ? 1u : 0u; mine = (j == x) ? c : mine; }
        if (sum == G) break;
        __builtin_amdgcn_s_sleep(1);
        if ((++sp & 255u) == 0u) { if (xb_ld(&bar[XB_TMO])) break; if (sp > XB_SPIN_CAP) { atomicAdd(&bar[XB_TMO], 1u); break; } }
    }
    nloc = mine > 0u ? mine : 1u; nx = cnt > 0u ? cnt : 1u;
}
DI void xcd_barrier(const XcdBarrier& b) {
    WAIT_V(0);
    __syncthreads();
    if (b.wave == 0 && lane_id() == 0) {
        unsigned* bar = b.bar;
        __builtin_amdgcn_s_waitcnt(0);
        unsigned nloc = b.st[0], nx = b.st[1];
        if (nloc == 0u) { xcd_barrier_complete(bar, b.x, nloc, nx); b.st[0] = nloc; b.st[1] = nx; }
        const unsigned old = xb_add(&bar[XB_XSUB(b.x)], 1u);
        const unsigned gen = old / nloc;
        if (old + 1u == (gen + 1u) * nloc) {
            __builtin_amdgcn_fence(__ATOMIC_RELEASE, "agent");
            WAIT_V1(0);
            const unsigned og = xb_add(&bar[XB_TOP], 1u);
            const unsigned tg = og / nx;
            if (og + 1u == (tg + 1u) * nx) xb_add(&bar[XB_TOPGEN], 1u);
            else XB_SPIN(xb_ld(&bar[XB_TOPGEN]) == tg, bar);
            __builtin_amdgcn_fence(__ATOMIC_ACQUIRE, "agent");
            xb_add(&bar[XB_XGEN(b.x)], 1u);
            WAIT_V1(0);
        } else {
            XB_SPIN(xb_ld(&bar[XB_XGEN(b.x)]) == gen, bar);
            __builtin_amdgcn_fence(__ATOMIC_ACQUIRE, "agent");
            WAIT_V1(0);
        }
    }
    __syncthreads();
}

namespace pg8 {
constexpr int BM = 256, BK = 64, HALF = 128, HTB = HALF * BK * 2, STAGE_BYTES = 8 * HTB, NXCD = 8, WGM = 8;
DI int lds_byte(int r, int c) { const int st = (r >> 4) * 2 + (c >> 5), rr = r & 15, cc = c & 31, ob = rr * 64 + cc * 2; return st * 1024 + (ob ^ (((ob >> 9) & 1) << 5)); }
DI void stage_rc(int b, int& R_, int& C_) { const int st = b / 1024, sb = b % 1024, swz = sb ^ (((sb >> 9) & 1) << 5); R_ = (st >> 1) * 16 + swz / 64; C_ = (st & 1) * 32 + (swz % 64) / 2; }
DI int perm32(int rho) { const int n = rho >> 4, i = rho & 15; return 8 * (i >> 2) + 4 * n + (i & 3); }
struct Unit { int pm, pn; };
struct Gemm { const bf16_t* A; const bf16_t* Bt; int M, N, K; };
struct StaticOrder {
    int nM, nN, nwg, G, c;
    DI void init(int M, int N, int G_, int c_) { nM = M / BM; nN = N / BM; nwg = nM * nN; G = G_; c = c_; }
    DI bool next(int i, Unit& u) const {
        const long L = (long)i * G + c; if (L >= nwg) return false;
        int wgid = (int)L; { const int q = nwg / NXCD, r = nwg % NXCD, xcd = wgid % NXCD, off = wgid / NXCD; wgid = (xcd < r ? xcd * (q + 1) : r * (q + 1) + (xcd - r) * q) + off; }
        const int nig = WGM * nN, gid = wgid / nig, fm = gid * WGM, gsz = (nM - fm) < WGM ? (nM - fm) : WGM;
        u.pm = fm + ((wgid % nig) % gsz); u.pn = (wgid % nig) / gsz; return true;
    }
    DI void a_ready(const Unit&) const {}
    DI void done(const Unit&) const {}
};
struct AlignedOrder {
    StaticOrder so; bool al;
    DI void init(int M, int N, int G_, int c_) { so.init(M, N, G_, c_); al = (G_ == 256 && so.nM == 68 && so.nN == 64); }
    DI bool next(int i, Unit& u) const {
        if (!al) return so.next(i, u);
        if (i > 16) return false;
        const int xcd = so.c & 7, slot = so.c >> 3;
        if (i < 16) { u.pm = 8 * xcd + (slot & 7); u.pn = 4 * i + (slot >> 3); } else { u.pm = 64 + (slot & 3); u.pn = 8 * xcd + (slot >> 2); }
        return true;
    }
    DI void a_ready(const Unit&) const {}
    DI void done(const Unit&) const {}
};
template <class Epi, class Sched, bool ALIGN_EPI = false, bool SP2 = false>
DI void gemm_phase(LAS unsigned char* lds, const Gemm g, const Sched& S, const Epi& E, int wid) {
    const int lane = lane_id(), tid = wid * 64 + lane, wr = wid >> 2, wc = wid & 3, fr = lane & 15, fq = lane >> 4;
    const int K = g.K, nt = K / BK;
    unsigned voffA[2], voffB[2];
#pragma unroll
    for (int i = 0; i < 2; ++i) { int R_, C_; stage_rc(tid * 16 + i * 8192, R_, C_); const int Rb = Epi::PERM ? ((R_ & ~31) + perm32(R_ & 31)) : R_;
        voffA[i] = (unsigned)(R_ * K + C_) * 2u; voffB[i] = (unsigned)(Rb * K + C_) * 2u; }
    const size_t kstep = (size_t)(BK * 2);
    const size_t hstep = (size_t)HALF * K * 2;
    const size_t tstep = 2 * hstep;
    const unsigned ldsw = (unsigned)wid * 1024u;
    const int aoff = lds_byte(wr * 64 + fr, fq * 8), boff = lds_byte(wc * 32 + fr, fq * 8);
#define PG8_SA(b, h) (((b) * 2 + (h)) * HTB)
#define PG8_SB(b, h) ((4 + (b) * 2 + (h)) * HTB)
#define PG8_STAGE(bufoff, gbase, voff) do { _Pragma("unroll") for (int _i = 0; _i < 2; ++_i) \
        __builtin_amdgcn_global_load_lds((const unsigned*)((const char*)(gbase) + (voff)[_i]), (LAS unsigned*)(lds + (bufoff) + ldsw + _i * 8192), 16, 0, 0); } while (0)
#define PG8_LDA(dst, b, h) do { _Pragma("unroll") for (int m = 0; m < 4; ++m) _Pragma("unroll") for (int k = 0; k < 2; ++k) dst[m][k] = *(const LAS bf16x8*)(lds + PG8_SA(b, h) + aoff + m * 2048 + k * 1024); } while (0)
#define PG8_LDB(dst, b, h) do { _Pragma("unroll") for (int n = 0; n < 2; ++n) _Pragma("unroll") for (int k = 0; k < 2; ++k) dst[n][k] = *(const LAS bf16x8*)(lds + PG8_SB(b, h) + boff + n * 2048 + k * 1024); } while (0)
#define PG8_MMA(ai, bj, At, Bt) do { __builtin_amdgcn_s_setprio(1); _Pragma("unroll") for (int m = 0; m < 4; ++m) _Pragma("unroll") for (int n = 0; n < 2; ++n) _Pragma("unroll") for (int k = 0; k < 2; ++k) \
        acc[ai][bj][m][n] = __builtin_amdgcn_mfma_f32_16x16x32_bf16(Bt[n][k], At[m][k], acc[ai][bj][m][n], 0, 0, 0); __builtin_amdgcn_s_setprio(0); } while (0)
#define PG8_WAIT_V(n) WAIT_V(n)
#define PG8_WAIT_L(n) WAIT_L(n)
#define PG8_BAR __builtin_amdgcn_s_barrier()
#define PG8_SCHED __builtin_amdgcn_sched_barrier(0)
    Unit cur, nxt; int ui = 0;
    if (!S.next(0, cur)) return;
    f32x4 acc[2][2][4][2];
#pragma unroll
    for (int a = 0; a < 2; ++a)
#pragma unroll
        for (int b = 0; b < 2; ++b)
#pragma unroll
            for (int m = 0; m < 4; ++m)
#pragma unroll
                for (int n = 0; n < 2; ++n) acc[a][b][m][n] = (f32x4){0.f, 0.f, 0.f, 0.f};
    bf16x8 At[4][2], B0[2][2], B1[2][2];
    const char* cA = (const char*)g.A + (size_t)cur.pm * tstep; const char* cB = (const char*)g.Bt + (size_t)cur.pn * tstep;
    S.a_ready(cur);
    if constexpr (SP2) {
        PG8_STAGE(PG8_SB(0, 0), cB, voffB); PG8_STAGE(PG8_SB(0, 1), cB + hstep, voffB); PG8_STAGE(PG8_SA(0, 0), cA, voffA); PG8_STAGE(PG8_SA(0, 1), cA + hstep, voffA);
        if (wr == 1) PG8_BAR;
        PG8_WAIT_V(2); PG8_BAR;
        PG8_STAGE(PG8_SB(1, 0), cB + kstep, voffB); PG8_STAGE(PG8_SA(1, 0), cA + kstep, voffA); PG8_STAGE(PG8_SB(1, 1), cB + hstep + kstep, voffB);
        PG8_WAIT_V(6); PG8_BAR;
    } else {
        PG8_STAGE(PG8_SB(0, 0), cB, voffB); PG8_STAGE(PG8_SA(0, 0), cA, voffA); PG8_STAGE(PG8_SB(0, 1), cB + hstep, voffB); PG8_STAGE(PG8_SA(0, 1), cA + hstep, voffA);
        if (wr == 1) PG8_BAR;
        PG8_WAIT_V(4); PG8_BAR;
        PG8_STAGE(PG8_SB(1, 0), cB + kstep, voffB); PG8_STAGE(PG8_SA(1, 0), cA + kstep, voffA); PG8_STAGE(PG8_SB(1, 1), cB + hstep + kstep, voffB);
        PG8_WAIT_V(6); PG8_BAR;
    }
    for (;;) {
        const bool has_next = S.next(ui + 1, nxt);
        const char* nA = has_next ? (const char*)g.A + (size_t)nxt.pm * tstep : cA; const char* nB = has_next ? (const char*)g.Bt + (size_t)nxt.pn * tstep : cB;
        for (int t = 0; t < nt; t += 2) {
            const bool last = (t == nt - 2);
            const char* a1 = cA + (size_t)(t + 1) * kstep;
            const char* a2 = last ? nA : cA + (size_t)(t + 2) * kstep; const char* b2 = last ? nB : cB + (size_t)(t + 2) * kstep;
            const char* a3 = a2 + kstep; const char* b3 = b2 + kstep;
            if (last && has_next) S.a_ready(nxt);
            if constexpr (SP2) {
            PG8_LDB(B0, 0, 0); PG8_LDB(B1, 0, 1); PG8_SCHED; PG8_LDA(At, 0, 0); PG8_STAGE(PG8_SA(1, 1), a1 + hstep, voffA);
            PG8_WAIT_V(8); PG8_WAIT_L(0); PG8_BAR; PG8_MMA(0, 0, At, B0); PG8_MMA(0, 1, At, B1); PG8_BAR; PG8_SCHED;
            PG8_LDA(At, 0, 1); PG8_STAGE(PG8_SB(0, 0), b2, voffB); PG8_STAGE(PG8_SB(0, 1), b2 + hstep, voffB); PG8_STAGE(PG8_SA(0, 0), a2, voffA);
            PG8_WAIT_V(8); PG8_WAIT_L(0); PG8_BAR; PG8_MMA(1, 0, At, B0); PG8_MMA(1, 1, At, B1); PG8_BAR; PG8_SCHED;
            PG8_LDB(B0, 1, 0); PG8_LDB(B1, 1, 1); PG8_SCHED; PG8_LDA(At, 1, 0); PG8_STAGE(PG8_SA(0, 1), a2 + hstep, voffA);
            PG8_WAIT_V(8); PG8_WAIT_L(0); PG8_BAR; PG8_MMA(0, 0, At, B0); PG8_MMA(0, 1, At, B1); PG8_BAR; PG8_SCHED;
            PG8_LDA(At, 1, 1); PG8_STAGE(PG8_SB(1, 0), b3, voffB); PG8_STAGE(PG8_SB(1, 1), b3 + hstep, voffB); PG8_STAGE(PG8_SA(1, 0), a3, voffA);
            PG8_WAIT_V(8); PG8_WAIT_L(0); PG8_BAR; PG8_MMA(1, 0, At, B0); PG8_MMA(1, 1, At, B1); PG8_BAR; PG8_SCHED;
            } else {
            PG8_LDB(B0, 0, 0); PG8_SCHED; PG8_LDA(At, 0, 0); PG8_STAGE(PG8_SA(1, 1), a1 + hstep, voffA);
            PG8_WAIT_L(8); PG8_BAR; PG8_WAIT_L(0); PG8_MMA(0, 0, At, B0); PG8_BAR; PG8_SCHED;
            PG8_LDB(B1, 0, 1); PG8_STAGE(PG8_SB(0, 0), b2, voffB);
            PG8_BAR; PG8_WAIT_L(0); PG8_MMA(0, 1, At, B1); PG8_BAR;
            PG8_LDA(At, 0, 1); PG8_STAGE(PG8_SA(0, 0), a2, voffA);
            PG8_BAR; PG8_WAIT_L(0); PG8_MMA(1, 0, At, B0); PG8_BAR; PG8_SCHED;
            PG8_STAGE(PG8_SB(0, 1), b2 + hstep, voffB);
            PG8_WAIT_V(6); PG8_BAR; PG8_MMA(1, 1, At, B1); PG8_BAR;
            PG8_LDB(B0, 1, 0); PG8_SCHED; PG8_LDA(At, 1, 0); PG8_STAGE(PG8_SA(0, 1), a2 + hstep, voffA);
            PG8_WAIT_L(8); PG8_BAR; PG8_WAIT_L(0); PG8_MMA(0, 0, At, B0); PG8_BAR; PG8_SCHED;
            PG8_LDB(B1, 1, 1); PG8_STAGE(PG8_SB(1, 0), b3, voffB);
            PG8_BAR; PG8_WAIT_L(0); PG8_MMA(0, 1, At, B1); PG8_BAR;
            PG8_LDA(At, 1, 1); PG8_STAGE(PG8_SA(1, 0), a3, voffA);
            PG8_BAR; PG8_WAIT_L(0); PG8_MMA(1, 0, At, B0); PG8_BAR; PG8_SCHED;
            PG8_STAGE(PG8_SB(1, 1), b3 + hstep, voffB);
            PG8_WAIT_V(6); PG8_BAR; PG8_MMA(1, 1, At, B1); PG8_BAR;
            }
        }
        if constexpr (ALIGN_EPI) { if (wr == 0) PG8_BAR; }
        E(acc, cur, wr, wc, fr, fq); S.done(cur);
        if (!has_next) break;
#pragma unroll
        for (int a = 0; a < 2; ++a)
#pragma unroll
            for (int b = 0; b < 2; ++b)
#pragma unroll
                for (int m = 0; m < 4; ++m)
#pragma unroll
                    for (int n = 0; n < 2; ++n) acc[a][b][m][n] = (f32x4){0.f, 0.f, 0.f, 0.f};
        cur = nxt; cA = nA; cB = nB; ++ui;
        if constexpr (ALIGN_EPI) { if (wr == 1) PG8_BAR; }
    }
    PG8_WAIT_V(0);
    if constexpr (!ALIGN_EPI) { if (wr == 0) PG8_BAR; }
    PG8_BAR;
#undef PG8_SA
#undef PG8_SB
#undef PG8_STAGE
#undef PG8_LDA
#undef PG8_LDB
#undef PG8_MMA
#undef PG8_WAIT_V
#undef PG8_WAIT_L
#undef PG8_BAR
#undef PG8_SCHED
}
}
#ifndef PG8_SP2
#define PG8_SP2 true
#endif
#ifndef PG8_ALIGN
#define PG8_ALIGN true
#endif

struct Params {
    const float* in[21]; float* out; unsigned char* ws; int ph_lo, ph_hi, li, pad;
};
struct Frame {
    LAS unsigned char* lds; volatile LAS unsigned* MISC; unsigned* ctl;
    int tid, lane, wave, vcu, G;
    const Params* P; float* out; unsigned char* ws;
};
enum { IN_XP = 0, IN_XS, IN_CK, IN_CV, IN_SSM, IN_CONVS, IN_META, IN_RELB, IN_PREN, IN_WIN, IN_LQ1, IN_LK1, IN_LQ2, IN_LK2, IN_SUBLN, IN_CONVW, IN_ALOG, IN_DTB, IN_NORMB, IN_WOUT, IN_POSTN };

DI const float* src_row(const Frame& F, int r) {
    if (r < ROW_S0) return F.P->in[IN_XP] + (size_t)r * D_MODEL;
    if (r < ROW_M0) return F.P->in[IN_XS] + (size_t)(r - ROW_S0) * D_MODEL;
    if (r < NROWS) return F.P->in[IN_META] + (size_t)(r - ROW_M0) * D_MODEL;
    return nullptr;
}

DI void p0_transpose_item(const float* W, int K, int N, bf16_t* WT, LAS float* scr, int item, int nblk, int lane) {
    const int kb = item / nblk, nb = item % nblk, k0 = 64 * kb, n0 = 64 * nb;
    const int c4 = (lane & 15) * 4, r0 = lane >> 4;
    f32x4 v[16];
#pragma unroll
    for (int i = 0; i < 16; ++i) { const int kk = 4 * i + r0; v[i] = (n0 + c4 < N) ? *(const f32x4*)(W + (size_t)(k0 + kk) * N + n0 + c4) : (f32x4){0.f, 0.f, 0.f, 0.f}; }
#pragma unroll
    for (int i = 0; i < 16; ++i) { const int kk = 4 * i + r0; LAS float* d = scr + kk * 65 + c4; d[0] = v[i][0]; d[1] = v[i][1]; d[2] = v[i][2]; d[3] = v[i][3]; }
    WAIT_L(0); CFENCE();
    const int c = lane & 7;
#pragma unroll
    for (int j = 0; j < 8; ++j) { const int n = (lane >> 3) + 8 * j; const LAS float* sp = scr + (8 * c) * 65 + n;
        u32x4 o; o.x = cvtpk(sp[0 * 65], sp[1 * 65]); o.y = cvtpk(sp[2 * 65], sp[3 * 65]); o.z = cvtpk(sp[4 * 65], sp[5 * 65]); o.w = cvtpk(sp[6 * 65], sp[7 * 65]);
        *(u32x4*)(WT + (size_t)(n0 + n) * K + k0 + 8 * c) = o; }
    WAIT_L(0); CFENCE();
}
DI int rel_bucket_dev(int rel) {
    const int n = rel < 0 ? -rel : rel;
    int b = n < 8 ? n : 8 + (n >= 15) + (n >= 27) + (n >= 50) + (n >= 91) + (n >= 166) + (n >= 305) + (n >= 559);
    return (rel > 0 ? 16 : 0) + b;
}
DI void p0_prologue(Frame& F) {
    LAS float* scr = (LAS float*)(F.lds + F.wave * 16896);
    const int gw = F.vcu * 8 + F.wave, NGW = F.G * 8;
    bf16_t* WinT = (bf16_t*)(F.ws + WS_WINT); bf16_t* WoutT = (bf16_t*)(F.ws + WS_WOUTT); bf16_t* XN = (bf16_t*)(F.ws + WS_XN);
    constexpr int NB_IN = NP_IN / 64, I_IN = (D_MODEL / 64) * NB_IN, NB_O = D_MODEL / 64, I_O = (D_MODEL / 64) * NB_O;
    for (int it = gw; it < I_IN + I_O; it += NGW) {
        if (it < I_IN) p0_transpose_item(F.P->in[IN_WIN], D_MODEL, IN_COLS, WinT, scr, it, NB_IN, F.lane);
        else p0_transpose_item(F.P->in[IN_WOUT], D_MODEL, D_MODEL, WoutT, scr, it - I_IN, NB_O, F.lane);
    }
    constexpr int NJ = D_MODEL / 256;
    for (int r = gw; r < R; r += NGW) {
        const float* xr = src_row(F, r);
        unsigned long long* o8 = (unsigned long long*)(XN + (size_t)r * D_MODEL) + F.lane;
        if (!xr) {
#pragma unroll
            for (int j = 0; j < NJ; ++j) o8[64 * j] = 0ull;
            continue; }
        f32x4 v[NJ]; float s = 0.f;
#pragma unroll
        for (int j = 0; j < NJ; ++j) { v[j] = ((const f32x4*)xr)[F.lane + 64 * j]; s += (v[j].x * v[j].x + v[j].y * v[j].y) + (v[j].z * v[j].z + v[j].w * v[j].w); }
        const float rs = 1.0f / sqrtf(wave_sum(s) * (1.f / D_MODEL) + EPS);
#pragma unroll
        for (int j = 0; j < NJ; ++j) { const f32x4 w = ((const f32x4*)F.P->in[IN_PREN])[F.lane + 64 * j];
            o8[64 * j] = (unsigned long long)cvtpk(v[j].x * rs * w.x, v[j].y * rs * w.y) | ((unsigned long long)cvtpk(v[j].z * rs * w.z, v[j].w * rs * w.w) << 32); }
    }
    float* TBL = (float*)(F.ws + WS_TB);
    for (int i = F.vcu * 512 + F.tid; i < NH_A * NTB; i += F.G * 512) { const int h = i / NTB, idx = i % NTB; TBL[i] = F.P->in[IN_RELB][rel_bucket_dev(idx - TB_OFF) * NH_A + h] * LOG2E; }
}

struct EpiIn {
    static constexpr bool PERM = true;
    float* out; unsigned char* ws;
    DI void operator()(const f32x4 (&acc)[2][2][4][2], const pg8::Unit& u, int wr, int wc, int fr, int fq) const {
        const int pn = u.pn; const int row0 = u.pm * 256 + wr * 64 + fr;
        int seg, colt;
        if (pn < 4 * TA) { seg = pn / TA; colt = (pn - seg * TA) * 256; }
        else if (pn < 4 * TA + 3 * TB) { seg = 4; colt = (pn - 4 * TA) * 256; }
        else if (pn < 4 * TA + 4 * TB) { seg = 5; colt = (pn - 4 * TA - 3 * TB) * 256; }
        else { seg = 6; colt = 0; }
        const int col0 = colt + wc * 32 + 8 * fq;
#pragma unroll
        for (int ai = 0; ai < 2; ++ai)
#pragma unroll
            for (int m = 0; m < 4; ++m) {
                const int r = row0 + ai * 128 + m * 16;
#pragma unroll
                for (int bj = 0; bj < 2; ++bj) {
                    const f32x4 v0 = acc[ai][bj][m][0], v1 = acc[ai][bj][m][1]; const int col = col0 + bj * 128;
                    if (seg == 0) { u32x4 w; w.x = cvtpk(v0[0] * C2Q, v0[1] * C2Q); w.y = cvtpk(v0[2] * C2Q, v0[3] * C2Q); w.z = cvtpk(v1[0] * C2Q, v1[1] * C2Q); w.w = cvtpk(v1[2] * C2Q, v1[3] * C2Q);
                        *(u32x4*)((bf16_t*)(ws + WS_Q) + (size_t)r * W_A + col) = w; }
                    else if (seg == 1 || seg == 2) {
                        u32x4 w; w.x = cvtpk(v0[0], v0[1]); w.y = cvtpk(v0[2], v0[3]); w.z = cvtpk(v1[0], v1[1]); w.w = cvtpk(v1[2], v1[3]);
                        *(u32x4*)((bf16_t*)(ws + (seg == 1 ? WS_K : WS_V)) + (size_t)r * W_A + col) = w;
                        float* o = nullptr;
                        if (r < ROW_S0) o = out + (seg == 1 ? O_KP : O_VP) + (size_t)(N_META + r) * W_A;
                        else if (r < ROW_M0) o = out + (seg == 1 ? O_KS : O_VS) + (size_t)(r - ROW_S0) * W_A;
                        else if (r < NROWS) o = out + (seg == 1 ? O_KP : O_VP) + (size_t)(r - ROW_M0) * W_A;
                        if (o) { *(f32x4*)(o + col) = v0; *(f32x4*)(o + col + 4) = v1; } }
                    else if (seg == 3 || seg == 5) {
                        u32x4 w; w.x = cvtpk(silu_f(v0[0]), silu_f(v0[1])); w.y = cvtpk(silu_f(v0[2]), silu_f(v0[3])); w.z = cvtpk(silu_f(v1[0]), silu_f(v1[1])); w.w = cvtpk(silu_f(v1[2]), silu_f(v1[3]));
                        *(u32x4*)((bf16_t*)(ws + (seg == 3 ? WS_GA : WS_GB)) + (size_t)r * W_A + col) = w; }
                    else if (seg == 4) {
                        u32x4 w; w.x = cvtpk(v0[0], v0[1]); w.y = cvtpk(v0[2], v0[3]); w.z = cvtpk(v1[0], v1[1]); w.w = cvtpk(v1[2], v1[3]);
                        *(u32x4*)((bf16_t*)(ws + WS_QKVB) + (size_t)r * C3 + col) = w;
                        float* o = nullptr;
                        if (r >= SEQ - 3 && r < SEQ) o = out + O_CP + (size_t)(r - (SEQ - 3)) * C3;
                        else if (r >= ROW_S0 && r < ROW_M0 && ((r - ROW_S0) & 31) >= 29) o = out + O_CS + (size_t)(((r - ROW_S0) >> 5) * 3 + (((r - ROW_S0) & 31) - 29)) * C3;
                        if (o) { *(f32x4*)(o + col) = v0; *(f32x4*)(o + col + 4) = v1; } }
                    else { if (col < 32) { float* o = (float*)(ws + WS_AB) + (size_t)r * 32 + col; *(f32x4*)o = v0; *(f32x4*)(o + 4) = v1; } }
                }
            }
    }
};

struct EpiOut {
    static constexpr bool PERM = true;
    unsigned char* ws;
    DI void operator()(const f32x4 (&acc)[2][2][4][2], const pg8::Unit& u, int wr, int wc, int fr, int fq) const {
        const int row0 = u.pm * 256 + wr * 64 + fr, col0 = u.pn * 256 + wc * 32 + 8 * fq;
        bf16_t* Y = (bf16_t*)(ws + WS_Y); float* SSp = (float*)(ws + WS_SS);
#pragma unroll
        for (int ai = 0; ai < 2; ++ai)
#pragma unroll
            for (int m = 0; m < 4; ++m) {
                const int r = row0 + ai * 128 + m * 16; float s = 0.f;
#pragma unroll
                for (int bj = 0; bj < 2; ++bj) { const f32x4 v0 = acc[ai][bj][m][0], v1 = acc[ai][bj][m][1];
                    s += (v0[0] * v0[0] + v0[1] * v0[1]) + (v0[2] * v0[2] + v0[3] * v0[3]) + (v1[0] * v1[0] + v1[1] * v1[1]) + (v1[2] * v1[2] + v1[3] * v1[3]);
                    u32x4 w; w.x = cvtpk(v0[0], v0[1]); w.y = cvtpk(v0[2], v0[3]); w.z = cvtpk(v1[0], v1[1]); w.w = cvtpk(v1[2], v1[3]);
                    *(u32x4*)(Y + (size_t)r * D_MODEL + col0 + bj * 128) = w; }
                s += __shfl_xor(s, 16); s += __shfl_xor(s, 32);
                if (fq == 0) SSp[(size_t)r * 64 + u.pn * 4 + wc] = s;
            }
    }
};
static_assert(D_MODEL / 256 * 4 <= 64, "SS slots");

constexpr int M_MAIN = (ROW_M0 + 255) / 256 * 256, N_MAIN = 4 * W_A + 4 * W_B;
constexpr int SK_AB_TILES = (NROWS + 31) / 32, SK_META_TILES = (2 * W_A + 3 * W_B) / 32;
#define SK_LOAD(A_, B_, KB_) do { const int kk_ = 64 * ((KB_) < kbe ? (KB_) : kbe - 1); _Pragma("unroll") for (int q = 0; q < 4; ++q) { A_[q] = *(const bf16x8*)(ap + kk_ + 8 * q); B_[q] = *(const bf16x8*)(bp + kk_ + 8 * q); } } while (0)
#define SK_MMA(A_, B_) do { _Pragma("unroll") for (int q = 0; q < 4; ++q) acc = __builtin_amdgcn_mfma_f32_32x32x16_bf16(A_[q], B_[q], acc, 0, 0, 0); } while (0)
DI f32x16 skinny_tile(const bf16_t* Arows, const bf16_t* Brows, int lane, int kb0, int nkb) {
    const int r = lane & 31, h = lane >> 5, kbe = kb0 + nkb;
    const bf16_t* ap = Arows + (size_t)r * D_MODEL + 32 * h; const bf16_t* bp = Brows + (size_t)r * D_MODEL + 32 * h;
    f32x16 acc = {};
    bf16x8 A0[4], B0[4], A1[4], B1[4], A2[4], B2[4], A3[4], B3[4];
    SK_LOAD(A0, B0, kb0); SK_LOAD(A1, B1, kb0 + 1); SK_LOAD(A2, B2, kb0 + 2);
    for (int kb = kb0; kb < kbe; kb += 4) {
        SK_LOAD(A3, B3, kb + 3); SBAR(); SK_MMA(A0, B0); SBAR();
        SK_LOAD(A0, B0, kb + 4); SBAR(); SK_MMA(A1, B1); SBAR();
        SK_LOAD(A1, B1, kb + 5); SBAR(); SK_MMA(A2, B2); SBAR();
        SK_LOAD(A2, B2, kb + 6); SBAR(); SK_MMA(A3, B3); SBAR();
    }
    return acc;
}
static_assert((D_MODEL / 64 / 2) % 4 == 0, "skinny K halves are whole prefetch rings");
DI void p1a_skinny(Frame& F) {
    const int lane = F.lane, j = lane & 31, h = lane >> 5, ws4 = F.wave & 3, kh = F.wave >> 2;
    const bf16_t* XN = (const bf16_t*)(F.ws + WS_XN); const bf16_t* WinT = (const bf16_t*)(F.ws + WS_WINT);
    constexpr int NT = SK_AB_TILES + SK_META_TILES, NKH = D_MODEL / 64 / 2;
    float* xch = (float*)(F.lds) + (size_t)ws4 * 64 * 17;
    const int nit = (NT + F.G * 4 - 1) / (F.G * 4);
    for (int n = 0; n < nit; ++n) {
        const int it = F.vcu + F.G * (ws4 + 4 * n);
        const bool valid = it < NT, isab = it < SK_AB_TILES;
        int seg = 0, colp = 0; const bf16_t* Ar = WinT + (size_t)N_MAIN * D_MODEL; const bf16_t* Br = XN;
        if (valid) {
            if (isab) Br = XN + (size_t)(32 * it) * D_MODEL;
            else {
                const int ct = it - SK_AB_TILES;
                if (ct < W_A / 32) { seg = 0; colp = 32 * ct; } else if (ct < 2 * W_A / 32) { seg = 1; colp = 32 * ct - W_A; } else { seg = 2; colp = 32 * ct - 2 * W_A; }
                const int gcol = seg == 0 ? W_A + colp : (seg == 1 ? 2 * W_A + colp : 4 * W_A + colp);
                Ar = XN + (size_t)ROW_M0 * D_MODEL; Br = WinT + (size_t)gcol * D_MODEL;
            }
        }
        f32x16 acc = {};
        if (valid) acc = skinny_tile(Ar, Br, lane, kh * NKH, NKH);
        if (kh == 1) {
#pragma unroll
            for (int q = 0; q < 16; ++q) xch[lane * 17 + q] = acc[q]; }
        __syncthreads();
        if (kh == 0 && valid) {
#pragma unroll
            for (int q = 0; q < 16; ++q) acc[q] += xch[lane * 17 + q];
            if (isab) {
                float* o = (float*)(F.ws + WS_AB) + (size_t)(32 * it + j) * 32 + 4 * h;
#pragma unroll
                for (int q = 0; q < 4; ++q) *(f32x4*)(o + 8 * q) = (f32x4){acc[4 * q], acc[4 * q + 1], acc[4 * q + 2], acc[4 * q + 3]};
            } else {
#pragma unroll
                for (int r = 0; r < 8; ++r) { const int tok = crow_c(r, h); const float v = acc[r];
                    if (seg == 2) ((bf16_t*)(F.ws + WS_QKVB))[(size_t)(ROW_M0 + tok) * C3 + colp + j] = (bf16_t)f2bf(v);
                    else { ((bf16_t*)(F.ws + (seg == 0 ? WS_K : WS_V)))[(size_t)(ROW_M0 + tok) * W_A + colp + j] = (bf16_t)f2bf(v);
                           F.out[(seg == 0 ? O_KP : O_VP) + (size_t)tok * W_A + colp + j] = v; } }
            }
        }
        __syncthreads();
    }
}
DI int dummy_unused() { return 0; }

DI void p5_final(Frame& F) {
    const int gw = F.vcu * 8 + F.wave, NGW = F.G * 8;
    const bf16_t* Y = (const bf16_t*)(F.ws + WS_Y); const float* SSp = (const float*)(F.ws + WS_SS);
    constexpr int NJ = D_MODEL / 512, NSL = D_MODEL / 256 * 4;
    for (int r = gw; r < ROW_M0; r += NGW) {
        float s = F.lane < NSL ? SSp[(size_t)r * 64 + F.lane] : 0.f; s = wave_sum(s);
        const float rs = 1.0f / sqrtf(s * (1.f / D_MODEL) + EPS);
        const float* h = src_row(F, r); float* o = r < ROW_S0 ? F.out + O_YP + (size_t)r * D_MODEL : F.out + O_YS + (size_t)(r - ROW_S0) * D_MODEL;
#pragma unroll
        for (int j = 0; j < NJ; ++j) { const int c = (F.lane + 64 * j) * 8;
            const u32x4 yv = *(const u32x4*)(Y + (size_t)r * D_MODEL + c);
            const f32x4 h0 = *(const f32x4*)(h + c), h1 = *(const f32x4*)(h + c + 4), w0 = *(const f32x4*)(F.P->in[IN_POSTN] + c), w1 = *(const f32x4*)(F.P->in[IN_POSTN] + c + 4);
            f32x4 o0, o1; o0[0] = h0[0] + lo_bf(yv.x) * rs * w0[0]; o0[1] = h0[1] + hi_bf(yv.x) * rs * w0[1]; o0[2] = h0[2] + lo_bf(yv.y) * rs * w0[2]; o0[3] = h0[3] + hi_bf(yv.y) * rs * w0[3];
            o1[0] = h1[0] + lo_bf(yv.z) * rs * w1[0]; o1[1] = h1[1] + hi_bf(yv.z) * rs * w1[1]; o1[2] = h1[2] + lo_bf(yv.w) * rs * w1[2]; o1[3] = h1[3] + hi_bf(yv.w) * rs * w1[3];
            *(f32x4*)(o + c) = o0; *(f32x4*)(o + c + 4) = o1; }
    }
}

DI void load8_hist(const Frame& F, int r, int i, int cb, float (&x)[8]) {
    const bf16_t* QKVB = (const bf16_t*)(F.ws + WS_QKVB);
    int row = -1; const float* cs = nullptr;
    if (r < ROW_S0) { const int p = r - i; row = p >= 0 ? p : ROW_M0 + N_META + p; }
    else if (r < ROW_M0) { const int s = (r - ROW_S0) & 31, b = (r - ROW_S0) >> 5; if (s - i >= 0) row = r - i; else cs = F.P->in[IN_CONVS] + ((size_t)b * 3 + (3 + s - i)) * C3 + cb; }
    else { const int m = r - ROW_M0; if (m - i >= 0) row = r - i; }
    if (row >= 0) { const u32x4 w = *(const u32x4*)(QKVB + (size_t)row * C3 + cb); x[0] = lo_bf(w.x); x[1] = hi_bf(w.x); x[2] = lo_bf(w.y); x[3] = hi_bf(w.y); x[4] = lo_bf(w.z); x[5] = hi_bf(w.z); x[6] = lo_bf(w.w); x[7] = hi_bf(w.w); }
    else if (cs) { const f32x4 a = *(const f32x4*)cs, b = *(const f32x4*)(cs + 4); x[0] = a[0]; x[1] = a[1]; x[2] = a[2]; x[3] = a[3]; x[4] = b[0]; x[5] = b[1]; x[6] = b[2]; x[7] = b[3]; }
    else {
#pragma unroll
        for (int j = 0; j < 8; ++j) x[j] = 0.f; }
}
DI void p2_conv(Frame& F) {
    const int gw = F.vcu * 8 + F.wave, NGW = F.G * 8, sub = F.lane >> 4, l16 = F.lane & 15;
    bf16_t* QKVN = (bf16_t*)(F.ws + WS_QKVN); const float* AB = (const float*)(F.ws + WS_AB); float* BG = (float*)(F.ws + WS_BG);
    const float* cw = F.P->in[IN_CONVW];
    constexpr int NRB = (NROWS + 63) / 64, NIT = NRB * NH_B * 3;
    for (int it = gw; it < NIT; it += NGW) {
        const int t = it % 3, hb = (it / 3) % NH_B, rb = it / (3 * NH_B), r0 = rb * 64 + sub * 16;
        const float adt = F.P->in[IN_DTB][hb], nea = -expf(F.P->in[IN_ALOG][hb]);
        {
            const int cb = t * W_B + hb * 128 + l16 * 8;
            float w[4][8];
#pragma unroll
            for (int i = 0; i < 4; ++i) { const f32x4 w0 = *(const f32x4*)(cw + (size_t)i * C3 + cb), w1 = *(const f32x4*)(cw + (size_t)i * C3 + cb + 4);
#pragma unroll
                for (int j = 0; j < 4; ++j) { w[i][j] = w0[j]; w[i][4 + j] = w1[j]; } }
            float x0[8], x1[8], x2[8], x3[8];
            if (r0 < NROWS) { load8_hist(F, r0, 3, cb, x0); load8_hist(F, r0, 2, cb, x1); load8_hist(F, r0, 1, cb, x2); }
            else {
#pragma unroll
                for (int j = 0; j < 8; ++j) { x0[j] = 0.f; x1[j] = 0.f; x2[j] = 0.f; } }
            const float post = t == 0 ? 0.08838834764831845f : 1.0f;
            u32x4 raw[16];
            { const bf16_t* QKVB = (const bf16_t*)(F.ws + WS_QKVB);
#pragma unroll
              for (int k = 0; k < 16; ++k) { raw[k] = (u32x4){0u, 0u, 0u, 0u}; if (r0 + k < NROWS) raw[k] = *(const u32x4*)(QKVB + (size_t)(r0 + k) * C3 + cb); } }
#pragma unroll
            for (int k = 0; k < 16; ++k) {
                const int r = r0 + k; const bool valid = r < NROWS;
                { const u32x4 wq = raw[k]; x3[0] = lo_bf(wq.x); x3[1] = hi_bf(wq.x); x3[2] = lo_bf(wq.y); x3[3] = hi_bf(wq.y); x3[4] = lo_bf(wq.z); x3[5] = hi_bf(wq.z); x3[6] = lo_bf(wq.w); x3[7] = hi_bf(wq.w); }
                float y[8]; float ss = 0.f;
#pragma unroll
                for (int j = 0; j < 8; ++j) { y[j] = silu_f(x0[j] * w[0][j] + x1[j] * w[1][j] + x2[j] * w[2][j] + x3[j] * w[3][j]); ss += y[j] * y[j]; x0[j] = x1[j]; x1[j] = x2[j]; x2[j] = x3[j]; }
                float sc = 1.0f;
                if (t < 2) { ss += __shfl_xor(ss, 1); ss += __shfl_xor(ss, 2); ss += __shfl_xor(ss, 4); ss += __shfl_xor(ss, 8); sc = post / sqrtf(ss + EPS); }
                if (valid) { u32x4 o; o.x = cvtpk(y[0] * sc, y[1] * sc); o.y = cvtpk(y[2] * sc, y[3] * sc); o.z = cvtpk(y[4] * sc, y[5] * sc); o.w = cvtpk(y[6] * sc, y[7] * sc);
                    *(u32x4*)(QKVN + (size_t)r * C3 + cb) = o; }
            }
        }
        { const int r = rb * 64 + F.lane;
          if (t == 0 && r < NROWS) { const float braw = AB[(size_t)r * 32 + hb], araw = AB[(size_t)r * 32 + NH_B + hb];
              const float beta = 1.0f / (1.0f + expf(-braw)); const float xx = araw + adt; const float sp = xx > 20.f ? xx : log1pf(expf(xx));
              BG[((size_t)r * NH_B + hb) * 2] = beta; BG[((size_t)r * NH_B + hb) * 2 + 1] = nea * sp; } }
    }
}

constexpr int PK_W = 0, PK_Q = 16384, PK_A = 32768, PK_K = 40960, PK_U = 57344;
DI int crow(int r, int h) { return (r & 3) + 8 * (r >> 2) + 4 * h; }
DI int sc_base_row(int sc) { return sc == 0 ? ROW_M0 : (sc < NCH_P ? (sc - 1) * 64 : ROW_S0 + (sc - NCH_P) * 32); }
DI int sc_len(int sc) { return sc == 0 ? N_META : (sc < NCH_P ? 64 : DEC_SEQ); }
DI float rdlane_f(float v, int lane) { return __builtin_bit_cast(float, __builtin_amdgcn_readlane(__builtin_bit_cast(int, v), lane)); }
DI bf16x8 pack8f(const float* x) { u32x4 w; w.x = cvtpk(x[0], x[1]); w.y = cvtpk(x[2], x[3]); w.z = cvtpk(x[4], x[5]); w.w = cvtpk(x[6], x[7]); return __builtin_bit_cast(bf16x8, w); }
DI bf16x8 pack8v(const f32x16& v, int b, float sc) { u32x4 w; w.x = cvtpk(v[b] * sc, v[b + 1] * sc); w.y = cvtpk(v[b + 2] * sc, v[b + 3] * sc); w.z = cvtpk(v[b + 4] * sc, v[b + 5] * sc); w.w = cvtpk(v[b + 6] * sc, v[b + 7] * sc); return __builtin_bit_cast(bf16x8, w); }
template <int C> struct InvStep {
    static DI void run(float (&T)[64], const LAS float* Al, int lane) {
        float a0 = 0.f, a1 = 0.f;
#pragma unroll
        for (int j4 = ((C + 1) & ~3); j4 < 64; j4 += 4) { const f32x4 a = *(const LAS f32x4*)(Al + C * 64 + j4);
#pragma unroll
            for (int e = 0; e < 4; ++e) { const int j = j4 + e; if (j > C) { if (j & 1) a1 = __builtin_fmaf(-T[j], a[e], a1); else a0 = __builtin_fmaf(-T[j], a[e], a0); } }
            }
        T[C] = (lane == C) ? 1.0f : (a0 + a1);
        PINV(T[C]);
        if constexpr (C > 0) InvStep<C - 1>::run(T, Al, lane);
    }
};
DI void p3_prep(Frame& F) {
    const int gw = F.vcu * 8 + F.wave, NGW = F.G * 8, lane = F.lane, r32 = lane & 31, h = lane >> 5;
    const bf16_t* QKVN = (const bf16_t*)(F.ws + WS_QKVN); const float* BG = (const float*)(F.ws + WS_BG);
    LAS unsigned char* tile = F.lds + F.wave * 17408;
    LAS float* gs = (LAS float*)(F.lds + F.wave * 17408 + 16384);
    for (int rnd = 0; rnd * NGW < NSC * NH_B; ++rnd) {
        const int item = rnd * NGW + (((rnd + 1) * NGW <= NSC * NH_B) ? gw : F.vcu + F.G * F.wave);
        if (item >= NSC * NH_B) break;
        const int sc = item / NH_B, hb = item % NH_B, row0 = sc_base_row(sc), L = sc_len(sc);
        unsigned char* pkg = F.ws + WS_PKG + (size_t)item * PKG_BYTES;
        float g = 0.f, beta = 0.f; if (lane < L) { beta = BG[((size_t)(row0 + lane) * NH_B + hb) * 2]; g = BG[((size_t)(row0 + lane) * NH_B + hb) * 2 + 1]; }
        float G = g;
#pragma unroll
        for (int off = 1; off < 64; off <<= 1) { const float t = __shfl(G, (lane - off) & 63); if (lane >= off) G += t; }
        const float Glast = __shfl(G, 63);
        gs[lane] = G; gs[64 + lane] = fast_exp2((Glast - G) * LOG2E); gs[128 + lane] = beta * fast_exp2(G * LOG2E); gs[192 + lane] = beta;
        if (lane == 0) ((float*)(F.ws + WS_DEC))[item] = fast_exp2(Glast * LOG2E);
        WAIT_L(0); CFENCE();
        bf16x8 kf[2][8], qf[2][8];
#pragma unroll
        for (int tt = 0; tt < 2; ++tt) { const int tok = 32 * tt + r32; const bool ok = tok < L; const bf16_t* rp = QKVN + (size_t)(row0 + tok) * C3 + hb * 128;
#pragma unroll
            for (int ks = 0; ks < 8; ++ks) { const int ch = 16 * ks + 4 * h; u32x2 a = {0u, 0u}, b = {0u, 0u}, c = {0u, 0u}, d = {0u, 0u};
                if (ok) { a = *(const u32x2*)(rp + W_B + ch); b = *(const u32x2*)(rp + W_B + ch + 8); c = *(const u32x2*)(rp + ch); d = *(const u32x2*)(rp + ch + 8); }
                kf[tt][ks] = __builtin_bit_cast(bf16x8, (u32x4){a.x, a.y, b.x, b.y}); qf[tt][ks] = __builtin_bit_cast(bf16x8, (u32x4){c.x, c.y, d.x, d.y}); } }
        const float Gi0 = __shfl(G, r32), Gi1 = __shfl(G, 32 + r32);
#pragma unroll
        for (int tl = 0; tl < 3; ++tl) {
            const int jt = tl >> 1, it = (tl + 1) >> 1; f32x16 Sx = {};
#pragma unroll
            for (int ks = 0; ks < 8; ++ks) Sx = __builtin_amdgcn_mfma_f32_32x32x16_bf16(kf[jt][ks], qf[it][ks], Sx, 0, 0, 0);
            const float Gi = it ? Gi1 : Gi0;
#pragma unroll
            for (int q4 = 0; q4 < 4; ++q4) { const f32x4 gj = *(const LAS f32x4*)(gs + 32 * jt + 8 * q4 + 4 * h);
#pragma unroll
                for (int e = 0; e < 4; ++e) { const int r = 4 * q4 + e, j0 = 8 * q4 + 4 * h + e; const float v = Sx[r] * fast_exp2((Gi - gj[e]) * LOG2E); Sx[r] = (jt != it || j0 <= r32) ? v : 0.f; } }
#pragma unroll
            for (int s2 = 0; s2 < 2; ++s2) *(bf16x8*)(pkg + PK_A + (it * 4 + jt * 2 + s2) * 1024 + lane * 16) = pack8v(Sx, 8 * s2, 1.f);
            SBAR();
        }
        { bf16x8 z = {}; *(bf16x8*)(pkg + PK_A + (0 * 4 + 1 * 2 + 0) * 1024 + lane * 16) = z; *(bf16x8*)(pkg + PK_A + (0 * 4 + 1 * 2 + 1) * 1024 + lane * 16) = z; }
        {
            const float e0 = fast_exp2(Gi0 * LOG2E), e1 = fast_exp2(Gi1 * LOG2E);
#pragma unroll
            for (int tt = 0; tt < 2; ++tt)
#pragma unroll
                for (int ks = 0; ks < 8; ++ks) { const u32x4 w = __builtin_bit_cast(u32x4, qf[tt][ks]); const float e = tt ? e1 : e0;
                    u32x4 o; o.x = cvtpk(lo_bf(w.x) * e, hi_bf(w.x) * e); o.y = cvtpk(lo_bf(w.y) * e, hi_bf(w.y) * e); o.z = cvtpk(lo_bf(w.z) * e, hi_bf(w.z) * e); o.w = cvtpk(lo_bf(w.w) * e, hi_bf(w.w) * e);
                    *(u32x4*)(pkg + PK_Q + (tt * 8 + ks) * 1024 + lane * 16) = o; }
        }
        {
            const float b0 = __shfl(beta, r32), b1 = __shfl(beta, 32 + r32);
            LAS float* Al = (LAS float*)tile;
#pragma unroll
            for (int tl = 0; tl < 3; ++tl) {
                const int ct = tl >> 1, jt = (tl + 1) >> 1; f32x16 Kx = {};
#pragma unroll
                for (int ks = 0; ks < 8; ++ks) Kx = __builtin_amdgcn_mfma_f32_32x32x16_bf16(kf[ct][ks], kf[jt][ks], Kx, 0, 0, 0);
                const float Gj = jt ? Gi1 : Gi0, bj = jt ? b1 : b0;
#pragma unroll
                for (int q4 = 0; q4 < 4; ++q4) { const f32x4 gc = *(const LAS f32x4*)(gs + 32 * ct + 8 * q4 + 4 * h);
#pragma unroll
                    for (int e = 0; e < 4; ++e) { const int r = 4 * q4 + e; Al[(32 * ct + crow(r, h)) * 64 + 32 * jt + r32] = Kx[r] * bj * fast_exp2(fminf(Gj - gc[e], 0.f) * LOG2E); } }
                SBAR();
            }
        }
        WAIT_L(0); CFENCE();
        float T[64];
#pragma unroll
        for (int j = 0; j < 64; ++j) T[j] = (lane == j) ? 1.f : 0.f;
        InvStep<62>::run(T, (const LAS float*)tile, lane);
        WAIT_L(0); CFENCE();
#pragma unroll
        for (int tt = 0; tt < 2; ++tt) { const int tok = 32 * tt + r32; const bool ok = tok < L; const bf16_t* rp = QKVN + (size_t)(row0 + tok) * C3 + hb * 128;
#pragma unroll
            for (int ks = 0; ks < 8; ++ks) { const int ch = 16 * ks + 4 * h; u32x2 a = {0u, 0u}, b = {0u, 0u};
                if (ok) { a = *(const u32x2*)(rp + W_B + ch); b = *(const u32x2*)(rp + W_B + ch + 8); }
                kf[tt][ks] = __builtin_bit_cast(bf16x8, (u32x4){a.x, a.y, b.x, b.y}); } }
#pragma unroll
        for (int tt = 0; tt < 2; ++tt)
#pragma unroll
            for (int ks = 0; ks < 8; ++ks) { const u32x4 w = __builtin_bit_cast(u32x4, kf[tt][ks]); LAS unsigned char* p = tile + (32 * tt + r32) * 256 + (16 * ks + 4 * h) * 2;
                *(LAS u32x2*)p = (u32x2){w.x, w.y}; *(LAS u32x2*)(p + 16) = (u32x2){w.z, w.w}; }
        bf16x8 TW[2][4], TU[2][4];
#pragma unroll
        for (int ks = 0; ks < 4; ++ks) {
            float xa[8], xb[8], ya[8], yb[8];
#pragma unroll
            for (int q = 0; q < 2; ++q) { const f32x4 w0 = *(const LAS f32x4*)(gs + 128 + 16 * ks + 4 * q), w1 = *(const LAS f32x4*)(gs + 128 + 16 * ks + 8 + 4 * q), u0 = *(const LAS f32x4*)(gs + 192 + 16 * ks + 4 * q), u1 = *(const LAS f32x4*)(gs + 192 + 16 * ks + 8 + 4 * q);
#pragma unroll
                for (int e = 0; e < 4; ++e) { const int jj = 4 * q + e; xa[jj] = T[16 * ks + jj] * w0[e]; xb[jj] = T[16 * ks + 8 + jj] * w1[e]; ya[jj] = T[16 * ks + jj] * u0[e]; yb[jj] = T[16 * ks + 8 + jj] * u1[e]; } }
            const u32x4 a = __builtin_bit_cast(u32x4, pack8f(xa)), b = __builtin_bit_cast(u32x4, pack8f(xb)), c = __builtin_bit_cast(u32x4, pack8f(ya)), d = __builtin_bit_cast(u32x4, pack8f(yb));
            u32x4 t0, t1, u0v, u1v;
#pragma unroll
            for (int e = 0; e < 4; ++e) { auto rr = __builtin_amdgcn_permlane32_swap(a[e], b[e], false, false); t0[e] = rr[0]; t1[e] = rr[1];
                auto r2 = __builtin_amdgcn_permlane32_swap(c[e], d[e], false, false); u0v[e] = r2[0]; u1v[e] = r2[1]; }
            TW[0][ks] = __builtin_bit_cast(bf16x8, t0); TW[1][ks] = __builtin_bit_cast(bf16x8, t1); TU[0][ks] = __builtin_bit_cast(bf16x8, u0v); TU[1][ks] = __builtin_bit_cast(bf16x8, u1v);
        }
        WAIT_L(0); CFENCE();
        const int tr_off = ((lane >> 2) & 3) * 256 + (16 * ((lane >> 4) & 1) + 4 * (lane & 3)) * 2;
#define TRF(tok0, ch0) ({ const s16x4 lo_ = tr16(tile + tr_off + (tok0) * 256 + (ch0) * 2), hi_ = tr16(tile + tr_off + ((tok0) + 4) * 256 + (ch0) * 2); (bf16x8){lo_[0], lo_[1], lo_[2], lo_[3], hi_[0], hi_[1], hi_[2], hi_[3]}; })
#pragma unroll
        for (int it = 0; it < 2; ++it) {
            f32x16 acc[4] = {};
#pragma unroll
            for (int ks = 0; ks < 4; ++ks)
#pragma unroll
                for (int ct = 0; ct < 4; ++ct) { const bf16x8 a = TRF(16 * ks + 8 * h, 32 * ct); acc[ct] = __builtin_amdgcn_mfma_f32_32x32x16_bf16(a, TW[it][ks], acc[ct], 0, 0, 0); }
#pragma unroll
            for (int ct = 0; ct < 4; ++ct)
#pragma unroll
                for (int s = 0; s < 2; ++s) *(bf16x8*)(pkg + PK_W + (it * 8 + ct * 2 + s) * 1024 + lane * 16) = pack8v(acc[ct], 8 * s, -1.f);
        }
#pragma unroll
        for (int ct = 0; ct < 4; ++ct)
#pragma unroll
            for (int ts = 0; ts < 4; ++ts) { const int tb = 16 * ts + 4 * h;
                const s16x4 lo_ = tr16(tile + tr_off + tb * 256 + (32 * ct) * 2), hi_ = tr16(tile + tr_off + (tb + 8) * 256 + (32 * ct) * 2);
                const f32x4 e0 = *(const LAS f32x4*)(gs + 64 + tb), e1 = *(const LAS f32x4*)(gs + 64 + tb + 8);
                float x[8];
#pragma unroll
                for (int e = 0; e < 4; ++e) { x[e] = bf2f((unsigned short)lo_[e]) * e0[e]; x[4 + e] = bf2f((unsigned short)hi_[e]) * e1[e]; }
                *(bf16x8*)(pkg + PK_K + (ct * 4 + ts) * 1024 + lane * 16) = pack8f(x); }
        WAIT_L(0); CFENCE();
#pragma unroll
        for (int i4 = 0; i4 < 16; ++i4) { const int tok = 4 * i4 + (lane >> 4); u32x4 w = {0u, 0u, 0u, 0u};
            if (tok < L) w = *(const u32x4*)(QKVN + (size_t)(row0 + tok) * C3 + 2 * W_B + hb * 128 + (lane & 15) * 8);
            *(LAS u32x4*)(tile + tok * 256 + (lane & 15) * 16) = w; }
        WAIT_L(0); CFENCE();
#pragma unroll
        for (int it = 0; it < 2; ++it) {
            f32x16 acc[4] = {};
#pragma unroll
            for (int ks = 0; ks < 4; ++ks)
#pragma unroll
                for (int ct = 0; ct < 4; ++ct) { const bf16x8 b = TRF(16 * ks + 8 * h, 32 * ct); acc[ct] = __builtin_amdgcn_mfma_f32_32x32x16_bf16(TU[it][ks], b, acc[ct], 0, 0, 0); }
#pragma unroll
            for (int ct = 0; ct < 4; ++ct) { unsigned char* up = pkg + PK_U + (ct * 2 + it) * 2048 + lane * 32; *(bf16x8*)up = pack8v(acc[ct], 0, 1.f); *(bf16x8*)(up + 16) = pack8v(acc[ct], 8, 1.f); }
        }
#undef TRF
        WAIT_L(0); CFENCE();
    }
}
constexpr int SC_FRAG = 57344, SC_OEX = 2 * SC_FRAG, SC_OEXB = 16384;
constexpr int SG = 4;
constexpr int N_SCAN_P = NH_B, N_SCAN_S = (DEC_BATCH * NH_B + SG - 1) / SG;
DI void scan_unit(Frame& F, int kind, int idx) {
    const int lane = F.lane, w = F.wave, r32 = lane & 31, h = lane >> 5;
    const int n = kind == 0 ? NCH_P : ((DEC_BATCH * NH_B - idx * SG) < SG ? (DEC_BATCH * NH_B - idx * SG) : SG);
    const float* DEC = (const float*)(F.ws + WS_DEC);
    bf16_t* YCAT = (bf16_t*)(F.ws + WS_YCAT); const bf16_t* GB = (const bf16_t*)(F.ws + WS_GB);
#define SC_ITEM(k) (kind == 0 ? (k) * NH_B + idx : (NCH_P + (idx * SG + (k)) / NH_B) * NH_B + (idx * SG + (k)) % NH_B)
    f32x16 S[4] = {};
    if (w >= 4) {
        const unsigned char* src = F.ws + WS_PKG + (size_t)SC_ITEM(0) * PKG_BYTES;
        for (int b = w - 4; b < 56; b += 4) __builtin_amdgcn_global_load_lds((const unsigned*)(src + b * 1024 + lane * 16), (LAS unsigned*)(F.lds + b * 1024), 16, 0, 0);
    }
    WAIT_V(0); __syncthreads();
    for (int k = 0; k < n; ++k) {
        const int item = SC_ITEM(k), sc = item / NH_B, hb = item % NH_B;
        LAS unsigned char* buf = F.lds + (k & 1) * SC_FRAG;
        if (w >= 4) {
            if (k + 1 < n) { const unsigned char* src = F.ws + WS_PKG + (size_t)SC_ITEM(k + 1) * PKG_BYTES; LAS unsigned char* dst = F.lds + ((k + 1) & 1) * SC_FRAG;
                for (int b = w - 4; b < 56; b += 4) __builtin_amdgcn_global_load_lds((const unsigned*)(src + b * 1024 + lane * 16), (LAS unsigned*)(dst + b * 1024), 16, 0, 0); }
        }
        if (w >= 4 && k > 0) {
            const int pit = SC_ITEM(k - 1), psc = pit / NH_B, phb = pit % NH_B, prow0 = sc_base_row(psc), pL = sc_len(psc);
            const LAS unsigned char* ox = F.lds + SC_OEX + ((k - 1) & 1) * SC_OEXB;
            if (psc != 0) {
#pragma unroll
                for (int ps = 0; ps < 4; ++ps) { const int t = (w - 4) * 16 + ps * 4 + (lane >> 4), ch = (lane & 15) * 8;
                    const u32x4 xv = *(const LAS u32x4*)(ox + t * 256 + ch * 2);
                    float x[8] = {lo_bf(xv.x), hi_bf(xv.x), lo_bf(xv.y), hi_bf(xv.y), lo_bf(xv.z), hi_bf(xv.z), lo_bf(xv.w), hi_bf(xv.w)};
                    float ss = 0.f;
#pragma unroll
                    for (int j = 0; j < 8; ++j) ss += x[j] * x[j];
                    { int lq = F.lane; OPAQUE(lq); ss += shfl_xor_l(ss, 1, lq); ss += shfl_xor_l(ss, 2, lq); ss += shfl_xor_l(ss, 4, lq); ss += shfl_xor_l(ss, 8, lq); }
                    const float rs = 1.0f / sqrtf(ss * (1.f / 128.f) + EPS);
                    if (t < pL) { const int row = prow0 + t; const u32x4 gv = *(const u32x4*)(GB + (size_t)row * W_B + phb * 128 + ch);
                        const f32x4 n0 = *(const f32x4*)(F.P->in[IN_NORMB] + ch), n1 = *(const f32x4*)(F.P->in[IN_NORMB] + ch + 4);
                        u32x4 o; o.x = cvtpk(x[0] * rs * n0[0] * lo_bf(gv.x), x[1] * rs * n0[1] * hi_bf(gv.x)); o.y = cvtpk(x[2] * rs * n0[2] * lo_bf(gv.y), x[3] * rs * n0[3] * hi_bf(gv.y));
                        o.z = cvtpk(x[4] * rs * n1[0] * lo_bf(gv.z), x[5] * rs * n1[1] * hi_bf(gv.z)); o.w = cvtpk(x[6] * rs * n1[2] * lo_bf(gv.w), x[7] * rs * n1[3] * hi_bf(gv.w));
                        *(u32x4*)(YCAT + (size_t)row * D_MODEL + W_A + phb * 128 + ch) = o; } }
            }
        }
        if (w < 4) {
            const unsigned char* pkg = F.ws + WS_PKG + (size_t)item * PKG_BYTES;
            if (kind == 1) {
                const float* sp = F.P->in[IN_SSM] + (size_t)((sc - NCH_P) * NH_B + hb) * 16384 + (size_t)(4 * h) * 128 + 32 * w + r32;
#pragma unroll
                for (int T = 0; T < 4; ++T) {
#pragma unroll
                    for (int r = 0; r < 16; ++r) S[T][r] = sp[(32 * T + (r & 3) + 8 * (r >> 2)) * 128];
                    SBAR(); }
            }
            const float d = DEC[item];
            f32x16 vn[2], o[2] = {};
#pragma unroll
            for (int rt = 0; rt < 2; ++rt) { const u32x4 a = *(const u32x4*)(pkg + PK_U + (w * 2 + rt) * 2048 + lane * 32), b = *(const u32x4*)(pkg + PK_U + (w * 2 + rt) * 2048 + lane * 32 + 16);
                vn[rt][0] = lo_bf(a.x); vn[rt][1] = hi_bf(a.x); vn[rt][2] = lo_bf(a.y); vn[rt][3] = hi_bf(a.y); vn[rt][4] = lo_bf(a.z); vn[rt][5] = hi_bf(a.z); vn[rt][6] = lo_bf(a.w); vn[rt][7] = hi_bf(a.w);
                vn[rt][8] = lo_bf(b.x); vn[rt][9] = hi_bf(b.x); vn[rt][10] = lo_bf(b.y); vn[rt][11] = hi_bf(b.y); vn[rt][12] = lo_bf(b.z); vn[rt][13] = hi_bf(b.z); vn[rt][14] = lo_bf(b.w); vn[rt][15] = hi_bf(b.w); }
            SBAR();
#define FRAG(off, blk) (*(const LAS bf16x8*)(buf + (off) + (blk) * 1024 + lane * 16))
#pragma unroll
            for (int T = 0; T < 4; ++T)
#pragma unroll
                for (int s = 0; s < 2; ++s) { const bf16x8 sb = pack8v(S[T], 8 * s, 1.f);
#pragma unroll
                    for (int rt = 0; rt < 2; ++rt) { vn[rt] = __builtin_amdgcn_mfma_f32_32x32x16_bf16(FRAG(PK_W, rt * 8 + T * 2 + s), sb, vn[rt], 0, 0, 0);
                        o[rt] = __builtin_amdgcn_mfma_f32_32x32x16_bf16(FRAG(PK_Q, rt * 8 + T * 2 + s), sb, o[rt], 0, 0, 0); }
                    SBAR(); }
#pragma unroll
            for (int T = 0; T < 4; ++T) S[T] *= d;
#pragma unroll
            for (int Tt = 0; Tt < 2; ++Tt)
#pragma unroll
                for (int s = 0; s < 2; ++s) { const bf16x8 vb = pack8v(vn[Tt], 8 * s, 1.f);
#pragma unroll
                    for (int rt = 0; rt < 2; ++rt) o[rt] = __builtin_amdgcn_mfma_f32_32x32x16_bf16(FRAG(PK_A, rt * 4 + Tt * 2 + s), vb, o[rt], 0, 0, 0);
                    SBAR();
#pragma unroll
                    for (int T = 0; T < 4; ++T) S[T] = __builtin_amdgcn_mfma_f32_32x32x16_bf16(FRAG(PK_K, T * 4 + Tt * 2 + s), vb, S[T], 0, 0, 0);
                    SBAR(); }
#undef FRAG
            LAS unsigned short* ox = (LAS unsigned short*)(F.lds + SC_OEX + (k & 1) * SC_OEXB);
#pragma unroll
            for (int rt = 0; rt < 2; ++rt)
#pragma unroll
                for (int r = 0; r < 16; ++r) ox[(32 * rt + crow(r, h)) * 128 + 32 * w + r32] = (unsigned short)f2bf(o[rt][r]);
            if (kind == 1 || k == n - 1) {
                float* dp = (kind == 1 ? F.out + O_SS + (size_t)((sc - NCH_P) * NH_B + hb) * 16384 : F.out + O_SP + (size_t)hb * 16384) + (size_t)(4 * h) * 128 + 32 * w + r32;
#pragma unroll
                for (int T = 0; T < 4; ++T) {
#pragma unroll
                    for (int r = 0; r < 16; ++r) dp[(32 * T + (r & 3) + 8 * (r >> 2)) * 128] = S[T][r];
                    SBAR(); }
            }
        }
        WAIT_VL0(); __syncthreads();
    }
    if (w >= 4) {
        const int pit = SC_ITEM(n - 1), psc = pit / NH_B, phb = pit % NH_B, prow0 = sc_base_row(psc), pL = sc_len(psc);
        const LAS unsigned char* ox = F.lds + SC_OEX + ((n - 1) & 1) * SC_OEXB;
        if (psc != 0) {
#pragma unroll
            for (int ps = 0; ps < 4; ++ps) { const int t = (w - 4) * 16 + ps * 4 + (lane >> 4), ch = (lane & 15) * 8;
                const u32x4 xv = *(const LAS u32x4*)(ox + t * 256 + ch * 2);
                float x[8] = {lo_bf(xv.x), hi_bf(xv.x), lo_bf(xv.y), hi_bf(xv.y), lo_bf(xv.z), hi_bf(xv.z), lo_bf(xv.w), hi_bf(xv.w)};
                float ss = 0.f;
#pragma unroll
                for (int j = 0; j < 8; ++j) ss += x[j] * x[j];
                { int lq = F.lane; OPAQUE(lq); ss += shfl_xor_l(ss, 1, lq); ss += shfl_xor_l(ss, 2, lq); ss += shfl_xor_l(ss, 4, lq); ss += shfl_xor_l(ss, 8, lq); }
                const float rs = 1.0f / sqrtf(ss * (1.f / 128.f) + EPS);
                if (t < pL) { const int row = prow0 + t; const u32x4 gv = *(const u32x4*)(GB + (size_t)row * W_B + phb * 128 + ch);
                    const f32x4 n0 = *(const f32x4*)(F.P->in[IN_NORMB] + ch), n1 = *(const f32x4*)(F.P->in[IN_NORMB] + ch + 4);
                    u32x4 o; o.x = cvtpk(x[0] * rs * n0[0] * lo_bf(gv.x), x[1] * rs * n0[1] * hi_bf(gv.x)); o.y = cvtpk(x[2] * rs * n0[2] * lo_bf(gv.y), x[3] * rs * n0[3] * hi_bf(gv.y));
                    o.z = cvtpk(x[4] * rs * n1[0] * lo_bf(gv.z), x[5] * rs * n1[1] * hi_bf(gv.z)); o.w = cvtpk(x[6] * rs * n1[2] * lo_bf(gv.w), x[7] * rs * n1[3] * hi_bf(gv.w));
                    *(u32x4*)(YCAT + (size_t)row * D_MODEL + W_A + phb * 128 + ch) = o; } }
        }
    }
    __syncthreads();
#undef SC_ITEM
}
constexpr int AT_KB = 32768, AT_K = 0, AT_V = 2 * AT_KB, AT_TB = 4 * AT_KB, AT_WS = AT_TB + NTB * 4, AT_END = AT_WS + 8 * 256;
static_assert(AT_END <= RING_BYTES, "attention LDS");
constexpr float THR_L2 = 11.5f;
DI int v_rd_base(int lane) { return ((lane & 3) << 3) | (((lane >> 2) & 3) << 6) | (((lane >> 4) & 1) << 5) | (((lane >> 5) & 1) << 8); }
struct AttnW { bf16x8 qr[8]; f32x16 o[8]; float m, l; };
DI void attn_tile(AttnW& A, const LAS unsigned char* Kc, const LAS unsigned char* Vt, const LAS float* tbl, LAS float* wsf, int lane, int tbi, float bu, int nvalid) {
    const int r32 = lane & 31, hi = lane >> 5;
    const float ub = tbi >= 0 ? 0.f : bu;
    const LAS unsigned char* vb0 = Vt + v_rd_base(lane);
#pragma unroll
    for (int hf = 0; hf < 2; ++hf) {
        f32x16 p = {};
        {
            const LAS unsigned char* kb[4];
#pragma unroll
            for (int dd = 0; dd < 4; ++dd) kb[dd] = Kc + hf * 8192 + r32 * 256 + (((dd * 16 + hi * 8) * 2) ^ ((r32 & 7) << 4));
#pragma unroll
            for (int d0 = 0; d0 < 8; ++d0) { const bf16x8 b0 = *(const LAS bf16x8*)(kb[d0 & 3] + (d0 >> 2) * 128); p = __builtin_amdgcn_mfma_f32_32x32x16_bf16(b0, A.qr[d0], p, 0, 0, 0); }
        }
        SBAR();
        if (tbi >= 0) {
            const LAS float* tp = tbl + tbi + 4 * hi + 32 * hf;
#pragma unroll
            for (int r = 0; r < 16; ++r) p[r] += tp[(r & 3) + 8 * (r >> 2)];
        }
        if (nvalid < 64) {
            const float NEG = -__builtin_inff();
#pragma unroll
            for (int r = 0; r < 16; ++r) { if ((r & 3) + 8 * (r >> 2) + 4 * hi + 32 * hf >= nvalid) p[r] = NEG; }
        }
        float pmax = p[0];
#pragma unroll
        for (int r = 1; r < 16; ++r) pmax = fmaxf(pmax, p[r]);
        { auto rr = __builtin_amdgcn_permlane32_swap(__float_as_uint(pmax), __float_as_uint(pmax), false, false); pmax = fmaxf(__uint_as_float(rr[0]), __uint_as_float(rr[1])); }
        pmax += ub;
        float mn, alpha;
        if (__all(pmax - A.m <= THR_L2)) { mn = A.m; alpha = 1.f; }
        else { mn = fmaxf(A.m, pmax); alpha = fast_exp2(A.m - mn); A.m = mn; }
        const float sh = ub - mn;
        float ps = 0.f;
#pragma unroll
        for (int r = 0; r < 16; ++r) { p[r] = fast_exp2(p[r] + sh); ps += p[r]; }
        { auto rr = __builtin_amdgcn_permlane32_swap(__float_as_uint(ps), __float_as_uint(ps), false, false); ps = __uint_as_float(rr[0]) + __uint_as_float(rr[1]); }
        A.l = A.l * alpha + ps;
        if (__any(alpha < 1.f)) {
            if (hi == 0) wsf[r32] = alpha;
            WAIT_L(0); CFENCE();
#pragma unroll
            for (int r = 0; r < 16; ++r) { const float al = wsf[crow(r, hi)];
#pragma unroll
                for (int d = 0; d < 8; ++d) A.o[d][r] *= al; }
            WAIT_L(0); CFENCE();
        }
        bf16x8 pa[2];
#define PK4(P, B_, OUT) do { const unsigned a0 = cvtpk(P[B_ + 0], P[B_ + 1]), a1 = cvtpk(P[B_ + 2], P[B_ + 3]), b0_ = cvtpk(P[B_ + 4], P[B_ + 5]), b1_ = cvtpk(P[B_ + 6], P[B_ + 7]); \
            auto r0 = __builtin_amdgcn_permlane32_swap(a0, b0_, false, false); auto r1 = __builtin_amdgcn_permlane32_swap(a1, b1_, false, false); \
            u32x4 w_ = {r0[0], r1[0], r0[1], r1[1]}; OUT = __builtin_bit_cast(bf16x8, w_); } while (0)
        PK4(p, 0, pa[0]); PK4(p, 8, pa[1]);
#undef PK4
        SBAR();
#pragma unroll
        for (int d0 = 0; d0 < 8; ++d0) {
#pragma unroll
            for (int k2 = 0; k2 < 2; ++k2) { const int ks = 2 * hf + k2; const s16x4 lo_ = tr16(vb0 + d0 * 512 + ks * 8192), hi_ = tr16(vb0 + d0 * 512 + ks * 8192 + 4096);
                const bf16x8 vf = {lo_[0], lo_[1], lo_[2], lo_[3], hi_[0], hi_[1], hi_[2], hi_[3]};
                A.o[d0] = __builtin_amdgcn_mfma_f32_32x32x16_bf16(pa[k2], vf, A.o[d0], 0, 0, 0); }
            if (d0 & 1) SBAR();
        }
    }
}
DI void attn_dma_k(const Frame& F, int kr0, int h, int bufi, int l) {
    const unsigned char* Kg = F.ws + WS_K + ((size_t)kr0 * W_A + h * 256) * 2; const int w = F.wave;
#pragma unroll
    for (int i = 0; i < 4; ++i) { const int cc = w >> 2, m = 4 * (w & 3) + i, row = 4 * m + (l >> 4), ch = (l & 15) ^ (row & 7); const unsigned off = (unsigned)(row * W_A + cc * 128 + ch * 8) * 2u;
        glds16(Kg + off, LDS_A(F.lds) + (unsigned)__builtin_amdgcn_readfirstlane(AT_K + bufi * AT_KB + cc * 16384 + m * 1024)); }
}
DI void attn_dma_v(const Frame& F, int kr0, int h, int bufi, int l) {
    const unsigned char* Vg = F.ws + WS_V + ((size_t)kr0 * W_A + h * 256) * 2; const int w = F.wave;
#pragma unroll
    for (int i = 0; i < 4; ++i) { const int j = 4 * w + i, key = 2 * j + (l >> 5); const unsigned off = (unsigned)(key * W_A * 2) + (unsigned)((16 * (l & 31)) ^ ((key & 3) << 6));
        glds16(Vg + off, LDS_A(F.lds) + (unsigned)__builtin_amdgcn_readfirstlane(AT_V + bufi * AT_KB + j * 1024)); }
}
DI void attn_QK(const AttnW& A, f32x16& p0, f32x16& p1, const LAS unsigned char* Kc, int lane, float init) {
    const int r32 = lane & 31, hi = lane >> 5;
#pragma unroll
    for (int r = 0; r < 16; ++r) { p0[r] = init; p1[r] = init; }
    lds_a kb[4];
#pragma unroll
    for (int dd = 0; dd < 4; ++dd) kb[dd] = LDS_A(Kc) + (unsigned)(r32 * 256 + (((dd * 16 + hi * 8) * 2) ^ ((r32 & 7) << 4)));
    bf16x8 x0, x1, y0, y1;
#define KBATCH(d0, a0, a1) do { LDRD128(a0, kb[(d0) & 3], ((d0) >> 2) * 128); LDRD128(a1, kb[(d0) & 3], ((d0) >> 2) * 128 + 8192); } while (0)
#define KMMA(d0, a0, a1) do { p0 = __builtin_amdgcn_mfma_f32_32x32x16_bf16(a0, A.qr[d0], p0, 0, 0, 0); p1 = __builtin_amdgcn_mfma_f32_32x32x16_bf16(a1, A.qr[d0], p1, 0, 0, 0); } while (0)
#define LWAIT2(a, b) do { asm_lwait2(a, b); } while (0)
    KBATCH(0, x0, x1); LWAIT2(x0, x1);
    KBATCH(1, y0, y1); KMMA(0, x0, x1); LWAIT2(y0, y1);
    KBATCH(2, x0, x1); KMMA(1, y0, y1); LWAIT2(x0, x1);
    KBATCH(3, y0, y1); KMMA(2, x0, x1); LWAIT2(y0, y1);
    KBATCH(4, x0, x1); KMMA(3, y0, y1); LWAIT2(x0, x1);
    KBATCH(5, y0, y1); KMMA(4, x0, x1); LWAIT2(y0, y1);
    KBATCH(6, x0, x1); KMMA(5, y0, y1); LWAIT2(x0, x1);
    KBATCH(7, y0, y1); KMMA(6, x0, x1); LWAIT2(y0, y1);
    KMMA(7, y0, y1);
    PIN2(p0, p1);
#undef KBATCH
#undef KMMA
#undef LWAIT2
}
DI bool attn_SM(AttnW& A, f32x16& p0, f32x16& p1, bf16x8 (&pa)[4], const LAS float* tbl, LAS float* wsf, int lane, int tbi, int nvalid, bool first) {
    const int r32 = lane & 31, hi = lane >> 5;
    if (tbi >= 0) {
        const LAS float* tp = tbl + tbi + 4 * hi;
#pragma unroll
        for (int r = 0; r < 16; ++r) { const int c = (r & 3) + 8 * (r >> 2); p0[r] += tp[c]; p1[r] += tp[c + 32]; }
    }
    if (nvalid < 64) {
        const float NEG = -__builtin_inff();
#pragma unroll
        for (int r = 0; r < 16; ++r) { const int c = (r & 3) + 8 * (r >> 2) + 4 * hi; if (c >= nvalid) p0[r] = NEG; if (c + 32 >= nvalid) p1[r] = NEG; }
    }
    MFMA_PAD2(p0, p1);
    float pmax;
    { float a = max3f(p0[0], p0[1], p1[0]), b = max3f(p0[2], p0[3], p1[1]); a = max3f(a, p1[2], p1[3]);
#pragma unroll
      for (int r = 4; r < 16; r += 4) { a = max3f(a, p0[r], p0[r + 1]); b = max3f(b, p0[r + 2], p0[r + 3]); a = max3f(a, p1[r], p1[r + 1]); b = max3f(b, p1[r + 2], p1[r + 3]); }
      pmax = max2f(a, b); }
    VALU_PAD(pmax);
    { auto rr = __builtin_amdgcn_permlane32_swap(__float_as_uint(pmax), __float_as_uint(pmax), false, false); pmax = fmaxf(__uint_as_float(rr[0]), __uint_as_float(rr[1])); }
    bool resc = false;
    if (first || !__all(pmax <= THR_L2)) {
        const float delta = first ? pmax : fmaxf(pmax, 0.f);
#pragma unroll
        for (int r = 0; r < 16; ++r) { p0[r] -= delta; p1[r] -= delta; }
        const float alpha = first ? 0.f : fast_exp2(-delta);
        A.m += delta; A.l *= alpha; resc = !first; if (hi == 0) wsf[r32] = alpha;
    }
#pragma unroll
    for (int r = 0; r < 16; ++r) { p0[r] = fast_exp2(p0[r]); p1[r] = fast_exp2(p1[r]); }
    TRANS_PAD2(p0, p1);
    { float a = fadd_s(p0[0], p1[0]), b = fadd_s(p0[1], p1[1]);
#pragma unroll
      for (int r = 2; r < 16; r += 2) { a = fadd_s(a, p0[r]); b = fadd_s(b, p0[r + 1]); a = fadd_s(a, p1[r]); b = fadd_s(b, p1[r + 1]); }
      A.l += fadd_s(a, b); }
    pa[0] = pack8v(p0, 0, 1.f); pa[1] = pack8v(p0, 8, 1.f); pa[2] = pack8v(p1, 0, 1.f); pa[3] = pack8v(p1, 8, 1.f);
    PIN4(pa[0], pa[1], pa[2], pa[3]);
    return resc;
}
DI void attn_PV(AttnW& A, const bf16x8 (&pa)[4], const LAS unsigned char* Vt, const LAS float* wsf, int lane, bool resc) {
    const int hi = lane >> 5;
    if (resc) {
#pragma unroll
        for (int r = 0; r < 16; ++r) { const float al = wsf[crow(r, hi)];
#pragma unroll
            for (int d = 0; d < 8; ++d) A.o[d][r] *= al; }
    }
    lds_a vb[4];
    { const int q = (lane >> 2) & 3, pp = lane & 3, ch = (lane >> 4) & 1;
#pragma unroll
      for (int dd = 0; dd < 4; ++dd) vb[dd] = LDS_A(Vt) + (unsigned)((4 * hi + q) * 512 + ((64 * dd + 32 * ch + 8 * pp) ^ (q << 6))); }
    s16x4 xl0, xh0, xl1, xh1, yl0, yh0, yl1, yh1;
#define VBATCH(hb, l0, h0, l1, h1) do { TRRD(l0, vb[((hb) >> 1) & 3], ((hb) >> 3) * 256 + ((hb) & 1) * 16384); TRRD(h0, vb[((hb) >> 1) & 3], ((hb) >> 3) * 256 + ((hb) & 1) * 16384 + 4096); \
        TRRD(l1, vb[((hb) >> 1) & 3], ((hb) >> 3) * 256 + ((hb) & 1) * 16384 + 8192); TRRD(h1, vb[((hb) >> 1) & 3], ((hb) >> 3) * 256 + ((hb) & 1) * 16384 + 12288); } while (0)
#define VF(l, h) ((bf16x8){l[0], l[1], l[2], l[3], h[0], h[1], h[2], h[3]})
#define VMMA(hb, l0, h0, l1, h1) do { A.o[(hb) >> 1] = __builtin_amdgcn_mfma_f32_32x32x16_bf16(pa[2 * ((hb) & 1)], VF(l0, h0), A.o[(hb) >> 1], 0, 0, 0); \
        A.o[(hb) >> 1] = __builtin_amdgcn_mfma_f32_32x32x16_bf16(pa[2 * ((hb) & 1) + 1], VF(l1, h1), A.o[(hb) >> 1], 0, 0, 0); } while (0)
#define VSTEP2(hb) do { VBATCH((hb) + 1, yl0, yh0, yl1, yh1); VMMA(hb, xl0, xh0, xl1, xh1); LWAIT4(yl0, yh0, yl1, yh1); \
        VBATCH((hb) + 2, xl0, xh0, xl1, xh1); VMMA((hb) + 1, yl0, yh0, yl1, yh1); LWAIT4(xl0, xh0, xl1, xh1); } while (0)
    VBATCH(0, xl0, xh0, xl1, xh1); LWAIT4(xl0, xh0, xl1, xh1);
    VSTEP2(0); VSTEP2(2); VSTEP2(4); VSTEP2(6); VSTEP2(8); VSTEP2(10); VSTEP2(12);
    VBATCH(15, yl0, yh0, yl1, yh1); VMMA(14, xl0, xh0, xl1, xh1); LWAIT4(yl0, yh0, yl1, yh1);
    VMMA(15, yl0, yh0, yl1, yh1);
#undef VBATCH
#undef VF
#undef VMMA
#undef VSTEP2
}
DI void attn_epilogue(Frame& F, AttnW& A, int h, int row0, bool act, float lam, bool half_l) {
    int lane = F.lane; OPAQUE(lane);
    const int r32 = lane & 31, hi = lane >> 5, rg = F.wave & 3, c = F.wave >> 2;
    LAS float* wsf = (LAS float*)(F.lds + AT_WS + F.wave * 256);
    LAS float* ex = (LAS float*)(F.lds + rg * 32768);
    { float lt = A.l; if (half_l) lt += shfl_xor_l(lt, 32, lane); if (hi == 0) wsf[32 + r32] = lt; }
    WAIT_L(0); CFENCE();
    float rl[16];
#pragma unroll
    for (int r = 0; r < 16; ++r) rl[r] = fast_rcp(wsf[32 + crow(r, hi)]);
    if (c == 1 && act) {
#pragma unroll
        for (int d = 0; d < 8; ++d)
#pragma unroll
            for (int r = 0; r < 16; ++r) ex[crow(r, hi) * 256 + d * 32 + r32] = A.o[d][r] * rl[r] * lam;
    }
    WAIT_L(0); __syncthreads();
    if (c == 0 && act) {
        float sw[8];
#pragma unroll
        for (int d = 0; d < 8; ++d) sw[d] = F.P->in[IN_SUBLN][d * 32 + r32] * (1.0f - LAM_INIT);
#pragma unroll
        for (int r = 0; r < 16; ++r) { const int rr = (r & 3) + 8 * (r >> 2); float s = 0.f; float v[8];
#pragma unroll
            for (int d = 0; d < 8; ++d) { v[d] = A.o[d][r] * rl[r] - ex[(rr + 4 * hi) * 256 + d * 32 + r32]; s += v[d] * v[d]; }
            s += shfl_xor_l(s, 1, lane); s += shfl_xor_l(s, 2, lane); s += shfl_xor_l(s, 4, lane); s += shfl_xor_l(s, 8, lane); s += shfl_xor_l(s, 16, lane);
            const float rs = 1.0f / sqrtf(s * (1.f / 256.f) + EPS);
#pragma unroll
            for (int d = 0; d < 8; ++d) ex[(rr + 4 * hi) * 256 + d * 32 + r32] = v[d] * rs * sw[d];
            SBAR(); }
        WAIT_L(0); CFENCE();
        const bf16_t* GA = (const bf16_t*)(F.ws + WS_GA) + (size_t)(row0 + rg * 32 + hi) * W_A + (size_t)h * 256 + r32 * 8;
        bf16_t* YC = (bf16_t*)(F.ws + WS_YCAT) + (size_t)(row0 + rg * 32 + hi) * D_MODEL + (size_t)h * 256 + r32 * 8;
#pragma unroll 4
        for (int it = 0; it < 16; ++it) { const int row = 2 * it + hi;
            const f32x4 a = *(const LAS f32x4*)(ex + row * 256 + r32 * 8), b = *(const LAS f32x4*)(ex + row * 256 + r32 * 8 + 4);
            const u32x4 g = *(const u32x4*)(GA + (size_t)(2 * it) * W_A);
            u32x4 o; o.x = cvtpk(a[0] * lo_bf(g.x), a[1] * hi_bf(g.x)); o.y = cvtpk(a[2] * lo_bf(g.y), a[3] * hi_bf(g.y)); o.z = cvtpk(b[0] * lo_bf(g.z), b[1] * hi_bf(g.z)); o.w = cvtpk(b[2] * lo_bf(g.w), b[3] * hi_bf(g.w));
            *(u32x4*)(YC + (size_t)(2 * it) * D_MODEL) = o; }
        WAIT_L(0); CFENCE();
    }
    __syncthreads();
}
DI float diff_lambda(const Frame& F) {
    int l = F.lane; OPAQUE(l);
    float a = F.P->in[IN_LQ1][l] * F.P->in[IN_LK1][l] + F.P->in[IN_LQ1][l + 64] * F.P->in[IN_LK1][l + 64], b = F.P->in[IN_LQ2][l] * F.P->in[IN_LK2][l] + F.P->in[IN_LQ2][l + 64] * F.P->in[IN_LK2][l + 64];
#pragma unroll
    for (int o = 1; o < 64; o <<= 1) { a += shfl_xor_l(a, o, l); b += shfl_xor_l(b, o, l); }
    return __builtin_expf(a) - __builtin_expf(b) + LAM_INIT;
}
DI void attn_init(const Frame& F, AttnW& A, int h, int c, int qrow0) {
    int ln = F.lane; OPAQUE(ln);
    const bf16_t* Qg = (const bf16_t*)(F.ws + WS_Q) + (size_t)(qrow0 + (ln & 31)) * W_A + h * 256 + c * 128 + (ln >> 5) * 8;
#pragma unroll
    for (int d0 = 0; d0 < 8; ++d0) A.qr[d0] = *(const bf16x8*)(Qg + d0 * 16);
#pragma unroll
    for (int d = 0; d < 8; ++d) A.o[d] = (f32x16){};
    A.m = 0.f; A.l = 0.f;
}
DI void attn_load_table(const Frame& F, int h) { const float* T = (const float*)(F.ws + WS_TB) + (size_t)h * NTB; LAS float* t = (LAS float*)(F.lds + AT_TB); int t0 = F.tid; OPAQUE(t0); for (int i = t0; i < NTB; i += 512) t[i] = T[i]; }
DI void attn_prompt_unit(Frame& F, int h, int qb, float lam) {
    const int w = F.wave, rg = w & 3, c = w >> 2;
    const LAS float* tbl = (const LAS float*)(F.lds + AT_TB); LAS float* wsf = (LAS float*)(F.lds + AT_WS + w * 256);
    AttnW A; attn_init(F, A, h, c, qb * 128 + rg * 32);
    attn_load_table(F, h);
    const int q0w = qb * 128 + rg * 32, qc = q0w >> 6;
    const int NT = 2 * qb + 3;
    const int NTW = (qc + 2) < NT ? (qc + 2) : NT;
#define KROW(t) ((t) == 0 ? ROW_M0 : ((t) - 1) * 64)
    { int ln = F.lane; OPAQUE(ln); attn_dma_k(F, KROW(0), h, 0, ln); attn_dma_v(F, KROW(0), h, 0, ln); attn_dma_k(F, KROW(1), h, 1, ln); }
    WAIT_V(0); WAIT_L(0); __builtin_amdgcn_s_barrier();
    const float bu = tbl[0];
    bf16x8 pa[4]; f32x16 p0, p1; bool resc = false;
#define KPOS0(t) ((t) == 0 ? -N_META : ((t) - 1) * 64)
#define NEAR(t) (KPOS0(t) + 63 - q0w > -559)
#define DO_QK(t) do { int ln = F.lane; OPAQUE(ln); attn_QK(A, p0, p1, F.lds + AT_K + ((t) & 1) * AT_KB + c * 16384, ln, (NEAR(t) ? 0.f : bu) - A.m); } while (0)
#define DO_SM(t) do { int ln = F.lane; OPAQUE(ln); resc = attn_SM(A, p0, p1, pa, tbl, wsf, ln, NEAR(t) ? KPOS0(t) - (q0w + (ln & 31)) + TB_OFF : -1, (t) == 0 ? N_META : 64, (t) == 0); } while (0)
#define DO_PV(t) do { int ln = F.lane; OPAQUE(ln); attn_PV(A, pa, F.lds + AT_V + ((t) & 1) * AT_KB, wsf, ln, resc); } while (0)
#define END_SUB(issued) do { if (issued) { WAIT_V(4); } else { WAIT_V(0); } WAIT_L(0); __builtin_amdgcn_s_barrier(); } while (0)
#define DMA_K2(u) do { if ((u) < NT) { int ln = F.lane; OPAQUE(ln); attn_dma_k(F, KROW(u), h, (u) & 1, ln); } } while (0)
#define DMA_V2(u) do { if ((u) < NT) { int ln = F.lane; OPAQUE(ln); attn_dma_v(F, KROW(u), h, (u) & 1, ln); } } while (0)
    if (c == 0) {
        DO_QK(0); END_SUB(false);
        for (int t = 0; t < NT; ++t) {
            DMA_K2(t + 2); if (t < NTW) { DO_SM(t); if (t + 1 < NTW) DO_QK(t + 1); } END_SUB(t + 2 < NT);
            DMA_V2(t + 1); if (t < NTW) DO_PV(t); END_SUB(t + 1 < NT);
        }
        END_SUB(false);
    } else {
        DO_QK(0); END_SUB(false);
        DMA_K2(2); END_SUB(2 < NT);
        for (int t = 0; t < NT; ++t) {
            DMA_V2(t + 1); if (t < NTW) { DO_SM(t); if (t + 1 < NTW) DO_QK(t + 1); } END_SUB(t + 1 < NT);
            DMA_K2(t + 3); if (t < NTW) DO_PV(t); END_SUB(t + 3 < NT);
        }
    }
#undef KROW
#undef KPOS0
#undef NEAR
#undef DO_QK
#undef DO_SM
#undef DO_PV
#undef END_SUB
#undef DMA_K2
#undef DMA_V2
    attn_epilogue(F, A, h, qb * 128, true, lam, true);
}
DI void attn_sample_unit(Frame& F, int b, int h, float lam) {
    const int w = F.wave, rg = w & 3, c = w >> 2;
    const LAS float* tbl = (const LAS float*)(F.lds + AT_TB); LAS float* wsf = (LAS float*)(F.lds + AT_WS + w * 256);
    const bool act = rg == 0;
    AttnW A; attn_init(F, A, h, c, ROW_S0 + b * 32); A.m = -1e30f;
    attn_load_table(F, h);
    constexpr int NKEY = LCACHE + DEC_SEQ, NT = (NKEY + 63) / 64;
    const float* CK = F.P->in[IN_CK] + (size_t)b * LCACHE * W_A + h * 256; const float* CV = F.P->in[IN_CV] + (size_t)b * LCACHE * W_A + h * 256;
    const bf16_t* Kn = (const bf16_t*)(F.ws + WS_K) + (size_t)(ROW_S0 + b * 32) * W_A + h * 256; const bf16_t* Vn = (const bf16_t*)(F.ws + WS_V) + (size_t)(ROW_S0 + b * 32) * W_A + h * 256;
    __syncthreads();
    for (int t = 0; t < NT; ++t) {
        int tid = F.tid; OPAQUE(tid); const int lane = tid & 63, r32 = lane & 31;
        const int qpos = PAST_LEN + r32;
        const int key = tid >> 3, j = t * 64 + key, g8 = tid & 7;
#pragma unroll
        for (int kv = 0; kv < 2; ++kv) {
#pragma unroll
            for (int q4 = 0; q4 < 4; ++q4) { const int col = g8 * 32 + q4 * 8; u32x4 wv = {0u, 0u, 0u, 0u};
                if (j < LCACHE) { const float* sp = (kv ? CV : CK) + (size_t)j * W_A + col; const f32x4 a = *(const f32x4*)sp, bq = *(const f32x4*)(sp + 4);
                    wv.x = cvtpk(a[0], a[1]); wv.y = cvtpk(a[2], a[3]); wv.z = cvtpk(bq[0], bq[1]); wv.w = cvtpk(bq[2], bq[3]); }
                else if (j < NKEY) wv = *(const u32x4*)((kv ? Vn : Kn) + (size_t)(j - LCACHE) * W_A + col);
                if (kv == 0) { const int cc = col >> 7, chk = (col & 127) >> 3; *(LAS u32x4*)(F.lds + AT_K + cc * 16384 + key * 256 + ((chk ^ (key & 7)) << 4)) = wv; }
                else { const int kk = (key & ~0xC) | ((key & 4) << 1) | ((key & 8) >> 1); *(LAS u32x4*)(F.lds + AT_V + ((kk >> 3) * 8 + (col >> 5)) * 512 + ((kk & 7) * 32 + (col & 31)) * 2) = wv; } }
        }
        WAIT_VL0(); __syncthreads();
        if (act) { const int kpos0 = t * 64 - N_META; const int nv = NKEY - t * 64;
            attn_tile(A, F.lds + AT_K + c * 16384, F.lds + AT_V, tbl, wsf, lane, kpos0 - qpos + TB_OFF, 0.f, nv < 64 ? nv : 64); }
        WAIT_VL0(); __syncthreads();
    }
    attn_epilogue(F, A, h, ROW_S0 + b * 32, act, lam, false);
}
template <int MIXM, int QB = 0> DI void p4_mixer(Frame& F) {
    constexpr int NAP = NH_A * (SEQ / 128), NAS = DEC_BATCH * NH_A;
    const float lam = diff_lambda(F);
    if (MIXM & 1) { for (int u = F.vcu; u < N_SCAN_P; u += F.G) scan_unit(F, 0, u); }
#define DEQ(qi, uvar) do { __syncthreads(); if (F.tid == 0) F.MISC[16] = __hip_atomic_fetch_add(F.ctl + CW_QUEUE + 64 * (qi), 1u, __ATOMIC_RELAXED, __HIP_MEMORY_SCOPE_AGENT); __syncthreads(); uvar = (int)F.MISC[16]; uvar = __builtin_amdgcn_readfirstlane(uvar); } while (0)
    if (MIXM & 2) {
        const int h0 = (int)(xb_xcc_id() % (unsigned)NH_A);
        for (int hs = 0; hs < NH_A; ++hs) { const int hh = (h0 + hs) % NH_A;
            for (;;) { int a; DEQ(QB + 8 + hh, a); if (a >= SEQ / 128) break; attn_prompt_unit(F, hh, (SEQ / 128 - 1) - a, lam); } }
    }
    if (MIXM & 4) { for (;;) { int a; DEQ(QB + 1, a); if (a >= NAS) break; attn_sample_unit(F, a / NH_A, a % NH_A, lam); } }
    if (MIXM & 1) { for (;;) { int a; DEQ(QB + 2, a); if (a >= N_SCAN_S) break; scan_unit(F, 1, a); } }
#undef DEQ
}

constexpr int N_PHASES = 7;
#ifndef MK_N_LAUNCHES
#define MK_N_LAUNCHES 1
#endif
__global__ void __launch_bounds__(512, 2) hymba_fwd(Params p) {
#ifdef EMU
    unsigned char* lds_raw = emu::cur->block->lds;
#else
    extern __shared__ __attribute__((aligned(16))) unsigned char lds_raw[];
#endif
    Frame F;
    F.lds = (LAS unsigned char*)lds_raw; F.MISC = (volatile LAS unsigned*)(F.lds + MISC_OFF);
    F.wave = __builtin_amdgcn_readfirstlane((int)threadIdx.x >> 6); F.lane = lane_id(); F.tid = F.wave * 64 + F.lane;
    F.G = gridDim.x; { const int bx = blockIdx.x; F.vcu = (F.G % 8 == 0) ? (bx % 8) * (F.G / 8) + bx / 8 : bx; }
    F.P = &p; F.out = p.out; F.ws = p.ws; F.ctl = (unsigned*)(p.ws + WS_CTL);
    for (int u = F.tid; u < (LDS_BYTES - MISC_OFF) / 4; u += 512) ((LAS unsigned*)(F.lds + MISC_OFF))[u] = 0u;
    __syncthreads();
    const bool use_bar = (p.ph_hi - p.ph_lo) > 1;
    XcdBarrier bar; bar.bar = F.ctl + CW_BAR + p.li * XCD_BAR_WORDS; bar.x = 0; bar.st = nullptr; bar.wave = F.wave;
    if (use_bar) bar = xcd_barrier_post(F.ctl + CW_BAR + p.li * XCD_BAR_WORDS, F.MISC + 8, F.wave);
    const int lo = p.ph_lo, hi = p.ph_hi;
#ifdef ONLY_PHASE
#define IN(k) ((k) == ONLY_PHASE && lo <= (k) && (k) < hi)
#else
#define IN(k) (lo <= (k) && (k) < hi)
#endif
#ifdef EMU
#define PHMARK(k) ((void)0)
#else
#define PHMARK(k) asm volatile("; PHASE_MARK " #k ::: "memory")
#endif
#define SEAM(k) do { PHMARK(k); if (IN(k) && IN((k) + 1)) xcd_barrier(bar); F.lane = lane_id(); F.tid = F.wave * 64 + F.lane; } while (0)
#ifndef REPEAT_MASK
#define REPEAT_MASK 0
#endif
#define RBIT(k) ((((REPEAT_MASK) >> (k)) & 1) != 0)
#define P1BODY() do { p1a_skinny(F); __syncthreads(); pg8::Gemm g{(const bf16_t*)(F.ws + WS_XN), (const bf16_t*)(F.ws + WS_WINT), M_MAIN, N_MAIN, D_MODEL}; pg8::AlignedOrder S; S.init(M_MAIN, N_MAIN, F.G, (int)blockIdx.x); \
        EpiIn E{F.out, F.ws}; pg8::gemm_phase<EpiIn, pg8::AlignedOrder, PG8_ALIGN, PG8_SP2>(F.lds, g, S, E, F.wave); } while (0)
#define P5BODY() do { pg8::Gemm g{(const bf16_t*)(F.ws + WS_YCAT), (const bf16_t*)(F.ws + WS_WOUTT), R, D_MODEL, D_MODEL}; pg8::StaticOrder S; S.init(R, D_MODEL, F.G, (int)blockIdx.x); \
        EpiOut E{F.ws}; pg8::gemm_phase<EpiOut, pg8::StaticOrder, PG8_ALIGN, PG8_SP2>(F.lds, g, S, E, F.wave); } while (0)
    if (IN(0)) { p0_prologue(F); if constexpr (RBIT(0)) { __syncthreads(); p0_prologue(F); } } SEAM(0);
    if (IN(1)) { P1BODY(); if constexpr (RBIT(1)) { P1BODY(); } } SEAM(1);
    if (IN(2)) { p2_conv(F); if constexpr (RBIT(2)) { p2_conv(F); } } SEAM(2);
    if (IN(3)) { p3_prep(F); if constexpr (RBIT(3)) { p3_prep(F); } } SEAM(3);
#ifndef MIX_MAIN
#define MIX_MAIN 7
#endif
#ifndef MIX_REP
#define MIX_REP 7
#endif
    if (IN(4)) { p4_mixer<MIX_MAIN>(F); if constexpr (RBIT(4)) { __syncthreads(); p4_mixer<MIX_REP, 32>(F); } } SEAM(4);
    if (IN(5)) { P5BODY(); if constexpr (RBIT(5)) { P5BODY(); } } SEAM(5);
    if (IN(6)) { p5_final(F); if constexpr (RBIT(6)) { p5_final(F); } }
#undef IN
#undef SEAM
}

extern "C" void kernel_launch(void* const* d_in, const int* in_sizes, int n_in, void* d_out, int out_size, void* d_ws, size_t ws_size, hipStream_t stream) {
    static int grid = 0;
    if (grid == 0) {
        if (n_in != 21 || (size_t)out_size != O_END || ws_size < WS_END) { fprintf(stderr, "kernel_launch: shape/workspace mismatch (n_in %d out %d ws %zu need %zu)\n", n_in, out_size, ws_size, (size_t)WS_END); grid = -1; return; }
        int dev = 0, cus = 0;
        if (hipGetDevice(&dev) != hipSuccess || hipDeviceGetAttribute(&cus, hipDeviceAttributeMultiprocessorCount, dev) != hipSuccess) { grid = -1; return; }
        if (hipFuncSetAttribute((const void*)hymba_fwd, hipFuncAttributeMaxDynamicSharedMemorySize, LDS_BYTES) != hipSuccess) { fprintf(stderr, "kernel_launch: hipFuncSetAttribute failed\n"); grid = -1; return; }
        int per_cu = 0; (void)hipOccupancyMaxActiveBlocksPerMultiprocessor(&per_cu, (const void*)hymba_fwd, 512, LDS_BYTES); (void)hipGetLastError();
        grid = cus;
    }
    if (grid < 0) return;
    (void)hipMemsetAsync((char*)d_ws + WS_CTL, 0, CTL_ZERO_BYTES, stream);
    Params p{};
    for (int i = 0; i < 21; ++i) p.in[i] = (const float*)d_in[i];
    p.out = (float*)d_out; p.ws = (unsigned char*)d_ws; p.pad = 0;
#if MK_N_LAUNCHES == 1
    p.ph_lo = 0; p.ph_hi = N_PHASES; p.li = 0;
    hipLaunchKernelGGL(hymba_fwd, dim3(grid), dim3(512), LDS_BYTES, stream, p);
#else
    for (int k = 0; k < N_PHASES; ++k) { p.ph_lo = k; p.ph_hi = k + 1; p.li = 0; hipLaunchKernelGGL(hymba_fwd, dim3(grid), dim3(512), LDS_BYTES, stream, p); }
#endif
}
```

```cpp
#ifndef EMU
#include <hip/hip_runtime.h>
#endif
#include <cstdio>
#include <cstdint>

#define DI __device__ __forceinline__
#ifdef EMU
#define LAS
#define GAS
#define WAIT_V(n) emu::wave_op(emu::op_nop)
#define WAIT_L(n) emu::wave_op(emu::op_nop)
#define WAIT_VL0() emu::wave_op(emu::op_nop)
#define WAIT_V1(n) ((void)0)
#define CFENCE() ((void)0)
#define PINV(x) ((void)0)
#define OPAQUE(x) ((void)0)
#define PIN4(a, b, c, d) ((void)0)
#define PIN2(a, b) ((void)0)
#else
#define LAS __attribute__((address_space(3)))
#define GAS __attribute__((address_space(1)))
#define WAIT_V(n) asm volatile("s_waitcnt vmcnt(" #n ")" ::: "memory")
#define WAIT_L(n) asm volatile("s_waitcnt lgkmcnt(" #n ")" ::: "memory")
#define WAIT_VL0() asm volatile("s_waitcnt vmcnt(0) lgkmcnt(0)" ::: "memory")
#define WAIT_V1(n) asm volatile("s_waitcnt vmcnt(" #n ")" ::: "memory")
#define CFENCE() asm volatile("" ::: "memory")
#define OPAQUE(x) asm volatile("" : "+v"(x))
#define PIN4(a, b, c, d) asm volatile("" : "+v"(a), "+v"(b), "+v"(c), "+v"(d) :: "memory")
#define PIN2(a, b) asm volatile("" : "+v"(a), "+v"(b) :: "memory")
#define PINV(x) asm volatile("" : "+v"(x) :: "memory")
#endif
#define SBAR() __builtin_amdgcn_sched_barrier(0)

#if defined(MIDCFG)
constexpr int D_MODEL = 512, SEQ = 2048, DEC_BATCH = 2, PAST_LEN = 1024;
#elif defined(SMALLCFG)
constexpr int D_MODEL = 512, SEQ = 512, DEC_BATCH = 2, PAST_LEN = 128;
#else
constexpr int D_MODEL = 4096, SEQ = 16384, DEC_BATCH = 32, PAST_LEN = 1024;
#endif
constexpr int DEC_SEQ = 32, N_META = 16, CHUNK = 64;
constexpr int W_A = D_MODEL / 2, NH_A = W_A / 256, W_B = D_MODEL / 2, NH_B = W_B / 128, C3 = 3 * W_B;
constexpr int IN_COLS = 4 * W_A + 4 * W_B + 2 * NH_B;
constexpr int NS = DEC_BATCH * DEC_SEQ;
constexpr int ROW_S0 = SEQ, ROW_M0 = SEQ + NS, NROWS = ROW_M0 + N_META;
constexpr int R = (NROWS + 255) / 256 * 256;
constexpr int NP_IN = (IN_COLS + 255) / 256 * 256;
constexpr int LCACHE = N_META + PAST_LEN;
constexpr int TA = W_A / 256, TB = W_B / 256;
constexpr int NCH_P = SEQ / CHUNK + 1;
constexpr int NSC = NCH_P + DEC_BATCH;
constexpr float EPS = 1e-6f;
constexpr float LOG2E = 1.4426950408889634f;
constexpr float C2Q = 0.08838834764831845f * LOG2E;
constexpr float LAM_INIT = 0.2f;
constexpr size_t O_YP = 0, O_YS = O_YP + (size_t)SEQ * D_MODEL, O_KP = O_YS + (size_t)NS * D_MODEL, O_VP = O_KP + (size_t)(N_META + SEQ) * W_A,
                 O_SP = O_VP + (size_t)(N_META + SEQ) * W_A, O_CP = O_SP + (size_t)NH_B * 16384, O_KS = O_CP + (size_t)3 * C3, O_VS = O_KS + (size_t)NS * W_A,
                 O_SS = O_VS + (size_t)NS * W_A, O_CS = O_SS + (size_t)DEC_BATCH * NH_B * 16384, O_END = O_CS + (size_t)DEC_BATCH * 3 * C3;

typedef unsigned short bf16_t;
typedef short bf16x8 __attribute__((ext_vector_type(8)));
typedef short s16x4 __attribute__((ext_vector_type(4)));
typedef float f32x4 __attribute__((ext_vector_type(4)));
typedef float f32x2 __attribute__((ext_vector_type(2)));
typedef float f32x16 __attribute__((ext_vector_type(16)));
typedef unsigned u32x4 __attribute__((ext_vector_type(4)));
typedef unsigned u32x2 __attribute__((ext_vector_type(2)));

constexpr size_t al256(size_t x) { return (x + 255) / 256 * 256; }
constexpr size_t WS_CTL = 0, CTL_ZERO_BYTES = 1u << 20;
constexpr size_t SZ_WINT = (size_t)NP_IN * D_MODEL * 2, SZ_XN = (size_t)R * D_MODEL * 2, SZ_RA = (size_t)R * W_A * 2, SZ_QKVB = (size_t)R * C3 * 2;
constexpr int PKG_BYTES = 73728;
constexpr size_t SZ_PKG = (size_t)NSC * NH_B * PKG_BYTES;
constexpr size_t WS_WINT = al256(WS_CTL + CTL_ZERO_BYTES);
constexpr size_t WS_XN = WS_WINT + SZ_WINT;
constexpr size_t WS_QKVN = WS_WINT;
constexpr size_t WS_YCAT = WS_WINT;
constexpr size_t WS_WOUTT = al256(WS_XN + SZ_XN);
constexpr size_t WS_Q = al256(WS_WOUTT + (size_t)D_MODEL * D_MODEL * 2), WS_K = WS_Q + SZ_RA, WS_V = WS_K + SZ_RA, WS_GA = WS_V + SZ_RA, WS_GB = WS_GA + SZ_RA;
constexpr size_t WS_QKVB = al256(WS_GB + SZ_RA);
constexpr size_t WS_PKG = WS_QKVB, WS_Y = WS_QKVB;
constexpr size_t SZ_BIG = SZ_PKG > SZ_QKVB ? SZ_PKG : SZ_QKVB;
constexpr size_t WS_AB = al256(WS_QKVB + SZ_BIG);
constexpr size_t WS_BG = al256(WS_AB + (size_t)R * 32 * 4);
constexpr size_t WS_SS = al256(WS_BG + (size_t)R * NH_B * 8);
constexpr int NTB = 1280, TB_OFF = 1216;
constexpr size_t WS_TB = al256(WS_SS + (size_t)R * 64 * 4);
constexpr size_t WS_DEC = al256(WS_TB + (size_t)NH_A * NTB * 4);
constexpr size_t WS_END = al256(WS_DEC + (size_t)NSC * NH_B * 4);
static_assert(SZ_WINT + SZ_XN >= SZ_QKVB && SZ_WINT + SZ_XN >= SZ_XN, "overlay sizes");
static_assert((size_t)R * D_MODEL * 2 <= SZ_BIG, "Y fits the PKG region");

constexpr int CW_TMO = 0, CW_BAR = 4096, CW_QUEUE = 8192;
constexpr int RING_BYTES = 147456;
constexpr int MISC_OFF = RING_BYTES, LDS_BYTES = RING_BYTES + 512;

DI unsigned f2bf(float f) { unsigned u = __builtin_bit_cast(unsigned, f); return (u + 0x7fffu + ((u >> 16) & 1u)) >> 16; }
DI float bf2f(unsigned short b) { return __builtin_bit_cast(float, ((unsigned)b) << 16); }
#ifdef EMU
DI unsigned cvtpk(float lo, float hi) { return f2bf(lo) | (f2bf(hi) << 16); }
DI s16x4 tr16(const LAS void* p) { return emu_tr16((const void*)p); }
#else
typedef __bf16 bf16x2_t __attribute__((ext_vector_type(2)));
typedef short v4i16_t __attribute__((ext_vector_type(4)));
DI unsigned cvtpk(float lo, float hi) { f32x2 v = {lo, hi}; bf16x2_t b = __builtin_convertvector(v, bf16x2_t); return __builtin_bit_cast(unsigned, b); }
DI s16x4 tr16(const LAS void* p) { return __builtin_bit_cast(s16x4, __builtin_amdgcn_ds_read_tr16_b64_v4i16((LAS v4i16_t*)p)); }
#endif
DI int crow_c(int r, int h) { return (r & 3) + 8 * (r >> 2) + 4 * h; }
DI float lo_bf(unsigned w) { return __builtin_bit_cast(float, w << 16); }
DI float hi_bf(unsigned w) { return __builtin_bit_cast(float, w & 0xffff0000u); }
DI float fast_exp2(float x) { return __builtin_amdgcn_exp2f(x); }
DI float fast_rcp(float x) { return __builtin_amdgcn_rcpf(x); }
DI float silu_f(float x) { return x * fast_rcp(1.0f + fast_exp2(-x * LOG2E)); }
#ifdef EMU
DI int lane_id() { return emu::cur->lane; }
#else
DI int lane_id() { return (int)__builtin_amdgcn_mbcnt_hi(~0u, __builtin_amdgcn_mbcnt_lo(~0u, 0u)); }
#endif
#ifdef EMU
DI float shfl_xor_l(float v, int k, int lane) { (void)lane; return __shfl_xor(v, k); }
#else
DI float shfl_xor_l(float v, int k, int lane) { return __builtin_bit_cast(float, __builtin_amdgcn_ds_bpermute((lane ^ k) << 2, __builtin_bit_cast(int, v))); }
#endif
DI float wave_sum(float v) {
#pragma unroll
    for (int o = 1; o < 64; o <<= 1) v += __shfl_xor(v, o);
    return v;
}

#ifdef EMU
typedef const unsigned char* lds_a;
#define LDS_A(p) ((const unsigned char*)(p))
#define TRRD(dst, base, off) dst = tr16((base) + (off))
#define LDRD128(dst, base, off) dst = *(const bf16x8*)((base) + (off))
#define LWAIT8(a, b, c, d, e, f, g, h) WAIT_L(0)
#define LWAIT4(a, b, c, d) WAIT_L(0)
DI void glds16(const void* g, const unsigned char* l) { emu_glds16(g, (void*)l); }
template <class T> DI void asm_lwait2(T&, T&) { WAIT_L(0); }
#else
typedef unsigned lds_a;
#define LDS_A(p) ((unsigned)(size_t)(p))
#define TRRD(dst, base, off) asm volatile("ds_read_b64_tr_b16 %0, %1 offset:%2" : "=&v"(dst) : "v"(base), "i"(off) : "memory")
#define LDRD128(dst, base, off) asm volatile("ds_read_b128 %0, %1 offset:%2" : "=&v"(dst) : "v"(base), "i"(off) : "memory")
#define LWAIT8(a, b, c, d, e, f, g, h) do { asm volatile("s_waitcnt lgkmcnt(0)" : "+v"(a), "+v"(b), "+v"(c), "+v"(d), "+v"(e), "+v"(f), "+v"(g), "+v"(h) :: "memory"); SBAR(); } while (0)
#define LWAIT4(a, b, c, d) do { asm volatile("s_waitcnt lgkmcnt(0)" : "+v"(a), "+v"(b), "+v"(c), "+v"(d) :: "memory"); SBAR(); } while (0)
template <class T> DI void asm_lwait2(T& a, T& b) { asm volatile("s_waitcnt lgkmcnt(0)" : "+v"(a), "+v"(b) :: "memory"); SBAR(); }
DI void glds16(const void* gsrc, unsigned lds_dst) { unsigned keep;
    asm volatile("s_mov_b32 %0, m0\n\ts_mov_b32 m0, %2\n\ts_nop 0\n\tglobal_load_lds_dwordx4 %1, off\n\ts_mov_b32 m0, %0" : "=&s"(keep) : "v"(gsrc), "s"(lds_dst) : "memory"); }
#endif

#ifdef EMU
DI float max3f(float a, float b, float c) { return fmaxf(fmaxf(a, b), c); }
DI float max2f(float a, float b) { return fmaxf(a, b); }
DI float fadd_s(float a, float b) { return a + b; }
#define MFMA_PAD2(a, b) ((void)0)
#define VALU_PAD(x) ((void)0)
#define TRANS_PAD2(a, b) ((void)0)
#else
DI float max3f(float a, float b, float c) { float r; asm("v_max3_f32 %0, %1, %2, %3" : "=v"(r) : "v"(a), "v"(b), "v"(c)); return r; }
DI float max2f(float a, float b) { float r; asm("v_max_f32_e32 %0, %1, %2" : "=v"(r) : "v"(a), "v"(b)); return r; }
DI float fadd_s(float a, float b) { float r; asm("v_add_f32_e32 %0, %1, %2" : "=v"(r) : "v"(a), "v"(b)); return r; }
#define VALU_PAD(x) asm volatile("s_nop 1" : "+v"(x))
#define TRANS_PAD2(a, b) asm volatile("s_nop 3" : "+v"(a), "+v"(b))
#define MFMA_PAD2(a, b) asm volatile("s_nop 15\n\ts_nop 7" : "+v"(a), "+v"(b))
#endif
#define RLX_AGENT __ATOMIC_RELAXED, __HIP_MEMORY_SCOPE_AGENT

#define XB_TMO      128
#define XB_XCNT(j)  (256  + 64 * (j))
#define XB_XSUB(j)  (1280 + 64 * (j))
#define XB_XGEN(j)  (2304 + 64 * (j))
#define XB_TOP      3328
#define XB_TOPGEN   3392
#define XCD_BAR_WORDS 3456
#define XB_SPIN_CAP (1u << 18)
DI unsigned xb_ld(unsigned* p)              { return __hip_atomic_load(p, __ATOMIC_RELAXED, __HIP_MEMORY_SCOPE_AGENT); }
DI unsigned xb_add(unsigned* p, unsigned v) { return __hip_atomic_fetch_add(p, v, __ATOMIC_RELAXED, __HIP_MEMORY_SCOPE_AGENT); }
DI unsigned xb_xcc_id() { return (unsigned)__builtin_amdgcn_s_getreg((3 << 11) | 20) & 0xFu; }
#define XB_SPIN(cond, bar) do { unsigned _sp = 0; while (cond) { __builtin_amdgcn_s_sleep(1); \
    if ((++_sp & 255u) == 0u) { if (xb_ld(&(bar)[XB_TMO])) break; if (_sp > XB_SPIN_CAP) { atomicAdd(&(bar)[XB_TMO], 1u); break; } } } } while (0)
struct XcdBarrier { unsigned* bar; unsigned x; volatile LAS unsigned* st; int wave; };
DI XcdBarrier xcd_barrier_post(unsigned* bar, volatile LAS unsigned* st, int wave) {
    XcdBarrier b; b.bar = bar; b.x = xb_xcc_id(); b.st = st; b.wave = wave;
    if (wave == 0 && lane_id() == 0) (void)xb_add(&bar[XB_XCNT(b.x)], 1u);
    return b;
}
DI void xcd_barrier_complete(unsigned* bar, unsigned x, unsigned& nloc, unsigned& nx) {
    const unsigned G = gridDim.x * gridDim.y * gridDim.z;
    unsigned sum, cnt, mine, sp = 0u;
    for (;;) {
        sum = 0u; cnt = 0u; mine = 0u;
#pragma unroll
        for (unsigned j = 0; j < 16; ++j) { const unsigned c = xb_ld(&bar[XB_XCNT(j)]); sum += c; cnt += (c > 0u) ? 1u : 0u; mine = (j == x) ? c : mine; }
        if (sum == G) break;
        __builtin_amdgcn_s_sleep(1);
        if ((++sp & 255u) == 0u) { if (xb_ld(&bar[XB_TMO])) break; if (sp > XB_SPIN_CAP) { atomicAdd(&bar[XB_TMO], 1u); break; } }
    }
    nloc = mine > 0u ? mine : 1u; nx = cnt > 0u ? cnt : 1u;
}
DI void xcd_barrier(const XcdBarrier& b) {
    WAIT_V(0);
    __syncthreads();
    if (b.wave == 0 && lane_id() == 0) {
        unsigned* bar = b.bar;
        __builtin_amdgcn_s_waitcnt(0);
        unsigned nloc = b.st[0], nx = b.st[1];
        if (nloc == 0u) { xcd_barrier_complete(bar, b.x, nloc, nx); b.st[0] = nloc; b.st[1] = nx; }
        const unsigned old = xb_add(&bar[XB_XSUB(b.x)], 1u);
        const unsigned gen = old / nloc;
        if (old + 1u == (gen + 1u) * nloc) {
            __builtin_amdgcn_fence(__ATOMIC_RELEASE, "agent");
            WAIT_V1(0);
            const unsigned og = xb_add(&bar[XB_TOP], 1u);
            const unsigned tg = og / nx;
            if (og + 1u == (tg + 1u) * nx) xb_add(&bar[XB_TOPGEN], 1u);
            else XB_SPIN(xb_ld(&bar[XB_TOPGEN]) == tg, bar);
            __builtin_amdgcn_fence(__ATOMIC_ACQUIRE, "agent");
            xb_add(&bar[XB_XGEN(b.x)], 1u);
            WAIT_V1(0);
        } else {
            XB_SPIN(xb_ld(&bar[XB_XGEN(b.x)]) == gen, bar);
            __builtin_amdgcn_fence(__ATOMIC_ACQUIRE, "agent");
            WAIT_V1(0);
        }
    }
    __syncthreads();
}

namespace pg8 {
constexpr int BM = 256, BK = 64, HALF = 128, HTB = HALF * BK * 2, STAGE_BYTES = 8 * HTB, NXCD = 8, WGM = 8;
DI int lds_byte(int r, int c) { const int st = (r >> 4) * 2 + (c >> 5), rr = r & 15, cc = c & 31, ob = rr * 64 + cc * 2; return st * 1024 + (ob ^ (((ob >> 9) & 1) << 5)); }
DI void stage_rc(int b, int& R_, int& C_) { const int st = b / 1024, sb = b % 1024, swz = sb ^ (((sb >> 9) & 1) << 5); R_ = (st >> 1) * 16 + swz / 64; C_ = (st & 1) * 32 + (swz % 64) / 2; }
DI int perm32(int rho) { const int n = rho >> 4, i = rho & 15; return 8 * (i >> 2) + 4 * n + (i & 3); }
struct Unit { int pm, pn; };
struct Gemm { const bf16_t* A; const bf16_t* Bt; int M, N, K; };
struct StaticOrder {
    int nM, nN, nwg, G, c;
    DI void init(int M, int N, int G_, int c_) { nM = M / BM; nN = N / BM; nwg = nM * nN; G = G_; c = c_; }
    DI bool next(int i, Unit& u) const {
        const long L = (long)i * G + c; if (L >= nwg) return false;
        int wgid = (int)L; { const int q = nwg / NXCD, r = nwg % NXCD, xcd = wgid % NXCD, off = wgid / NXCD; wgid = (xcd < r ? xcd * (q + 1) : r * (q + 1) + (xcd - r) * q) + off; }
        const int nig = WGM * nN, gid = wgid / nig, fm = gid * WGM, gsz = (nM - fm) < WGM ? (nM - fm) : WGM;
        u.pm = fm + ((wgid % nig) % gsz); u.pn = (wgid % nig) / gsz; return true;
    }
    DI void a_ready(const Unit&) const {}
    DI void done(const Unit&) const {}
};
struct AlignedOrder {
    StaticOrder so; bool al;
    DI void init(int M, int N, int G_, int c_) { so.init(M, N, G_, c_); al = (G_ == 256 && so.nM == 68 && so.nN == 64); }
    DI bool next(int i, Unit& u) const {
        if (!al) return so.next(i, u);
        if (i > 16) return false;
        const int xcd = so.c & 7, slot = so.c >> 3;
        if (i < 16) { u.pm = 8 * xcd + (slot & 7); u.pn = 4 * i + (slot >> 3); } else { u.pm = 64 + (slot & 3); u.pn = 8 * xcd + (slot >> 2); }
        return true;
    }
    DI void a_ready(const Unit&) const {}
    DI void done(const Unit&) const {}
};
template <class Epi, class Sched, bool ALIGN_EPI = false, bool SP2 = false>
DI void gemm_phase(LAS unsigned char* lds, const Gemm g, const Sched& S, const Epi& E, int wid) {
    const int lane = lane_id(), tid = wid * 64 + lane, wr = wid >> 2, wc = wid & 3, fr = lane & 15, fq = lane >> 4;
    const int K = g.K, nt = K / BK;
    unsigned voffA[2], voffB[2];
#pragma unroll
    for (int i = 0; i < 2; ++i) { int R_, C_; stage_rc(tid * 16 + i * 8192, R_, C_); const int Rb = Epi::PERM ? ((R_ & ~31) + perm32(R_ & 31)) : R_;
        voffA[i] = (unsigned)(R_ * K + C_) * 2u; voffB[i] = (unsigned)(Rb * K + C_) * 2u; }
    const size_t kstep = (size_t)(BK * 2);
    const size_t hstep = (size_t)HALF * K * 2;
    const size_t tstep = 2 * hstep;
    const unsigned ldsw = (unsigned)wid * 1024u;
    const int aoff = lds_byte(wr * 64 + fr, fq * 8), boff = lds_byte(wc * 32 + fr, fq * 8);
#define PG8_SA(b, h) (((b) * 2 + (h)) * HTB)
#define PG8_SB(b, h) ((4 + (b) * 2 + (h)) * HTB)
#define PG8_STAGE(bufoff, gbase, voff) do { _Pragma("unroll") for (int _i = 0; _i < 2; ++_i) \
        __builtin_amdgcn_global_load_lds((const unsigned*)((const char*)(gbase) + (voff)[_i]), (LAS unsigned*)(lds + (bufoff) + ldsw + _i * 8192), 16, 0, 0); } while (0)
#define PG8_LDA(dst, b, h) do { _Pragma("unroll") for (int m = 0; m < 4; ++m) _Pragma("unroll") for (int k = 0; k < 2; ++k) dst[m][k] = *(const LAS bf16x8*)(lds + PG8_SA(b, h) + aoff + m * 2048 + k * 1024); } while (0)
#define PG8_LDB(dst, b, h) do { _Pragma("unroll") for (int n = 0; n < 2; ++n) _Pragma("unroll") for (int k = 0; k < 2; ++k) dst[n][k] = *(const LAS bf16x8*)(lds + PG8_SB(b, h) + boff + n * 2048 + k * 1024); } while (0)
#define PG8_MMA(ai, bj, At, Bt) do { __builtin_amdgcn_s_setprio(1); _Pragma("unroll") for (int m = 0; m < 4; ++m) _Pragma("unroll") for (int n = 0; n < 2; ++n) _Pragma("unroll") for (int k = 0; k < 2; ++k) \
        acc[ai][bj][m][n] = __builtin_amdgcn_mfma_f32_16x16x32_bf16(Bt[n][k], At[m][k], acc[ai][bj][m][n], 0, 0, 0); __builtin_amdgcn_s_setprio(0); } while (0)
#define PG8_WAIT_V(n) WAIT_V(n)
#define PG8_WAIT_L(n) WAIT_L(n)
#define PG8_BAR __builtin_amdgcn_s_barrier()
#define PG8_SCHED __builtin_amdgcn_sched_barrier(0)
    Unit cur, nxt; int ui = 0;
    if (!S.next(0, cur)) return;
    f32x4 acc[2][2][4][2];
#pragma unroll
    for (int a = 0; a < 2; ++a)
#pragma unroll
        for (int b = 0; b < 2; ++b)
#pragma unroll
            for (int m = 0; m < 4; ++m)
#pragma unroll
                for (int n = 0; n < 2; ++n) acc[a][b][m][n] = (f32x4){0.f, 0.f, 0.f, 0.f};
    bf16x8 At[4][2], B0[2][2], B1[2][2];
    const char* cA = (const char*)g.A + (size_t)cur.pm * tstep; const char* cB = (const char*)g.Bt + (size_t)cur.pn * tstep;
    S.a_ready(cur);
    if constexpr (SP2) {
        PG8_STAGE(PG8_SB(0, 0), cB, voffB); PG8_STAGE(PG8_SB(0, 1), cB + hstep, voffB); PG8_STAGE(PG8_SA(0, 0), cA, voffA); PG8_STAGE(PG8_SA(0, 1), cA + hstep, voffA);
        if (wr == 1) PG8_BAR;
        PG8_WAIT_V(2); PG8_BAR;
        PG8_STAGE(PG8_SB(1, 0), cB + kstep, voffB); PG8_STAGE(PG8_SA(1, 0), cA + kstep, voffA); PG8_STAGE(PG8_SB(1, 1), cB + hstep + kstep, voffB);
        PG8_WAIT_V(6); PG8_BAR;
    } else {
        PG8_STAGE(PG8_SB(0, 0), cB, voffB); PG8_STAGE(PG8_SA(0, 0), cA, voffA); PG8_STAGE(PG8_SB(0, 1), cB + hstep, voffB); PG8_STAGE(PG8_SA(0, 1), cA + hstep, voffA);
        if (wr == 1) PG8_BAR;
        PG8_WAIT_V(4); PG8_BAR;
        PG8_STAGE(PG8_SB(1, 0), cB + kstep, voffB); PG8_STAGE(PG8_SA(1, 0), cA + kstep, voffA); PG8_STAGE(PG8_SB(1, 1), cB + hstep + kstep, voffB);
        PG8_WAIT_V(6); PG8_BAR;
    }
    for (;;) {
        const bool has_next = S.next(ui + 1, nxt);
        const char* nA = has_next ? (const char*)g.A + (size_t)nxt.pm * tstep : cA; const char* nB = has_next ? (const char*)g.Bt + (size_t)nxt.pn * tstep : cB;
        for (int t = 0; t < nt; t += 2) {
            const bool last = (t == nt - 2);
            const char* a1 = cA + (size_t)(t + 1) * kstep;
            const char* a2 = last ? nA : cA + (size_t)(t + 2) * kstep; const char* b2 = last ? nB : cB + (size_t)(t + 2) * kstep;
            const char* a3 = a2 + kstep; const char* b3 = b2 + kstep;
            if (last && has_next) S.a_ready(nxt);
            if constexpr (SP2) {
            PG8_LDB(B0, 0, 0); PG8_LDB(B1, 0, 1); PG8_SCHED; PG8_LDA(At, 0, 0); PG8_STAGE(PG8_SA(1, 1), a1 + hstep, voffA);
            PG8_WAIT_V(8); PG8_WAIT_L(0); PG8_BAR; PG8_MMA(0, 0, At, B0); PG8_MMA(0, 1, At, B1); PG8_BAR; PG8_SCHED;
            PG8_LDA(At, 0, 1); PG8_STAGE(PG8_SB(0, 0), b2, voffB); PG8_STAGE(PG8_SB(0, 1), b2 + hstep, voffB); PG8_STAGE(PG8_SA(0, 0), a2, voffA);
            PG8_WAIT_V(8); PG8_WAIT_L(0); PG8_BAR; PG8_MMA(1, 0, At, B0); PG8_MMA(1, 1, At, B1); PG8_BAR; PG8_SCHED;
            PG8_LDB(B0, 1, 0); PG8_LDB(B1, 1, 1); PG8_SCHED; PG8_LDA(At, 1, 0); PG8_STAGE(PG8_SA(0, 1), a2 + hstep, voffA);
            PG8_WAIT_V(8); PG8_WAIT_L(0); PG8_BAR; PG8_MMA(0, 0, At, B0); PG8_MMA(0, 1, At, B1); PG8_BAR; PG8_SCHED;
            PG8_LDA(At, 1, 1); PG8_STAGE(PG8_SB(1, 0), b3, voffB); PG8_STAGE(PG8_SB(1, 1), b3 + hstep, voffB); PG8_STAGE(PG8_SA(1, 0), a3, voffA);
            PG8_WAIT_V(8); PG8_WAIT_L(0); PG8_BAR; PG8_MMA(1, 0, At, B0); PG8_MMA(1, 1, At, B1); PG8_BAR; PG8_SCHED;
            } else {
            PG8_LDB(B0, 0, 0); PG8_SCHED; PG8_LDA(At, 0, 0); PG8_STAGE(PG8_SA(1, 1), a1 + hstep, voffA);
            PG8_WAIT_L(8); PG8_BAR; PG8_WAIT_L(0); PG8_MMA(0, 0, At, B0); PG8_BAR; PG8_SCHED;
            PG8_LDB(B1, 0, 1); PG8_STAGE(PG8_SB(0, 0), b2, voffB);
            PG8_BAR; PG8_WAIT_L(0); PG8_MMA(0, 1, At, B1); PG8_BAR;
            PG8_LDA(At, 0, 1); PG8_STAGE(PG8_SA(0, 0), a2, voffA);
            PG8_BAR; PG8_WAIT_L(0); PG8_MMA(1, 0, At, B0); PG8_BAR; PG8_SCHED;
            PG8_STAGE(PG8_SB(0, 1), b2 + hstep, voffB);
            PG8_WAIT_V(6); PG8_BAR; PG8_MMA(1, 1, At, B1); PG8_BAR;
            PG8_LDB(B0, 1, 0); PG8_SCHED; PG8_LDA(At, 1, 0); PG8_STAGE(PG8_SA(0, 1), a2 + hstep, voffA);
            PG8_WAIT_L(8); PG8_BAR; PG8_WAIT_L(0); PG8_MMA(0, 0, At, B0); PG8_BAR; PG8_SCHED;
            PG8_LDB(B1, 1, 1); PG8_STAGE(PG8_SB(1, 0), b3, voffB);
            PG8_BAR; PG8_WAIT_L(0); PG8_MMA(0, 1, At, B1); PG8_BAR;
            PG8_LDA(At, 1, 1); PG8_STAGE(PG8_SA(1, 0), a3, voffA);
            PG8_BAR; PG8_WAIT_L(0); PG8_MMA(1, 0, At, B0); PG8_BAR; PG8_SCHED;
            PG8_STAGE(PG8_SB(1, 1), b3 + hstep, voffB);
            PG8_WAIT_V(6); PG8_BAR; PG8_MMA(1, 1, At, B1); PG8_BAR;
            }
        }
        if constexpr (ALIGN_EPI) { if (wr == 0) PG8_BAR; }
        E(acc, cur, wr, wc, fr, fq); S.done(cur);
        if (!has_next) break;
#pragma unroll
        for (int a = 0; a < 2; ++a)
#pragma unroll
            for (int b = 0; b < 2; ++b)
#pragma unroll
                for (int m = 0; m < 4; ++m)
#pragma unroll
                    for (int n = 0; n < 2; ++n) acc[a][b][m][n] = (f32x4){0.f, 0.f, 0.f, 0.f};
        cur = nxt; cA = nA; cB = nB; ++ui;
        if constexpr (ALIGN_EPI) { if (wr == 1) PG8_BAR; }
    }
    PG8_WAIT_V(0);
    if constexpr (!ALIGN_EPI) { if (wr == 0) PG8_BAR; }
    PG8_BAR;
#undef PG8_SA
#undef PG8_SB
#undef PG8_STAGE
#undef PG8_LDA
#undef PG8_LDB
#undef PG8_MMA
#undef PG8_WAIT_V
#undef PG8_WAIT_L
#undef PG8_BAR
#undef PG8_SCHED
}
}
#ifndef PG8_SP2
#define PG8_SP2 true
#endif
#ifndef PG8_ALIGN
#define PG8_ALIGN true
#endif

struct Params {
    const float* in[21]; float* out; unsigned char* ws; int ph_lo, ph_hi, li, pad;
};
struct Frame {
    LAS unsigned char* lds; volatile LAS unsigned* MISC; unsigned* ctl;
    int tid, lane, wave, vcu, G;
    const Params* P; float* out; unsigned char* ws;
};
enum { IN_XP = 0, IN_XS, IN_CK, IN_CV, IN_SSM, IN_CONVS, IN_META, IN_RELB, IN_PREN, IN_WIN, IN_LQ1, IN_LK1, IN_LQ2, IN_LK2, IN_SUBLN, IN_CONVW, IN_ALOG, IN_DTB, IN_NORMB, IN_WOUT, IN_POSTN };

DI const float* src_row(const Frame& F, int r) {
    if (r < ROW_S0) return F.P->in[IN_XP] + (size_t)r * D_MODEL;
    if (r < ROW_M0) return F.P->in[IN_XS] + (size_t)(r - ROW_S0) * D_MODEL;
    if (r < NROWS) return F.P->in[IN_META] + (size_t)(r - ROW_M0) * D_MODEL;
    return nullptr;
}

DI void p0_transpose_item(const float* W, int K, int N, bf16_t* WT, LAS float* scr, int item, int nblk, int lane) {
    const int kb = item / nblk, nb = item % nblk, k0 = 64 * kb, n0 = 64 * nb;
    const int c4 = (lane & 15) * 4, r0 = lane >> 4;
    f32x4 v[16];
#pragma unroll
    for (int i = 0; i < 16; ++i) { const int kk = 4 * i + r0; v[i] = (n0 + c4 < N) ? *(const f32x4*)(W + (size_t)(k0 + kk) * N + n0 + c4) : (f32x4){0.f, 0.f, 0.f, 0.f}; }
#pragma unroll
    for (int i = 0; i < 16; ++i) { const int kk = 4 * i + r0; LAS float* d = scr + kk * 65 + c4; d[0] = v[i][0]; d[1] = v[i][1]; d[2] = v[i][2]; d[3] = v[i][3]; }
    WAIT_L(0); CFENCE();
    const int c = lane & 7;
#pragma unroll
    for (int j = 0; j < 8; ++j) { const int n = (lane >> 3) + 8 * j; const LAS float* sp = scr + (8 * c) * 65 + n;
        u32x4 o; o.x = cvtpk(sp[0 * 65], sp[1 * 65]); o.y = cvtpk(sp[2 * 65], sp[3 * 65]); o.z = cvtpk(sp[4 * 65], sp[5 * 65]); o.w = cvtpk(sp[6 * 65], sp[7 * 65]);
        *(u32x4*)(WT + (size_t)(n0 + n) * K + k0 + 8 * c) = o; }
    WAIT_L(0); CFENCE();
}
DI int rel_bucket_dev(int rel) {
    const int n = rel < 0 ? -rel : rel;
    int b = n < 8 ? n : 8 + (n >= 15) + (n >= 27) + (n >= 50) + (n >= 91) + (n >= 166) + (n >= 305) + (n >= 559);
    return (rel > 0 ? 16 : 0) + b;
}
DI void p0_prologue(Frame& F) {
    LAS float* scr = (LAS float*)(F.lds + F.wave * 16896);
    const int gw = F.vcu * 8 + F.wave, NGW = F.G * 8;
    bf16_t* WinT = (bf16_t*)(F.ws + WS_WINT); bf16_t* WoutT = (bf16_t*)(F.ws + WS_WOUTT); bf16_t* XN = (bf16_t*)(F.ws + WS_XN);
    constexpr int NB_IN = NP_IN / 64, I_IN = (D_MODEL / 64) * NB_IN, NB_O = D_MODEL / 64, I_O = (D_MODEL / 64) * NB_O;
    for (int it = gw; it < I_IN + I_O; it += NGW) {
        if (it < I_IN) p0_transpose_item(F.P->in[IN_WIN], D_MODEL, IN_COLS, WinT, scr, it, NB_IN, F.lane);
        else p0_transpose_item(F.P->in[IN_WOUT], D_MODEL, D_MODEL, WoutT, scr, it - I_IN, NB_O, F.lane);
    }
    constexpr int NJ = D_MODEL / 256;
    for (int r = gw; r < R; r += NGW) {
        const float* xr = src_row(F, r);
        unsigned long long* o8 = (unsigned long long*)(XN + (size_t)r * D_MODEL) + F.lane;
        if (!xr) {
#pragma unroll
            for (int j = 0; j < NJ; ++j) o8[64 * j] = 0ull;
            continue; }
        f32x4 v[NJ]; float s = 0.f;
#pragma unroll
        for (int j = 0; j < NJ; ++j) { v[j] = ((const f32x4*)xr)[F.lane + 64 * j]; s += (v[j].x * v[j].x + v[j].y * v[j].y) + (v[j].z * v[j].z + v[j].w * v[j].w); }
        const float rs = 1.0f / sqrtf(wave_sum(s) * (1.f / D_MODEL) + EPS);
#pragma unroll
        for (int j = 0; j < NJ; ++j) { const f32x4 w = ((const f32x4*)F.P->in[IN_PREN])[F.lane + 64 * j];
            o8[64 * j] = (unsigned long long)cvtpk(v[j].x * rs * w.x, v[j].y * rs * w.y) | ((unsigned long long)cvtpk(v[j].z * rs * w.z, v[j].w * rs * w.w) << 32); }
    }
    float* TBL = (float*)(F.ws + WS_TB);
    for (int i = F.vcu * 512 + F.tid; i < NH_A * NTB; i += F.G * 512) { const int h = i / NTB, idx = i % NTB; TBL[i] = F.P->in[IN_RELB][rel_bucket_dev(idx - TB_OFF) * NH_A + h] * LOG2E; }
}

struct EpiIn {
    static constexpr bool PERM = true;
    float* out; unsigned char* ws;
    DI void operator()(const f32x4 (&acc)[2][2][4][2], const pg8::Unit& u, int wr, int wc, int fr, int fq) const {
        const int pn = u.pn; const int row0 = u.pm * 256 + wr * 64 + fr;
        int seg, colt;
        if (pn < 4 * TA) { seg = pn / TA; colt = (pn - seg * TA) * 256; }
        else if (pn < 4 * TA + 3 * TB) { seg = 4; colt = (pn - 4 * TA) * 256; }
        else if (pn < 4 * TA + 4 * TB) { seg = 5; colt = (pn - 4 * TA - 3 * TB) * 256; }
        else { seg = 6; colt = 0; }
        const int col0 = colt + wc * 32 + 8 * fq;
#pragma unroll
        for (int ai = 0; ai < 2; ++ai)
#pragma unroll
            for (int m = 0; m < 4; ++m) {
                const int r = row0 + ai * 128 + m * 16;
#pragma unroll
                for (int bj = 0; bj < 2; ++bj) {
                    const f32x4 v0 = acc[ai][bj][m][0], v1 = acc[ai][bj][m][1]; const int col = col0 + bj * 128;
                    if (seg == 0) { u32x4 w; w.x = cvtpk(v0[0] * C2Q, v0[1] * C2Q); w.y = cvtpk(v0[2] * C2Q, v0[3] * C2Q); w.z = cvtpk(v1[0] * C2Q, v1[1] * C2Q); w.w = cvtpk(v1[2] * C2Q, v1[3] * C2Q);
                        *(u32x4*)((bf16_t*)(ws + WS_Q) + (size_t)r * W_A + col) = w; }
                    else if (seg == 1 || seg == 2) {
                        u32x4 w; w.x = cvtpk(v0[0], v0[1]); w.y = cvtpk(v0[2], v0[3]); w.z = cvtpk(v1[0], v1[1]); w.w = cvtpk(v1[2], v1[3]);
                        *(u32x4*)((bf16_t*)(ws + (seg == 1 ? WS_K : WS_V)) + (size_t)r * W_A + col) = w;
                        float* o = nullptr;
                        if (r < ROW_S0) o = out + (seg == 1 ? O_KP : O_VP) + (size_t)(N_META + r) * W_A;
                        else if (r < ROW_M0) o = out + (seg == 1 ? O_KS : O_VS) + (size_t)(r - ROW_S0) * W_A;
                        else if (r < NROWS) o = out + (seg == 1 ? O_KP : O_VP) + (size_t)(r - ROW_M0) * W_A;
                        if (o) { *(f32x4*)(o + col) = v0; *(f32x4*)(o + col + 4) = v1; } }
                    else if (seg == 3 || seg == 5) {
                        u32x4 w; w.x = cvtpk(silu_f(v0[0]), silu_f(v0[1])); w.y = cvtpk(silu_f(v0[2]), silu_f(v0[3])); w.z = cvtpk(silu_f(v1[0]), silu_f(v1[1])); w.w = cvtpk(silu_f(v1[2]), silu_f(v1[3]));
                        *(u32x4*)((bf16_t*)(ws + (seg == 3 ? WS_GA : WS_GB)) + (size_t)r * W_A + col) = w; }
                    else if (seg == 4) {
                        u32x4 w; w.x = cvtpk(v0[0], v0[1]); w.y = cvtpk(v0[2], v0[3]); w.z = cvtpk(v1[0], v1[1]); w.w = cvtpk(v1[2], v1[3]);
                        *(u32x4*)((bf16_t*)(ws + WS_QKVB) + (size_t)r * C3 + col) = w;
                        float* o = nullptr;
                        if (r >= SEQ - 3 && r < SEQ) o = out + O_CP + (size_t)(r - (SEQ - 3)) * C3;
                        else if (r >= ROW_S0 && r < ROW_M0 && ((r - ROW_S0) & 31) >= 29) o = out + O_CS + (size_t)(((r - ROW_S0) >> 5) * 3 + (((r - ROW_S0) & 31) - 29)) * C3;
                        if (o) { *(f32x4*)(o + col) = v0; *(f32x4*)(o + col + 4) = v1; } }
                    else { if (col < 32) { float* o = (float*)(ws + WS_AB) + (size_t)r * 32 + col; *(f32x4*)o = v0; *(f32x4*)(o + 4) = v1; } }
                }
            }
    }
};

struct EpiOut {
    static constexpr bool PERM = true;
    unsigned char* ws;
    DI void operator()(const f32x4 (&acc)[2][2][4][2], const pg8::Unit& u, int wr, int wc, int fr, int fq) const {
        const int row0 = u.pm * 256 + wr * 64 + fr, col0 = u.pn * 256 + wc * 32 + 8 * fq;
        bf16_t* Y = (bf16_t*)(ws + WS_Y); float* SSp = (float*)(ws + WS_SS);
#pragma unroll
        for (int ai = 0; ai < 2; ++ai)
#pragma unroll
            for (int m = 0; m < 4; ++m) {
                const int r = row0 + ai * 128 + m * 16; float s = 0.f;
#pragma unroll
                for (int bj = 0; bj < 2; ++bj) { const f32x4 v0 = acc[ai][bj][m][0], v1 = acc[ai][bj][m][1];
                    s += (v0[0] * v0[0] + v0[1] * v0[1]) + (v0[2] * v0[2] + v0[3] * v0[3]) + (v1[0] * v1[0] + v1[1] * v1[1]) + (v1[2] * v1[2] + v1[3] * v1[3]);
                    u32x4 w; w.x = cvtpk(v0[0], v0[1]); w.y = cvtpk(v0[2], v0[3]); w.z = cvtpk(v1[0], v1[1]); w.w = cvtpk(v1[2], v1[3]);
                    *(u32x4*)(Y + (size_t)r * D_MODEL + col0 + bj * 128) = w; }
                s += __shfl_xor(s, 16); s += __shfl_xor(s, 32);
                if (fq == 0) SSp[(size_t)r * 64 + u.pn * 4 + wc] = s;
            }
    }
};
static_assert(D_MODEL / 256 * 4 <= 64, "SS slots");

constexpr int M_MAIN = (ROW_M0 + 255) / 256 * 256, N_MAIN = 4 * W_A + 4 * W_B;
constexpr int SK_AB_TILES = (NROWS + 31) / 32, SK_META_TILES = (2 * W_A + 3 * W_B) / 32;
#define SK_LOAD(A_, B_, KB_) do { const int kk_ = 64 * ((KB_) < kbe ? (KB_) : kbe - 1); _Pragma("unroll") for (int q = 0; q < 4; ++q) { A_[q] = *(const bf16x8*)(ap + kk_ + 8 * q); B_[q] = *(const bf16x8*)(bp + kk_ + 8 * q); } } while (0)
#define SK_MMA(A_, B_) do { _Pragma("unroll") for (int q = 0; q < 4; ++q) acc = __builtin_amdgcn_mfma_f32_32x32x16_bf16(A_[q], B_[q], acc, 0, 0, 0); } while (0)
DI f32x16 skinny_tile(const bf16_t* Arows, const bf16_t* Brows, int lane, int kb0, int nkb) {
    const int r = lane & 31, h = lane >> 5, kbe = kb0 + nkb;
    const bf16_t* ap = Arows + (size_t)r * D_MODEL + 32 * h; const bf16_t* bp = Brows + (size_t)r * D_MODEL + 32 * h;
    f32x16 acc = {};
    bf16x8 A0[4], B0[4], A1[4], B1[4], A2[4], B2[4], A3[4], B3[4];
    SK_LOAD(A0, B0, kb0); SK_LOAD(A1, B1, kb0 + 1); SK_LOAD(A2, B2, kb0 + 2);
    for (int kb = kb0; kb < kbe; kb += 4) {
        SK_LOAD(A3, B3, kb + 3); SBAR(); SK_MMA(A0, B0); SBAR();
        SK_LOAD(A0, B0, kb + 4); SBAR(); SK_MMA(A1, B1); SBAR();
        SK_LOAD(A1, B1, kb + 5); SBAR(); SK_MMA(A2, B2); SBAR();
        SK_LOAD(A2, B2, kb + 6); SBAR(); SK_MMA(A3, B3); SBAR();
    }
    return acc;
}
static_assert((D_MODEL / 64 / 2) % 4 == 0, "skinny K halves are whole prefetch rings");
DI void p1a_skinny(Frame& F) {
    const int lane = F.lane, j = lane & 31, h = lane >> 5, ws4 = F.wave & 3, kh = F.wave >> 2;
    const bf16_t* XN = (const bf16_t*)(F.ws + WS_XN); const bf16_t* WinT = (const bf16_t*)(F.ws + WS_WINT);
    constexpr int NT = SK_AB_TILES + SK_META_TILES, NKH = D_MODEL / 64 / 2;
    float* xch = (float*)(F.lds) + (size_t)ws4 * 64 * 17;
    const int nit = (NT + F.G * 4 - 1) / (F.G * 4);
    for (int n = 0; n < nit; ++n) {
        const int it = F.vcu + F.G * (ws4 + 4 * n);
        const bool valid = it < NT, isab = it < SK_AB_TILES;
        int seg = 0, colp = 0; const bf16_t* Ar = WinT + (size_t)N_MAIN * D_MODEL; const bf16_t* Br = XN;
        if (valid) {
            if (isab) Br = XN + (size_t)(32 * it) * D_MODEL;
            else {
                const int ct = it - SK_AB_TILES;
                if (ct < W_A / 32) { seg = 0; colp = 32 * ct; } else if (ct < 2 * W_A / 32) { seg = 1; colp = 32 * ct - W_A; } else { seg = 2; colp = 32 * ct - 2 * W_A; }
                const int gcol = seg == 0 ? W_A + colp : (seg == 1 ? 2 * W_A + colp : 4 * W_A + colp);
                Ar = XN + (size_t)ROW_M0 * D_MODEL; Br = WinT + (size_t)gcol * D_MODEL;
            }
        }
        f32x16 acc = {};
        if (valid) acc = skinny_tile(Ar, Br, lane, kh * NKH, NKH);
        if (kh == 1) {
#pragma unroll
            for (int q = 0; q < 16; ++q) xch[lane * 17 + q] = acc[q]; }
        __syncthreads();
        if (kh == 0 && valid) {
#pragma unroll
            for (int q = 0; q < 16; ++q) acc[q] += xch[lane * 17 + q];
            if (isab) {
                float* o = (float*)(F.ws + WS_AB) + (size_t)(32 * it + j) * 32 + 4 * h;
#pragma unroll
                for (int q = 0; q < 4; ++q) *(f32x4*)(o + 8 * q) = (f32x4){acc[4 * q], acc[4 * q + 1], acc[4 * q + 2], acc[4 * q + 3]};
            } else {
#pragma unroll
                for (int r = 0; r < 8; ++r) { const int tok = crow_c(r, h); const float v = acc[r];
                    if (seg == 2) ((bf16_t*)(F.ws + WS_QKVB))[(size_t)(ROW_M0 + tok) * C3 + colp + j] = (bf16_t)f2bf(v);
                    else { ((bf16_t*)(F.ws + (seg == 0 ? WS_K : WS_V)))[(size_t)(ROW_M0 + tok) * W_A + colp + j] = (bf16_t)f2bf(v);
                           F.out[(seg == 0 ? O_KP : O_VP) + (size_t)tok * W_A + colp + j] = v; } }
            }
        }
        __syncthreads();
    }
}
DI int dummy_unused() { return 0; }

DI void p5_final(Frame& F) {
    const int gw = F.vcu * 8 + F.wave, NGW = F.G * 8;
    const bf16_t* Y = (const bf16_t*)(F.ws + WS_Y); const float* SSp = (const float*)(F.ws + WS_SS);
    constexpr int NJ = D_MODEL / 512, NSL = D_MODEL / 256 * 4;
    for (int r = gw; r < ROW_M0; r += NGW) {
        float s = F.lane < NSL ? SSp[(size_t)r * 64 + F.lane] : 0.f; s = wave_sum(s);
        const float rs = 1.0f / sqrtf(s * (1.f / D_MODEL) + EPS);
        const float* h = src_row(F, r); float* o = r < ROW_S0 ? F.out + O_YP + (size_t)r * D_MODEL : F.out + O_YS + (size_t)(r - ROW_S0) * D_MODEL;
#pragma unroll
        for (int j = 0; j < NJ; ++j) { const int c = (F.lane + 64 * j) * 8;
            const u32x4 yv = *(const u32x4*)(Y + (size_t)r * D_MODEL + c);
            const f32x4 h0 = *(const f32x4*)(h + c), h1 = *(const f32x4*)(h + c + 4), w0 = *(const f32x4*)(F.P->in[IN_POSTN] + c), w1 = *(const f32x4*)(F.P->in[IN_POSTN] + c + 4);
            f32x4 o0, o1; o0[0] = h0[0] + lo_bf(yv.x) * rs * w0[0]; o0[1] = h0[1] + hi_bf(yv.x) * rs * w0[1]; o0[2] = h0[2] + lo_bf(yv.y) * rs * w0[2]; o0[3] = h0[3] + hi_bf(yv.y) * rs * w0[3];
            o1[0] = h1[0] + lo_bf(yv.z) * rs * w1[0]; o1[1] = h1[1] + hi_bf(yv.z) * rs * w1[1]; o1[2] = h1[2] + lo_bf(yv.w) * rs * w1[2]; o1[3] = h1[3] + hi_bf(yv.w) * rs * w1[3];
            *(f32x4*)(o + c) = o0; *(f32x4*)(o + c + 4) = o1; }
    }
}

DI void load8_hist(const Frame& F, int r, int i, int cb, float (&x)[8]) {
    const bf16_t* QKVB = (const bf16_t*)(F.ws + WS_QKVB);
    int row = -1; const float* cs = nullptr;
    if (r < ROW_S0) { const int p = r - i; row = p >= 0 ? p : ROW_M0 + N_META + p; }
    else if (r < ROW_M0) { const int s = (r - ROW_S0) & 31, b = (r - ROW_S0) >> 5; if (s - i >= 0) row = r - i; else cs = F.P->in[IN_CONVS] + ((size_t)b * 3 + (3 + s - i)) * C3 + cb; }
    else { const int m = r - ROW_M0; if (m - i >= 0) row = r - i; }
    if (row >= 0) { const u32x4 w = *(const u32x4*)(QKVB + (size_t)row * C3 + cb); x[0] = lo_bf(w.x); x[1] = hi_bf(w.x); x[2] = lo_bf(w.y); x[3] = hi_bf(w.y); x[4] = lo_bf(w.z); x[5] = hi_bf(w.z); x[6] = lo_bf(w.w); x[7] = hi_bf(w.w); }
    else if (cs) { const f32x4 a = *(const f32x4*)cs, b = *(const f32x4*)(cs + 4); x[0] = a[0]; x[1] = a[1]; x[2] = a[2]; x[3] = a[3]; x[4] = b[0]; x[5] = b[1]; x[6] = b[2]; x[7] = b[3]; }
    else {
#pragma unroll
        for (int j = 0; j < 8; ++j) x[j] = 0.f; }
}
DI void p2_conv(Frame& F) {
    const int gw = F.vcu * 8 + F.wave, NGW = F.G * 8, sub = F.lane >> 4, l16 = F.lane & 15;
    bf16_t* QKVN = (bf16_t*)(F.ws + WS_QKVN); const float* AB = (const float*)(F.ws + WS_AB); float* BG = (float*)(F.ws + WS_BG);
    const float* cw = F.P->in[IN_CONVW];
    constexpr int NRB = (NROWS + 63) / 64, NIT = NRB * NH_B * 3;
    for (int it = gw; it < NIT; it += NGW) {
        const int t = it % 3, hb = (it / 3) % NH_B, rb = it / (3 * NH_B), r0 = rb * 64 + sub * 16;
        const float adt = F.P->in[IN_DTB][hb], nea = -expf(F.P->in[IN_ALOG][hb]);
        {
            const int cb = t * W_B + hb * 128 + l16 * 8;
            float w[4][8];
#pragma unroll
            for (int i = 0; i < 4; ++i) { const f32x4 w0 = *(const f32x4*)(cw + (size_t)i * C3 + cb), w1 = *(const f32x4*)(cw + (size_t)i * C3 + cb + 4);
#pragma unroll
                for (int j = 0; j < 4; ++j) { w[i][j] = w0[j]; w[i][4 + j] = w1[j]; } }
            float x0[8], x1[8], x2[8], x3[8];
            if (r0 < NROWS) { load8_hist(F, r0, 3, cb, x0); load8_hist(F, r0, 2, cb, x1); load8_hist(F, r0, 1, cb, x2); }
            else {
#pragma unroll
                for (int j = 0; j < 8; ++j) { x0[j] = 0.f; x1[j] = 0.f; x2[j] = 0.f; } }
            const float post = t == 0 ? 0.08838834764831845f : 1.0f;
            u32x4 raw[16];
            { const bf16_t* QKVB = (const bf16_t*)(F.ws + WS_QKVB);
#pragma unroll
              for (int k = 0; k < 16; ++k) { raw[k] = (u32x4){0u, 0u, 0u, 0u}; if (r0 + k < NROWS) raw[k] = *(const u32x4*)(QKVB + (size_t)(r0 + k) * C3 + cb); } }
#pragma unroll
            for (int k = 0; k < 16; ++k) {
                const int r = r0 + k; const bool valid = r < NROWS;
                { const u32x4 wq = raw[k]; x3[0] = lo_bf(wq.x); x3[1] = hi_bf(wq.x); x3[2] = lo_bf(wq.y); x3[3] = hi_bf(wq.y); x3[4] = lo_bf(wq.z); x3[5] = hi_bf(wq.z); x3[6] = lo_bf(wq.w); x3[7] = hi_bf(wq.w); }
                float y[8]; float ss = 0.f;
#pragma unroll
                for (int j = 0; j < 8; ++j) { y[j] = silu_f(x0[j] * w[0][j] + x1[j] * w[1][j] + x2[j] * w[2][j] + x3[j] * w[3][j]); ss += y[j] * y[j]; x0[j] = x1[j]; x1[j] = x2[j]; x2[j] = x3[j]; }
                float sc = 1.0f;
                if (t < 2) { ss += __shfl_xor(ss, 1); ss += __shfl_xor(ss, 2); ss += __shfl_xor(ss, 4); ss += __shfl_xor(ss, 8); sc = post / sqrtf(ss + EPS); }
                if (valid) { u32x4 o; o.x = cvtpk(y[0] * sc, y[1] * sc); o.y = cvtpk(y[2] * sc, y[3] * sc); o.z = cvtpk(y[4] * sc, y[5] * sc); o.w = cvtpk(y[6] * sc, y[7] * sc);
                    *(u32x4*)(QKVN + (size_t)r * C3 + cb) = o; }
            }
        }
        { const int r = rb * 64 + F.lane;
          if (t == 0 && r < NROWS) { const float braw = AB[(size_t)r * 32 + hb], araw = AB[(size_t)r * 32 + NH_B + hb];
              const float beta = 1.0f / (1.0f + expf(-braw)); const float xx = araw + adt; const float sp = xx > 20.f ? xx : log1pf(expf(xx));
              BG[((size_t)r * NH_B + hb) * 2] = beta; BG[((size_t)r * NH_B + hb) * 2 + 1] = nea * sp; } }
    }
}

constexpr int PK_W = 0, PK_Q = 16384, PK_A = 32768, PK_K = 40960, PK_U = 57344;
DI int crow(int r, int h) { return (r & 3) + 8 * (r >> 2) + 4 * h; }
DI int sc_base_row(int sc) { return sc == 0 ? ROW_M0 : (sc < NCH_P ? (sc - 1) * 64 : ROW_S0 + (sc - NCH_P) * 32); }
DI int sc_len(int sc) { return sc == 0 ? N_META : (sc < NCH_P ? 64 : DEC_SEQ); }
DI float rdlane_f(float v, int lane) { return __builtin_bit_cast(float, __builtin_amdgcn_readlane(__builtin_bit_cast(int, v), lane)); }
DI bf16x8 pack8f(const float* x) { u32x4 w; w.x = cvtpk(x[0], x[1]); w.y = cvtpk(x[2], x[3]); w.z = cvtpk(x[4], x[5]); w.w = cvtpk(x[6], x[7]); return __builtin_bit_cast(bf16x8, w); }
DI bf16x8 pack8v(const f32x16& v, int b, float sc) { u32x4 w; w.x = cvtpk(v[b] * sc, v[b + 1] * sc); w.y = cvtpk(v[b + 2] * sc, v[b + 3] * sc); w.z = cvtpk(v[b + 4] * sc, v[b + 5] * sc); w.w = cvtpk(v[b + 6] * sc, v[b + 7] * sc); return __builtin_bit_cast(bf16x8, w); }
template <int C> struct InvStep {
    static DI void run(float (&T)[64], const LAS float* Al, int lane) {
        float a0 = 0.f, a1 = 0.f;
#pragma unroll
        for (int j4 = ((C + 1) & ~3); j4 < 64; j4 += 4) { const f32x4 a = *(const LAS f32x4*)(Al + C * 64 + j4);
#pragma unroll
            for (int e = 0; e < 4; ++e) { const int j = j4 + e; if (j > C) { if (j & 1) a1 = __builtin_fmaf(-T[j], a[e], a1); else a0 = __builtin_fmaf(-T[j], a[e], a0); } }
            }
        T[C] = (lane == C) ? 1.0f : (a0 + a1);
        PINV(T[C]);
        if constexpr (C > 0) InvStep<C - 1>::run(T, Al, lane);
    }
};
DI void p3_prep(Frame& F) {
    const int gw = F.vcu * 8 + F.wave, NGW = F.G * 8, lane = F.lane, r32 = lane & 31, h = lane >> 5;
    const bf16_t* QKVN = (const bf16_t*)(F.ws + WS_QKVN); const float* BG = (const float*)(F.ws + WS_BG);
    constexpr int TST = 272;
    static_assert(8 * (64 * TST + 1024) <= RING_BYTES, "prep tiles");
    LAS unsigned char* tile = F.lds + F.wave * (64 * TST + 1024);
    LAS float* gs = (LAS float*)(F.lds + F.wave * (64 * TST + 1024) + 64 * TST);
    for (int rnd = 0; rnd * NGW < NSC * NH_B; ++rnd) {
        const int item = rnd * NGW + (((rnd + 1) * NGW <= NSC * NH_B) ? gw : F.vcu + F.G * F.wave);
        if (item >= NSC * NH_B) break;
        const int sc = item / NH_B, hb = item % NH_B, row0 = sc_base_row(sc), L = sc_len(sc);
        unsigned char* pkg = F.ws + WS_PKG + (size_t)item * PKG_BYTES;
        float g = 0.f, beta = 0.f; if (lane < L) { beta = BG[((size_t)(row0 + lane) * NH_B + hb) * 2]; g = BG[((size_t)(row0 + lane) * NH_B + hb) * 2 + 1]; }
        float G = g;
#pragma unroll
        for (int off = 1; off < 64; off <<= 1) { const float t = __shfl(G, (lane - off) & 63); if (lane >= off) G += t; }
        const float Glast = __shfl(G, 63);
        gs[lane] = G; gs[64 + lane] = fast_exp2((Glast - G) * LOG2E); gs[128 + lane] = beta * fast_exp2(G * LOG2E); gs[192 + lane] = beta;
        if (lane == 0) ((float*)(F.ws + WS_DEC))[item] = fast_exp2(Glast * LOG2E);
        WAIT_L(0); CFENCE();
        bf16x8 kf[2][8], qf[2][8];
#pragma unroll
        for (int tt = 0; tt < 2; ++tt) { const int tok = 32 * tt + r32; const bool ok = tok < L; const bf16_t* rp = QKVN + (size_t)(row0 + tok) * C3 + hb * 128;
#pragma unroll
            for (int ks = 0; ks < 8; ++ks) { const int ch = 16 * ks + 4 * h; u32x2 a = {0u, 0u}, b = {0u, 0u}, c = {0u, 0u}, d = {0u, 0u};
                if (ok) { a = *(const u32x2*)(rp + W_B + ch); b = *(const u32x2*)(rp + W_B + ch + 8); c = *(const u32x2*)(rp + ch); d = *(const u32x2*)(rp + ch + 8); }
                kf[tt][ks] = __builtin_bit_cast(bf16x8, (u32x4){a.x, a.y, b.x, b.y}); qf[tt][ks] = __builtin_bit_cast(bf16x8, (u32x4){c.x, c.y, d.x, d.y}); } }
        const float Gi0 = __shfl(G, r32), Gi1 = __shfl(G, 32 + r32);
#pragma unroll
        for (int tl = 0; tl < 3; ++tl) {
            const int jt = tl >> 1, it = (tl + 1) >> 1; f32x16 Sx = {};
#pragma unroll
            for (int ks = 0; ks < 8; ++ks) Sx = __builtin_amdgcn_mfma_f32_32x32x16_bf16(kf[jt][ks], qf[it][ks], Sx, 0, 0, 0);
            const float Gi = it ? Gi1 : Gi0;
#pragma unroll
            for (int q4 = 0; q4 < 4; ++q4) { const f32x4 gj = *(const LAS f32x4*)(gs + 32 * jt + 8 * q4 + 4 * h);
#pragma unroll
                for (int e = 0; e < 4; ++e) { const int r = 4 * q4 + e, j0 = 8 * q4 + 4 * h + e; const float v = Sx[r] * fast_exp2((Gi - gj[e]) * LOG2E); Sx[r] = (jt != it || j0 <= r32) ? v : 0.f; } }
#pragma unroll
            for (int s2 = 0; s2 < 2; ++s2) *(bf16x8*)(pkg + PK_A + (it * 4 + jt * 2 + s2) * 1024 + lane * 16) = pack8v(Sx, 8 * s2, 1.f);
            SBAR();
        }
        { bf16x8 z = {}; *(bf16x8*)(pkg + PK_A + (0 * 4 + 1 * 2 + 0) * 1024 + lane * 16) = z; *(bf16x8*)(pkg + PK_A + (0 * 4 + 1 * 2 + 1) * 1024 + lane * 16) = z; }
        {
            const float e0 = fast_exp2(Gi0 * LOG2E), e1 = fast_exp2(Gi1 * LOG2E);
#pragma unroll
            for (int tt = 0; tt < 2; ++tt)
#pragma unroll
                for (int ks = 0; ks < 8; ++ks) { const u32x4 w = __builtin_bit_cast(u32x4, qf[tt][ks]); const float e = tt ? e1 : e0;
                    u32x4 o; o.x = cvtpk(lo_bf(w.x) * e, hi_bf(w.x) * e); o.y = cvtpk(lo_bf(w.y) * e, hi_bf(w.y) * e); o.z = cvtpk(lo_bf(w.z) * e, hi_bf(w.z) * e); o.w = cvtpk(lo_bf(w.w) * e, hi_bf(w.w) * e);
                    *(u32x4*)(pkg + PK_Q + (tt * 8 + ks) * 1024 + lane * 16) = o; }
        }
        {
            const float b0 = __shfl(beta, r32), b1 = __shfl(beta, 32 + r32);
            LAS float* Al = (LAS float*)tile;
#pragma unroll
            for (int tl = 0; tl < 3; ++tl) {
                const int ct = tl >> 1, jt = (tl + 1) >> 1; f32x16 Kx = {};
#pragma unroll
                for (int ks = 0; ks < 8; ++ks) Kx = __builtin_amdgcn_mfma_f32_32x32x16_bf16(kf[ct][ks], kf[jt][ks], Kx, 0, 0, 0);
                const float Gj = jt ? Gi1 : Gi0, bj = jt ? b1 : b0;
#pragma unroll
                for (int q4 = 0; q4 < 4; ++q4) { const f32x4 gc = *(const LAS f32x4*)(gs + 32 * ct + 8 * q4 + 4 * h);
#pragma unroll
                    for (int e = 0; e < 4; ++e) { const int r = 4 * q4 + e; Al[(32 * ct + crow(r, h)) * 64 + 32 * jt + r32] = Kx[r] * bj * fast_exp2(fminf(Gj - gc[e], 0.f) * LOG2E); } }
                SBAR();
            }
        }
        WAIT_L(0); CFENCE();
        float T[64];
#pragma unroll
        for (int j = 0; j < 64; ++j) T[j] = (lane == j) ? 1.f : 0.f;
        InvStep<62>::run(T, (const LAS float*)tile, lane);
        WAIT_L(0); CFENCE();
#pragma unroll
        for (int tt = 0; tt < 2; ++tt) { const int tok = 32 * tt + r32; const bool ok = tok < L; const bf16_t* rp = QKVN + (size_t)(row0 + tok) * C3 + hb * 128;
#pragma unroll
            for (int ks = 0; ks < 8; ++ks) { const int ch = 16 * ks + 4 * h; u32x2 a = {0u, 0u}, b = {0u, 0u};
                if (ok) { a = *(const u32x2*)(rp + W_B + ch); b = *(const u32x2*)(rp + W_B + ch + 8); }
                kf[tt][ks] = __builtin_bit_cast(bf16x8, (u32x4){a.x, a.y, b.x, b.y}); } }
#pragma unroll
        for (int tt = 0; tt < 2; ++tt)
#pragma unroll
            for (int ks = 0; ks < 8; ++ks) { const u32x4 w = __builtin_bit_cast(u32x4, kf[tt][ks]); LAS unsigned char* p = tile + (32 * tt + r32) * TST + (16 * ks + 4 * h) * 2;
                *(LAS u32x2*)p = (u32x2){w.x, w.y}; *(LAS u32x2*)(p + 16) = (u32x2){w.z, w.w}; }
        bf16x8 TW[2][4], TU[2][4];
#pragma unroll
        for (int ks = 0; ks < 4; ++ks) {
            float xa[8], xb[8], ya[8], yb[8];
#pragma unroll
            for (int q = 0; q < 2; ++q) { const f32x4 w0 = *(const LAS f32x4*)(gs + 128 + 16 * ks + 4 * q), w1 = *(const LAS f32x4*)(gs + 128 + 16 * ks + 8 + 4 * q), u0 = *(const LAS f32x4*)(gs + 192 + 16 * ks + 4 * q), u1 = *(const LAS f32x4*)(gs + 192 + 16 * ks + 8 + 4 * q);
#pragma unroll
                for (int e = 0; e < 4; ++e) { const int jj = 4 * q + e; xa[jj] = T[16 * ks + jj] * w0[e]; xb[jj] = T[16 * ks + 8 + jj] * w1[e]; ya[jj] = T[16 * ks + jj] * u0[e]; yb[jj] = T[16 * ks + 8 + jj] * u1[e]; } }
            const u32x4 a = __builtin_bit_cast(u32x4, pack8f(xa)), b = __builtin_bit_cast(u32x4, pack8f(xb)), c = __builtin_bit_cast(u32x4, pack8f(ya)), d = __builtin_bit_cast(u32x4, pack8f(yb));
            u32x4 t0, t1, u0v, u1v;
#pragma unroll
            for (int e = 0; e < 4; ++e) { auto rr = __builtin_amdgcn_permlane32_swap(a[e], b[e], false, false); t0[e] = rr[0]; t1[e] = rr[1];
                auto r2 = __builtin_amdgcn_permlane32_swap(c[e], d[e], false, false); u0v[e] = r2[0]; u1v[e] = r2[1]; }
            TW[0][ks] = __builtin_bit_cast(bf16x8, t0); TW[1][ks] = __builtin_bit_cast(bf16x8, t1); TU[0][ks] = __builtin_bit_cast(bf16x8, u0v); TU[1][ks] = __builtin_bit_cast(bf16x8, u1v);
        }
        WAIT_L(0); CFENCE();
        const int tr_off = ((lane >> 2) & 3) * TST + (16 * ((lane >> 4) & 1) + 4 * (lane & 3)) * 2;
#define TRF(tok0, ch0) ({ const s16x4 lo_ = tr16(tile + tr_off + (tok0) * TST + (ch0) * 2), hi_ = tr16(tile + tr_off + ((tok0) + 4) * TST + (ch0) * 2); (bf16x8){lo_[0], lo_[1], lo_[2], lo_[3], hi_[0], hi_[1], hi_[2], hi_[3]}; })
#pragma unroll
        for (int it = 0; it < 2; ++it) {
            f32x16 acc[4] = {};
#pragma unroll
            for (int ks = 0; ks < 4; ++ks)
#pragma unroll
                for (int ct = 0; ct < 4; ++ct) { const bf16x8 a = TRF(16 * ks + 8 * h, 32 * ct); acc[ct] = __builtin_amdgcn_mfma_f32_32x32x16_bf16(a, TW[it][ks], acc[ct], 0, 0, 0); }
#pragma unroll
            for (int ct = 0; ct < 4; ++ct)
#pragma unroll
                for (int s = 0; s < 2; ++s) *(bf16x8*)(pkg + PK_W + (it * 8 + ct * 2 + s) * 1024 + lane * 16) = pack8v(acc[ct], 8 * s, -1.f);
        }
#pragma unroll
        for (int ct = 0; ct < 4; ++ct)
#pragma unroll
            for (int ts = 0; ts < 4; ++ts) { const int tb = 16 * ts + 4 * h;
                const s16x4 lo_ = tr16(tile + tr_off + tb * TST + (32 * ct) * 2), hi_ = tr16(tile + tr_off + (tb + 8) * TST + (32 * ct) * 2);
                const f32x4 e0 = *(const LAS f32x4*)(gs + 64 + tb), e1 = *(const LAS f32x4*)(gs + 64 + tb + 8);
                float x[8];
#pragma unroll
                for (int e = 0; e < 4; ++e) { x[e] = bf2f((unsigned short)lo_[e]) * e0[e]; x[4 + e] = bf2f((unsigned short)hi_[e]) * e1[e]; }
                *(bf16x8*)(pkg + PK_K + (ct * 4 + ts) * 1024 + lane * 16) = pack8f(x); }
        WAIT_L(0); CFENCE();
#pragma unroll
        for (int i4 = 0; i4 < 16; ++i4) { const int tok = 4 * i4 + (lane >> 4); u32x4 w = {0u, 0u, 0u, 0u};
            if (tok < L) w = *(const u32x4*)(QKVN + (size_t)(row0 + tok) * C3 + 2 * W_B + hb * 128 + (lane & 15) * 8);
            *(LAS u32x4*)(tile + tok * TST + (lane & 15) * 16) = w; }
        WAIT_L(0); CFENCE();
#pragma unroll
        for (int it = 0; it < 2; ++it) {
            f32x16 acc[4] = {};
#pragma unroll
            for (int ks = 0; ks < 4; ++ks)
#pragma unroll
                for (int ct = 0; ct < 4; ++ct) { const bf16x8 b = TRF(16 * ks + 8 * h, 32 * ct); acc[ct] = __builtin_amdgcn_mfma_f32_32x32x16_bf16(TU[it][ks], b, acc[ct], 0, 0, 0); }
#pragma unroll
            for (int ct = 0; ct < 4; ++ct) { unsigned char* up = pkg + PK_U + (ct * 2 + it) * 2048 + lane * 32; *(bf16x8*)up = pack8v(acc[ct], 0, 1.f); *(bf16x8*)(up + 16) = pack8v(acc[ct], 8, 1.f); }
        }
#undef TRF
        WAIT_L(0); CFENCE();
    }
}
constexpr int SC_FRAG = 57344, SC_OEX = 2 * SC_FRAG, SC_OEXB = 16384;
constexpr int SG = 4;
constexpr int N_SCAN_P = NH_B, N_SCAN_S = (DEC_BATCH * NH_B + SG - 1) / SG;
DI void scan_unit(Frame& F, int kind, int idx) {
    const int lane = F.lane, w = F.wave, r32 = lane & 31, h = lane >> 5;
    const int n = kind == 0 ? NCH_P : ((DEC_BATCH * NH_B - idx * SG) < SG ? (DEC_BATCH * NH_B - idx * SG) : SG);
    const float* DEC = (const float*)(F.ws + WS_DEC);
    bf16_t* YCAT = (bf16_t*)(F.ws + WS_YCAT); const bf16_t* GB = (const bf16_t*)(F.ws + WS_GB);
#define SC_ITEM(k) (kind == 0 ? (k) * NH_B + idx : (NCH_P + (idx * SG + (k)) / NH_B) * NH_B + (idx * SG + (k)) % NH_B)
    f32x16 S[4] = {};
    if (w >= 4) {
        const unsigned char* src = F.ws + WS_PKG + (size_t)SC_ITEM(0) * PKG_BYTES;
        for (int b = w - 4; b < 56; b += 4) __builtin_amdgcn_global_load_lds((const unsigned*)(src + b * 1024 + lane * 16), (LAS unsigned*)(F.lds + b * 1024), 16, 0, 0);
    }
    WAIT_V(0); __syncthreads();
    for (int k = 0; k < n; ++k) {
        const int item = SC_ITEM(k), sc = item / NH_B, hb = item % NH_B;
        LAS unsigned char* buf = F.lds + (k & 1) * SC_FRAG;
        if (w >= 4) {
            if (k + 1 < n) { const unsigned char* src = F.ws + WS_PKG + (size_t)SC_ITEM(k + 1) * PKG_BYTES; LAS unsigned char* dst = F.lds + ((k + 1) & 1) * SC_FRAG;
                for (int b = w - 4; b < 56; b += 4) __builtin_amdgcn_global_load_lds((const unsigned*)(src + b * 1024 + lane * 16), (LAS unsigned*)(dst + b * 1024), 16, 0, 0); }
        }
        if (w >= 4 && k > 0) {
            const int pit = SC_ITEM(k - 1), psc = pit / NH_B, phb = pit % NH_B, prow0 = sc_base_row(psc), pL = sc_len(psc);
            const LAS unsigned char* ox = F.lds + SC_OEX + ((k - 1) & 1) * SC_OEXB;
            if (psc != 0) {
#pragma unroll
                for (int ps = 0; ps < 4; ++ps) { const int t = (w - 4) * 16 + ps * 4 + (lane >> 4), ch = (lane & 15) * 8;
                    const u32x4 xv = *(const LAS u32x4*)(ox + t * 256 + ch * 2);
                    float x[8] = {lo_bf(xv.x), hi_bf(xv.x), lo_bf(xv.y), hi_bf(xv.y), lo_bf(xv.z), hi_bf(xv.z), lo_bf(xv.w), hi_bf(xv.w)};
                    float ss = 0.f;
#pragma unroll
                    for (int j = 0; j < 8; ++j) ss += x[j] * x[j];
                    { int lq = F.lane; OPAQUE(lq); ss += shfl_xor_l(ss, 1, lq); ss += shfl_xor_l(ss, 2, lq); ss += shfl_xor_l(ss, 4, lq); ss += shfl_xor_l(ss, 8, lq); }
                    const float rs = 1.0f / sqrtf(ss * (1.f / 128.f) + EPS);
                    if (t < pL) { const int row = prow0 + t; const u32x4 gv = *(const u32x4*)(GB + (size_t)row * W_B + phb * 128 + ch);
                        const f32x4 n0 = *(const f32x4*)(F.P->in[IN_NORMB] + ch), n1 = *(const f32x4*)(F.P->in[IN_NORMB] + ch + 4);
                        u32x4 o; o.x = cvtpk(x[0] * rs * n0[0] * lo_bf(gv.x), x[1] * rs * n0[1] * hi_bf(gv.x)); o.y = cvtpk(x[2] * rs * n0[2] * lo_bf(gv.y), x[3] * rs * n0[3] * hi_bf(gv.y));
                        o.z = cvtpk(x[4] * rs * n1[0] * lo_bf(gv.z), x[5] * rs * n1[1] * hi_bf(gv.z)); o.w = cvtpk(x[6] * rs * n1[2] * lo_bf(gv.w), x[7] * rs * n1[3] * hi_bf(gv.w));
                        *(u32x4*)(YCAT + (size_t)row * D_MODEL + W_A + phb * 128 + ch) = o; } }
            }
        }
        if (w < 4) {
            const unsigned char* pkg = F.ws + WS_PKG + (size_t)item * PKG_BYTES;
            if (kind == 1) {
                const float* sp = F.P->in[IN_SSM] + (size_t)((sc - NCH_P) * NH_B + hb) * 16384 + (size_t)(4 * h) * 128 + 32 * w + r32;
#pragma unroll
                for (int T = 0; T < 4; ++T) {
#pragma unroll
                    for (int r = 0; r < 16; ++r) S[T][r] = sp[(32 * T + (r & 3) + 8 * (r >> 2)) * 128];
                    SBAR(); }
            }
            const float d = DEC[item];
            f32x16 vn[2], o[2] = {};
#pragma unroll
            for (int rt = 0; rt < 2; ++rt) { const u32x4 a = *(const u32x4*)(pkg + PK_U + (w * 2 + rt) * 2048 + lane * 32), b = *(const u32x4*)(pkg + PK_U + (w * 2 + rt) * 2048 + lane * 32 + 16);
                vn[rt][0] = lo_bf(a.x); vn[rt][1] = hi_bf(a.x); vn[rt][2] = lo_bf(a.y); vn[rt][3] = hi_bf(a.y); vn[rt][4] = lo_bf(a.z); vn[rt][5] = hi_bf(a.z); vn[rt][6] = lo_bf(a.w); vn[rt][7] = hi_bf(a.w);
                vn[rt][8] = lo_bf(b.x); vn[rt][9] = hi_bf(b.x); vn[rt][10] = lo_bf(b.y); vn[rt][11] = hi_bf(b.y); vn[rt][12] = lo_bf(b.z); vn[rt][13] = hi_bf(b.z); vn[rt][14] = lo_bf(b.w); vn[rt][15] = hi_bf(b.w); }
            SBAR();
#define FRAG(off, blk) (*(const LAS bf16x8*)(buf + (off) + (blk) * 1024 + lane * 16))
#pragma unroll
            for (int T = 0; T < 4; ++T)
#pragma unroll
                for (int s = 0; s < 2; ++s) { const bf16x8 sb = pack8v(S[T], 8 * s, 1.f);
#pragma unroll
                    for (int rt = 0; rt < 2; ++rt) { vn[rt] = __builtin_amdgcn_mfma_f32_32x32x16_bf16(FRAG(PK_W, rt * 8 + T * 2 + s), sb, vn[rt], 0, 0, 0);
                        o[rt] = __builtin_amdgcn_mfma_f32_32x32x16_bf16(FRAG(PK_Q, rt * 8 + T * 2 + s), sb, o[rt], 0, 0, 0); }
                    SBAR(); }
#pragma unroll
            for (int T = 0; T < 4; ++T) S[T] *= d;
#pragma unroll
            for (int Tt = 0; Tt < 2; ++Tt)
#pragma unroll
                for (int s = 0; s < 2; ++s) { const bf16x8 vb = pack8v(vn[Tt], 8 * s, 1.f);
#pragma unroll
                    for (int rt = 0; rt < 2; ++rt) o[rt] = __builtin_amdgcn_mfma_f32_32x32x16_bf16(FRAG(PK_A, rt * 4 + Tt * 2 + s), vb, o[rt], 0, 0, 0);
                    SBAR();
#pragma unroll
                    for (int T = 0; T < 4; ++T) S[T] = __builtin_amdgcn_mfma_f32_32x32x16_bf16(FRAG(PK_K, T * 4 + Tt * 2 + s), vb, S[T], 0, 0, 0);
                    SBAR(); }
#undef FRAG
            LAS unsigned short* ox = (LAS unsigned short*)(F.lds + SC_OEX + (k & 1) * SC_OEXB);
#pragma unroll
            for (int rt = 0; rt < 2; ++rt)
#pragma unroll
                for (int r = 0; r < 16; ++r) ox[(32 * rt + crow(r, h)) * 128 + 32 * w + r32] = (unsigned short)f2bf(o[rt][r]);
            if (kind == 1 || k == n - 1) {
                float* dp = (kind == 1 ? F.out + O_SS + (size_t)((sc - NCH_P) * NH_B + hb) * 16384 : F.out + O_SP + (size_t)hb * 16384) + (size_t)(4 * h) * 128 + 32 * w + r32;
#pragma unroll
                for (int T = 0; T < 4; ++T) {
#pragma unroll
                    for (int r = 0; r < 16; ++r) dp[(32 * T + (r & 3) + 8 * (r >> 2)) * 128] = S[T][r];
                    SBAR(); }
            }
        }
        WAIT_VL0(); __syncthreads();
    }
    if (w >= 4) {
        const int pit = SC_ITEM(n - 1), psc = pit / NH_B, phb = pit % NH_B, prow0 = sc_base_row(psc), pL = sc_len(psc);
        const LAS unsigned char* ox = F.lds + SC_OEX + ((n - 1) & 1) * SC_OEXB;
        if (psc != 0) {
#pragma unroll
            for (int ps = 0; ps < 4; ++ps) { const int t = (w - 4) * 16 + ps * 4 + (lane >> 4), ch = (lane & 15) * 8;
                const u32x4 xv = *(const LAS u32x4*)(ox + t * 256 + ch * 2);
                float x[8] = {lo_bf(xv.x), hi_bf(xv.x), lo_bf(xv.y), hi_bf(xv.y), lo_bf(xv.z), hi_bf(xv.z), lo_bf(xv.w), hi_bf(xv.w)};
                float ss = 0.f;
#pragma unroll
                for (int j = 0; j < 8; ++j) ss += x[j] * x[j];
                { int lq = F.lane; OPAQUE(lq); ss += shfl_xor_l(ss, 1, lq); ss += shfl_xor_l(ss, 2, lq); ss += shfl_xor_l(ss, 4, lq); ss += shfl_xor_l(ss, 8, lq); }
                const float rs = 1.0f / sqrtf(ss * (1.f / 128.f) + EPS);
                if (t < pL) { const int row = prow0 + t; const u32x4 gv = *(const u32x4*)(GB + (size_t)row * W_B + phb * 128 + ch);
                    const f32x4 n0 = *(const f32x4*)(F.P->in[IN_NORMB] + ch), n1 = *(const f32x4*)(F.P->in[IN_NORMB] + ch + 4);
                    u32x4 o; o.x = cvtpk(x[0] * rs * n0[0] * lo_bf(gv.x), x[1] * rs * n0[1] * hi_bf(gv.x)); o.y = cvtpk(x[2] * rs * n0[2] * lo_bf(gv.y), x[3] * rs * n0[3] * hi_bf(gv.y));
                    o.z = cvtpk(x[4] * rs * n1[0] * lo_bf(gv.z), x[5] * rs * n1[1] * hi_bf(gv.z)); o.w = cvtpk(x[6] * rs * n1[2] * lo_bf(gv.w), x[7] * rs * n1[3] * hi_bf(gv.w));
                    *(u32x4*)(YCAT + (size_t)row * D_MODEL + W_A + phb * 128 + ch) = o; } }
        }
    }
    __syncthreads();
#undef SC_ITEM
}
constexpr int AT_KB = 32768, AT_K = 0, AT_V = 2 * AT_KB, AT_TB = 4 * AT_KB, AT_WS = AT_TB + NTB * 4, AT_END = AT_WS + 8 * 256;
static_assert(AT_END <= RING_BYTES, "attention LDS");
constexpr float THR_L2 = 11.5f;
DI int v_rd_base(int lane) { return ((lane & 3) << 3) | (((lane >> 2) & 3) << 6) | (((lane >> 4) & 1) << 5) | (((lane >> 5) & 1) << 8); }
struct AttnW { bf16x8 qr[8]; f32x16 o[8]; float m, l; };
DI void attn_tile(AttnW& A, const LAS unsigned char* Kc, const LAS unsigned char* Vt, const LAS float* tbl, LAS float* wsf, int lane, int tbi, float bu, int nvalid) {
    const int r32 = lane & 31, hi = lane >> 5;
    const float ub = tbi >= 0 ? 0.f : bu;
    const LAS unsigned char* vb0 = Vt + v_rd_base(lane);
#pragma unroll
    for (int hf = 0; hf < 2; ++hf) {
        f32x16 p = {};
        {
            const LAS unsigned char* kb[4];
#pragma unroll
            for (int dd = 0; dd < 4; ++dd) kb[dd] = Kc + hf * 8192 + r32 * 256 + (((dd * 16 + hi * 8) * 2) ^ ((r32 & 7) << 4));
#pragma unroll
            for (int d0 = 0; d0 < 8; ++d0) { const bf16x8 b0 = *(const LAS bf16x8*)(kb[d0 & 3] + (d0 >> 2) * 128); p = __builtin_amdgcn_mfma_f32_32x32x16_bf16(b0, A.qr[d0], p, 0, 0, 0); }
        }
        SBAR();
        if (tbi >= 0) {
            const LAS float* tp = tbl + tbi + 4 * hi + 32 * hf;
#pragma unroll
            for (int r = 0; r < 16; ++r) p[r] += tp[(r & 3) + 8 * (r >> 2)];
        }
        if (nvalid < 64) {
            const float NEG = -__builtin_inff();
#pragma unroll
            for (int r = 0; r < 16; ++r) { if ((r & 3) + 8 * (r >> 2) + 4 * hi + 32 * hf >= nvalid) p[r] = NEG; }
        }
        float pmax = p[0];
#pragma unroll
        for (int r = 1; r < 16; ++r) pmax = fmaxf(pmax, p[r]);
        { auto rr = __builtin_amdgcn_permlane32_swap(__float_as_uint(pmax), __float_as_uint(pmax), false, false); pmax = fmaxf(__uint_as_float(rr[0]), __uint_as_float(rr[1])); }
        pmax += ub;
        float mn, alpha;
        if (__all(pmax - A.m <= THR_L2)) { mn = A.m; alpha = 1.f; }
        else { mn = fmaxf(A.m, pmax); alpha = fast_exp2(A.m - mn); A.m = mn; }
        const float sh = ub - mn;
        float ps = 0.f;
#pragma unroll
        for (int r = 0; r < 16; ++r) { p[r] = fast_exp2(p[r] + sh); ps += p[r]; }
        { auto rr = __builtin_amdgcn_permlane32_swap(__float_as_uint(ps), __float_as_uint(ps), false, false); ps = __uint_as_float(rr[0]) + __uint_as_float(rr[1]); }
        A.l = A.l * alpha + ps;
        if (__any(alpha < 1.f)) {
            if (hi == 0) wsf[r32] = alpha;
            WAIT_L(0); CFENCE();
#pragma unroll
            for (int r = 0; r < 16; ++r) { const float al = wsf[crow(r, hi)];
#pragma unroll
                for (int d = 0; d < 8; ++d) A.o[d][r] *= al; }
            WAIT_L(0); CFENCE();
        }
        bf16x8 pa[2];
#define PK4(P, B_, OUT) do { const unsigned a0 = cvtpk(P[B_ + 0], P[B_ + 1]), a1 = cvtpk(P[B_ + 2], P[B_ + 3]), b0_ = cvtpk(P[B_ + 4], P[B_ + 5]), b1_ = cvtpk(P[B_ + 6], P[B_ + 7]); \
            auto r0 = __builtin_amdgcn_permlane32_swap(a0, b0_, false, false); auto r1 = __builtin_amdgcn_permlane32_swap(a1, b1_, false, false); \
            u32x4 w_ = {r0[0], r1[0], r0[1], r1[1]}; OUT = __builtin_bit_cast(bf16x8, w_); } while (0)
        PK4(p, 0, pa[0]); PK4(p, 8, pa[1]);
#undef PK4
        SBAR();
#pragma unroll
        for (int d0 = 0; d0 < 8; ++d0) {
#pragma unroll
            for (int k2 = 0; k2 < 2; ++k2) { const int ks = 2 * hf + k2; const s16x4 lo_ = tr16(vb0 + d0 * 512 + ks * 8192), hi_ = tr16(vb0 + d0 * 512 + ks * 8192 + 4096);
                const bf16x8 vf = {lo_[0], lo_[1], lo_[2], lo_[3], hi_[0], hi_[1], hi_[2], hi_[3]};
                A.o[d0] = __builtin_amdgcn_mfma_f32_32x32x16_bf16(pa[k2], vf, A.o[d0], 0, 0, 0); }
            if (d0 & 1) SBAR();
        }
    }
}
DI void attn_dma_k(const Frame& F, int kr0, int h, int bufi, int l) {
    const unsigned char* Kg = F.ws + WS_K + ((size_t)kr0 * W_A + h * 256) * 2; const int w = F.wave;
#pragma unroll
    for (int i = 0; i < 4; ++i) { const int cc = w >> 2, m = 4 * (w & 3) + i, row = 4 * m + (l >> 4), ch = (l & 15) ^ (row & 7); const unsigned off = (unsigned)(row * W_A + cc * 128 + ch * 8) * 2u;
        glds16(Kg + off, LDS_A(F.lds) + (unsigned)__builtin_amdgcn_readfirstlane(AT_K + bufi * AT_KB + cc * 16384 + m * 1024)); }
}
DI void attn_dma_v(const Frame& F, int kr0, int h, int bufi, int l) {
    const unsigned char* Vg = F.ws + WS_V + ((size_t)kr0 * W_A + h * 256) * 2; const int w = F.wave;
#pragma unroll
    for (int i = 0; i < 4; ++i) { const int j = 4 * w + i, key = 2 * j + (l >> 5); const unsigned off = (unsigned)(key * W_A * 2) + (unsigned)((16 * (l & 31)) ^ ((key & 3) << 6));
        glds16(Vg + off, LDS_A(F.lds) + (unsigned)__builtin_amdgcn_readfirstlane(AT_V + bufi * AT_KB + j * 1024)); }
}
DI void attn_QK(const AttnW& A, f32x16& p0, f32x16& p1, const LAS unsigned char* Kc, int lane, float init) {
    const int r32 = lane & 31, hi = lane >> 5;
#pragma unroll
    for (int r = 0; r < 16; ++r) { p0[r] = init; p1[r] = init; }
    lds_a kb[4];
#pragma unroll
    for (int dd = 0; dd < 4; ++dd) kb[dd] = LDS_A(Kc) + (unsigned)(r32 * 256 + (((dd * 16 + hi * 8) * 2) ^ ((r32 & 7) << 4)));
    bf16x8 x0, x1, y0, y1;
#define KBATCH(d0, a0, a1) do { LDRD128(a0, kb[(d0) & 3], ((d0) >> 2) * 128); LDRD128(a1, kb[(d0) & 3], ((d0) >> 2) * 128 + 8192); } while (0)
#define KMMA(d0, a0, a1) do { p0 = __builtin_amdgcn_mfma_f32_32x32x16_bf16(a0, A.qr[d0], p0, 0, 0, 0); p1 = __builtin_amdgcn_mfma_f32_32x32x16_bf16(a1, A.qr[d0], p1, 0, 0, 0); } while (0)
#define LWAIT2(a, b) do { asm_lwait2(a, b); } while (0)
    KBATCH(0, x0, x1); LWAIT2(x0, x1);
    KBATCH(1, y0, y1); KMMA(0, x0, x1); LWAIT2(y0, y1);
    KBATCH(2, x0, x1); KMMA(1, y0, y1); LWAIT2(x0, x1);
    KBATCH(3, y0, y1); KMMA(2, x0, x1); LWAIT2(y0, y1);
    KBATCH(4, x0, x1); KMMA(3, y0, y1); LWAIT2(x0, x1);
    KBATCH(5, y0, y1); KMMA(4, x0, x1); LWAIT2(y0, y1);
    KBATCH(6, x0, x1); KMMA(5, y0, y1); LWAIT2(x0, x1);
    KBATCH(7, y0, y1); KMMA(6, x0, x1); LWAIT2(y0, y1);
    KMMA(7, y0, y1);
    PIN2(p0, p1);
#undef KBATCH
#undef KMMA
#undef LWAIT2
}
DI bool attn_SM(AttnW& A, f32x16& p0, f32x16& p1, bf16x8 (&pa)[4], const LAS float* tbl, LAS float* wsf, int lane, int tbi, int nvalid, bool first) {
    const int r32 = lane & 31, hi = lane >> 5;
    if (tbi >= 0) {
        const LAS float* tp = tbl + tbi + 4 * hi;
#pragma unroll
        for (int r = 0; r < 16; ++r) { const int c = (r & 3) + 8 * (r >> 2); p0[r] += tp[c]; p1[r] += tp[c + 32]; }
    }
    if (nvalid < 64) {
        const float NEG = -__builtin_inff();
#pragma unroll
        for (int r = 0; r < 16; ++r) { const int c = (r & 3) + 8 * (r >> 2) + 4 * hi; if (c >= nvalid) p0[r] = NEG; if (c + 32 >= nvalid) p1[r] = NEG; }
    }
    MFMA_PAD2(p0, p1);
    float pmax;
    { float a = max3f(p0[0], p0[1], p1[0]), b = max3f(p0[2], p0[3], p1[1]); a = max3f(a, p1[2], p1[3]);
#pragma unroll
      for (int r = 4; r < 16; r += 4) { a = max3f(a, p0[r], p0[r + 1]); b = max3f(b, p0[r + 2], p0[r + 3]); a = max3f(a, p1[r], p1[r + 1]); b = max3f(b, p1[r + 2], p1[r + 3]); }
      pmax = max2f(a, b); }
    VALU_PAD(pmax);
    { auto rr = __builtin_amdgcn_permlane32_swap(__float_as_uint(pmax), __float_as_uint(pmax), false, false); pmax = fmaxf(__uint_as_float(rr[0]), __uint_as_float(rr[1])); }
    bool resc = false;
    if (first || !__all(pmax <= THR_L2)) {
        const float delta = first ? pmax : fmaxf(pmax, 0.f);
#pragma unroll
        for (int r = 0; r < 16; ++r) { p0[r] -= delta; p1[r] -= delta; }
        const float alpha = first ? 0.f : fast_exp2(-delta);
        A.m += delta; A.l *= alpha; resc = !first; if (hi == 0) wsf[r32] = alpha;
    }
#pragma unroll
    for (int r = 0; r < 16; ++r) { p0[r] = fast_exp2(p0[r]); p1[r] = fast_exp2(p1[r]); }
    TRANS_PAD2(p0, p1);
    { float a = fadd_s(p0[0], p1[0]), b = fadd_s(p0[1], p1[1]);
#pragma unroll
      for (int r = 2; r < 16; r += 2) { a = fadd_s(a, p0[r]); b = fadd_s(b, p0[r + 1]); a = fadd_s(a, p1[r]); b = fadd_s(b, p1[r + 1]); }
      A.l += fadd_s(a, b); }
    pa[0] = pack8v(p0, 0, 1.f); pa[1] = pack8v(p0, 8, 1.f); pa[2] = pack8v(p1, 0, 1.f); pa[3] = pack8v(p1, 8, 1.f);
    PIN4(pa[0], pa[1], pa[2], pa[3]);
    return resc;
}
DI void attn_PV(AttnW& A, const bf16x8 (&pa)[4], const LAS unsigned char* Vt, const LAS float* wsf, int lane, bool resc) {
    const int hi = lane >> 5;
    if (resc) {
#pragma unroll
        for (int r = 0; r < 16; ++r) { const float al = wsf[crow(r, hi)];
#pragma unroll
            for (int d = 0; d < 8; ++d) A.o[d][r] *= al; }
    }
    lds_a vb[4];
    { const int q = (lane >> 2) & 3, pp = lane & 3, ch = (lane >> 4) & 1;
#pragma unroll
      for (int dd = 0; dd < 4; ++dd) vb[dd] = LDS_A(Vt) + (unsigned)((4 * hi + q) * 512 + ((64 * dd + 32 * ch + 8 * pp) ^ (q << 6))); }
    s16x4 xl0, xh0, xl1, xh1, yl0, yh0, yl1, yh1;
#define VBATCH(hb, l0, h0, l1, h1) do { TRRD(l0, vb[((hb) >> 1) & 3], ((hb) >> 3) * 256 + ((hb) & 1) * 16384); TRRD(h0, vb[((hb) >> 1) & 3], ((hb) >> 3) * 256 + ((hb) & 1) * 16384 + 4096); \
        TRRD(l1, vb[((hb) >> 1) & 3], ((hb) >> 3) * 256 + ((hb) & 1) * 16384 + 8192); TRRD(h1, vb[((hb) >> 1) & 3], ((hb) >> 3) * 256 + ((hb) & 1) * 16384 + 12288); } while (0)
#define VF(l, h) ((bf16x8){l[0], l[1], l[2], l[3], h[0], h[1], h[2], h[3]})
#define VMMA(hb, l0, h0, l1, h1) do { A.o[(hb) >> 1] = __builtin_amdgcn_mfma_f32_32x32x16_bf16(pa[2 * ((hb) & 1)], VF(l0, h0), A.o[(hb) >> 1], 0, 0, 0); \
        A.o[(hb) >> 1] = __builtin_amdgcn_mfma_f32_32x32x16_bf16(pa[2 * ((hb) & 1) + 1], VF(l1, h1), A.o[(hb) >> 1], 0, 0, 0); } while (0)
#define VSTEP2(hb) do { VBATCH((hb) + 1, yl0, yh0, yl1, yh1); VMMA(hb, xl0, xh0, xl1, xh1); LWAIT4(yl0, yh0, yl1, yh1); \
        VBATCH((hb) + 2, xl0, xh0, xl1, xh1); VMMA((hb) + 1, yl0, yh0, yl1, yh1); LWAIT4(xl0, xh0, xl1, xh1); } while (0)
    VBATCH(0, xl0, xh0, xl1, xh1); LWAIT4(xl0, xh0, xl1, xh1);
    VSTEP2(0); VSTEP2(2); VSTEP2(4); VSTEP2(6); VSTEP2(8); VSTEP2(10); VSTEP2(12);
    VBATCH(15, yl0, yh0, yl1, yh1); VMMA(14, xl0, xh0, xl1, xh1); LWAIT4(yl0, yh0, yl1, yh1);
    VMMA(15, yl0, yh0, yl1, yh1);
#undef VBATCH
#undef VF
#undef VMMA
#undef VSTEP2
}
DI void attn_epilogue(Frame& F, AttnW& A, int h, int row0, bool act, float lam, bool half_l) {
    int lane = F.lane; OPAQUE(lane);
    const int r32 = lane & 31, hi = lane >> 5, rg = F.wave & 3, c = F.wave >> 2;
    LAS float* wsf = (LAS float*)(F.lds + AT_WS + F.wave * 256);
    LAS float* ex = (LAS float*)(F.lds + rg * 32768);
    { float lt = A.l; if (half_l) lt += shfl_xor_l(lt, 32, lane); if (hi == 0) wsf[32 + r32] = lt; }
    WAIT_L(0); CFENCE();
    float rl[16];
#pragma unroll
    for (int r = 0; r < 16; ++r) rl[r] = fast_rcp(wsf[32 + crow(r, hi)]);
    if (c == 1 && act) {
#pragma unroll
        for (int d = 0; d < 8; ++d)
#pragma unroll
            for (int r = 0; r < 16; ++r) ex[crow(r, hi) * 256 + d * 32 + r32] = A.o[d][r] * rl[r] * lam;
    }
    WAIT_L(0); __syncthreads();
    if (c == 0 && act) {
        float sw[8];
#pragma unroll
        for (int d = 0; d < 8; ++d) sw[d] = F.P->in[IN_SUBLN][d * 32 + r32] * (1.0f - LAM_INIT);
#pragma unroll
        for (int r = 0; r < 16; ++r) { const int rr = (r & 3) + 8 * (r >> 2); float s = 0.f; float v[8];
#pragma unroll
            for (int d = 0; d < 8; ++d) { v[d] = A.o[d][r] * rl[r] - ex[(rr + 4 * hi) * 256 + d * 32 + r32]; s += v[d] * v[d]; }
            s += shfl_xor_l(s, 1, lane); s += shfl_xor_l(s, 2, lane); s += shfl_xor_l(s, 4, lane); s += shfl_xor_l(s, 8, lane); s += shfl_xor_l(s, 16, lane);
            const float rs = 1.0f / sqrtf(s * (1.f / 256.f) + EPS);
#pragma unroll
            for (int d = 0; d < 8; ++d) ex[(rr + 4 * hi) * 256 + d * 32 + r32] = v[d] * rs * sw[d];
            SBAR(); }
        WAIT_L(0); CFENCE();
        const bf16_t* GA = (const bf16_t*)(F.ws + WS_GA) + (size_t)(row0 + rg * 32 + hi) * W_A + (size_t)h * 256 + r32 * 8;
        bf16_t* YC = (bf16_t*)(F.ws + WS_YCAT) + (size_t)(row0 + rg * 32 + hi) * D_MODEL + (size_t)h * 256 + r32 * 8;
#pragma unroll 4
        for (int it = 0; it < 16; ++it) { const int row = 2 * it + hi;
            const f32x4 a = *(const LAS f32x4*)(ex + row * 256 + r32 * 8), b = *(const LAS f32x4*)(ex + row * 256 + r32 * 8 + 4);
            const u32x4 g = *(const u32x4*)(GA + (size_t)(2 * it) * W_A);
            u32x4 o; o.x = cvtpk(a[0] * lo_bf(g.x), a[1] * hi_bf(g.x)); o.y = cvtpk(a[2] * lo_bf(g.y), a[3] * hi_bf(g.y)); o.z = cvtpk(b[0] * lo_bf(g.z), b[1] * hi_bf(g.z)); o.w = cvtpk(b[2] * lo_bf(g.w), b[3] * hi_bf(g.w));
            *(u32x4*)(YC + (size_t)(2 * it) * D_MODEL) = o; }
        WAIT_L(0); CFENCE();
    }
    __syncthreads();
}
DI float diff_lambda(const Frame& F) {
    int l = F.lane; OPAQUE(l);
    float a = F.P->in[IN_LQ1][l] * F.P->in[IN_LK1][l] + F.P->in[IN_LQ1][l + 64] * F.P->in[IN_LK1][l + 64], b = F.P->in[IN_LQ2][l] * F.P->in[IN_LK2][l] + F.P->in[IN_LQ2][l + 64] * F.P->in[IN_LK2][l + 64];
#pragma unroll
    for (int o = 1; o < 64; o <<= 1) { a += shfl_xor_l(a, o, l); b += shfl_xor_l(b, o, l); }
    return __builtin_expf(a) - __builtin_expf(b) + LAM_INIT;
}
DI void attn_init(const Frame& F, AttnW& A, int h, int c, int qrow0) {
    int ln = F.lane; OPAQUE(ln);
    const bf16_t* Qg = (const bf16_t*)(F.ws + WS_Q) + (size_t)(qrow0 + (ln & 31)) * W_A + h * 256 + c * 128 + (ln >> 5) * 8;
#pragma unroll
    for (int d0 = 0; d0 < 8; ++d0) A.qr[d0] = *(const bf16x8*)(Qg + d0 * 16);
#pragma unroll
    for (int d = 0; d < 8; ++d) A.o[d] = (f32x16){};
    A.m = 0.f; A.l = 0.f;
}
DI void attn_load_table(const Frame& F, int h) { const float* T = (const float*)(F.ws + WS_TB) + (size_t)h * NTB; LAS float* t = (LAS float*)(F.lds + AT_TB); int t0 = F.tid; OPAQUE(t0); for (int i = t0; i < NTB; i += 512) t[i] = T[i]; }
DI void attn_prompt_unit(Frame& F, int h, int qb, float lam) {
    const int w = F.wave, rg = w & 3, c = w >> 2;
    const LAS float* tbl = (const LAS float*)(F.lds + AT_TB); LAS float* wsf = (LAS float*)(F.lds + AT_WS + w * 256);
    AttnW A; attn_init(F, A, h, c, qb * 128 + rg * 32);
    attn_load_table(F, h);
    const int q0w = qb * 128 + rg * 32, qc = q0w >> 6;
    const int NT = 2 * qb + 3;
    const int NTW = (qc + 2) < NT ? (qc + 2) : NT;
#define KROW(t) ((t) == 0 ? ROW_M0 : ((t) - 1) * 64)
    { int ln = F.lane; OPAQUE(ln); attn_dma_k(F, KROW(0), h, 0, ln); attn_dma_v(F, KROW(0), h, 0, ln); attn_dma_k(F, KROW(1), h, 1, ln); }
    WAIT_V(0); WAIT_L(0); __builtin_amdgcn_s_barrier();
    const float bu = tbl[0];
    bf16x8 pa[4]; f32x16 p0, p1; bool resc = false;
#define KPOS0(t) ((t) == 0 ? -N_META : ((t) - 1) * 64)
#define NEAR(t) (KPOS0(t) + 63 - q0w > -559)
#define DO_QK(t) do { int ln = F.lane; OPAQUE(ln); attn_QK(A, p0, p1, F.lds + AT_K + ((t) & 1) * AT_KB + c * 16384, ln, (NEAR(t) ? 0.f : bu) - A.m); } while (0)
#define DO_SM(t) do { int ln = F.lane; OPAQUE(ln); resc = attn_SM(A, p0, p1, pa, tbl, wsf, ln, NEAR(t) ? KPOS0(t) - (q0w + (ln & 31)) + TB_OFF : -1, (t) == 0 ? N_META : 64, (t) == 0); } while (0)
#define DO_PV(t) do { int ln = F.lane; OPAQUE(ln); attn_PV(A, pa, F.lds + AT_V + ((t) & 1) * AT_KB, wsf, ln, resc); } while (0)
#define END_SUB(issued) do { if (issued) { WAIT_V(4); } else { WAIT_V(0); } WAIT_L(0); __builtin_amdgcn_s_barrier(); } while (0)
#define DMA_K2(u) do { if ((u) < NT) { int ln = F.lane; OPAQUE(ln); attn_dma_k(F, KROW(u), h, (u) & 1, ln); } } while (0)
#define DMA_V2(u) do { if ((u) < NT) { int ln = F.lane; OPAQUE(ln); attn_dma_v(F, KROW(u), h, (u) & 1, ln); } } while (0)
    if (c == 0) {
        DO_QK(0); END_SUB(false);
        for (int t = 0; t < NT; ++t) {
            DMA_K2(t + 2); if (t < NTW) { DO_SM(t); if (t + 1 < NTW) DO_QK(t + 1); } END_SUB(t + 2 < NT);
            DMA_V2(t + 1); if (t < NTW) DO_PV(t); END_SUB(t + 1 < NT);
        }
        END_SUB(false);
    } else {
        DO_QK(0); END_SUB(false);
        DMA_K2(2); END_SUB(2 < NT);
        for (int t = 0; t < NT; ++t) {
            DMA_V2(t + 1); if (t < NTW) { DO_SM(t); if (t + 1 < NTW) DO_QK(t + 1); } END_SUB(t + 1 < NT);
            DMA_K2(t + 3); if (t < NTW) DO_PV(t); END_SUB(t + 3 < NT);
        }
    }
#undef KROW
#undef KPOS0
#undef NEAR
#undef DO_QK
#undef DO_SM
#undef DO_PV
#undef END_SUB
#undef DMA_K2
#undef DMA_V2
    attn_epilogue(F, A, h, qb * 128, true, lam, true);
}
DI void attn_sample_unit(Frame& F, int b, int h, float lam) {
    const int w = F.wave, rg = w & 3, c = w >> 2;
    const LAS float* tbl = (const LAS float*)(F.lds + AT_TB); LAS float* wsf = (LAS float*)(F.lds + AT_WS + w * 256);
    const bool act = rg == 0;
    AttnW A; attn_init(F, A, h, c, ROW_S0 + b * 32); A.m = -1e30f;
    attn_load_table(F, h);
    constexpr int NKEY = LCACHE + DEC_SEQ, NT = (NKEY + 63) / 64;
    const float* CK = F.P->in[IN_CK] + (size_t)b * LCACHE * W_A + h * 256; const float* CV = F.P->in[IN_CV] + (size_t)b * LCACHE * W_A + h * 256;
    const bf16_t* Kn = (const bf16_t*)(F.ws + WS_K) + (size_t)(ROW_S0 + b * 32) * W_A + h * 256; const bf16_t* Vn = (const bf16_t*)(F.ws + WS_V) + (size_t)(ROW_S0 + b * 32) * W_A + h * 256;
    __syncthreads();
    for (int t = 0; t < NT; ++t) {
        int tid = F.tid; OPAQUE(tid); const int lane = tid & 63, r32 = lane & 31;
        const int qpos = PAST_LEN + r32;
        const int key = tid >> 3, j = t * 64 + key, g8 = tid & 7;
#pragma unroll
        for (int kv = 0; kv < 2; ++kv) {
#pragma unroll
            for (int q4 = 0; q4 < 4; ++q4) { const int col = g8 * 32 + q4 * 8; u32x4 wv = {0u, 0u, 0u, 0u};
                if (j < LCACHE) { const float* sp = (kv ? CV : CK) + (size_t)j * W_A + col; const f32x4 a = *(const f32x4*)sp, bq = *(const f32x4*)(sp + 4);
                    wv.x = cvtpk(a[0], a[1]); wv.y = cvtpk(a[2], a[3]); wv.z = cvtpk(bq[0], bq[1]); wv.w = cvtpk(bq[2], bq[3]); }
                else if (j < NKEY) wv = *(const u32x4*)((kv ? Vn : Kn) + (size_t)(j - LCACHE) * W_A + col);
                if (kv == 0) { const int cc = col >> 7, chk = (col & 127) >> 3; *(LAS u32x4*)(F.lds + AT_K + cc * 16384 + key * 256 + ((chk ^ (key & 7)) << 4)) = wv; }
                else { const int kk = (key & ~0xC) | ((key & 4) << 1) | ((key & 8) >> 1); *(LAS u32x4*)(F.lds + AT_V + ((kk >> 3) * 8 + (col >> 5)) * 512 + ((kk & 7) * 32 + (col & 31)) * 2) = wv; } }
        }
        WAIT_VL0(); __syncthreads();
        if (act) { const int kpos0 = t * 64 - N_META; const int nv = NKEY - t * 64;
            attn_tile(A, F.lds + AT_K + c * 16384, F.lds + AT_V, tbl, wsf, lane, kpos0 - qpos + TB_OFF, 0.f, nv < 64 ? nv : 64); }
        WAIT_VL0(); __syncthreads();
    }
    attn_epilogue(F, A, h, ROW_S0 + b * 32, act, lam, false);
}
template <int MIXM, int QB = 0> DI void p4_mixer(Frame& F) {
    constexpr int NAP = NH_A * (SEQ / 128), NAS = DEC_BATCH * NH_A;
    const float lam = diff_lambda(F);
    if (MIXM & 1) { for (int u = F.vcu; u < N_SCAN_P; u += F.G) scan_unit(F, 0, u); }
#define DEQ(qi, uvar) do { __syncthreads(); if (F.tid == 0) F.MISC[16] = __hip_atomic_fetch_add(F.ctl + CW_QUEUE + 64 * (qi), 1u, __ATOMIC_RELAXED, __HIP_MEMORY_SCOPE_AGENT); __syncthreads(); uvar = (int)F.MISC[16]; uvar = __builtin_amdgcn_readfirstlane(uvar); } while (0)
    if (MIXM & 2) {
        const int h0 = (int)(xb_xcc_id() % (unsigned)NH_A);
        for (int hs = 0; hs < NH_A; ++hs) { const int hh = (h0 + hs) % NH_A;
            for (;;) { int a; DEQ(QB + 8 + hh, a); if (a >= SEQ / 128) break; attn_prompt_unit(F, hh, (SEQ / 128 - 1) - a, lam); } }
    }
    if (MIXM & 4) { for (;;) { int a; DEQ(QB + 1, a); if (a >= NAS) break; attn_sample_unit(F, a / NH_A, a % NH_A, lam); } }
    if (MIXM & 1) { for (;;) { int a; DEQ(QB + 2, a); if (a >= N_SCAN_S) break; scan_unit(F, 1, a); } }
#undef DEQ
}

constexpr int N_PHASES = 7;
#ifndef MK_N_LAUNCHES
#define MK_N_LAUNCHES 1
#endif
__global__ void __launch_bounds__(512, 2) hymba_fwd(Params p) {
#ifdef EMU
    unsigned char* lds_raw = emu::cur->block->lds;
#else
    extern __shared__ __attribute__((aligned(16))) unsigned char lds_raw[];
#endif
    Frame F;
    F.lds = (LAS unsigned char*)lds_raw; F.MISC = (volatile LAS unsigned*)(F.lds + MISC_OFF);
    F.wave = __builtin_amdgcn_readfirstlane((int)threadIdx.x >> 6); F.lane = lane_id(); F.tid = F.wave * 64 + F.lane;
    F.G = gridDim.x; { const int bx = blockIdx.x; F.vcu = (F.G % 8 == 0) ? (bx % 8) * (F.G / 8) + bx / 8 : bx; }
    F.P = &p; F.out = p.out; F.ws = p.ws; F.ctl = (unsigned*)(p.ws + WS_CTL);
    for (int u = F.tid; u < (LDS_BYTES - MISC_OFF) / 4; u += 512) ((LAS unsigned*)(F.lds + MISC_OFF))[u] = 0u;
    __syncthreads();
    const bool use_bar = (p.ph_hi - p.ph_lo) > 1;
    XcdBarrier bar; bar.bar = F.ctl + CW_BAR + p.li * XCD_BAR_WORDS; bar.x = 0; bar.st = nullptr; bar.wave = F.wave;
    if (use_bar) bar = xcd_barrier_post(F.ctl + CW_BAR + p.li * XCD_BAR_WORDS, F.MISC + 8, F.wave);
    const int lo = p.ph_lo, hi = p.ph_hi;
#ifdef ONLY_PHASE
#define IN(k) ((k) == ONLY_PHASE && lo <= (k) && (k) < hi)
#else
#define IN(k) (lo <= (k) && (k) < hi)
#endif
#ifdef EMU
#define PHMARK(k) ((void)0)
#else
#define PHMARK(k) asm volatile("; PHASE_MARK " #k ::: "memory")
#endif
#define SEAM(k) do { PHMARK(k); if (IN(k) && IN((k) + 1)) xcd_barrier(bar); F.lane = lane_id(); F.tid = F.wave * 64 + F.lane; } while (0)
#ifndef REPEAT_MASK
#define REPEAT_MASK 0
#endif
#define RBIT(k) ((((REPEAT_MASK) >> (k)) & 1) != 0)
#define P1BODY() do { p1a_skinny(F); __syncthreads(); pg8::Gemm g{(const bf16_t*)(F.ws + WS_XN), (const bf16_t*)(F.ws + WS_WINT), M_MAIN, N_MAIN, D_MODEL}; pg8::AlignedOrder S; S.init(M_MAIN, N_MAIN, F.G, (int)blockIdx.x); \
        EpiIn E{F.out, F.ws}; pg8::gemm_phase<EpiIn, pg8::AlignedOrder, PG8_ALIGN, PG8_SP2>(F.lds, g, S, E, F.wave); } while (0)
#define P5BODY() do { pg8::Gemm g{(const bf16_t*)(F.ws + WS_YCAT), (const bf16_t*)(F.ws + WS_WOUTT), R, D_MODEL, D_MODEL}; pg8::StaticOrder S; S.init(R, D_MODEL, F.G, (int)blockIdx.x); \
        EpiOut E{F.ws}; pg8::gemm_phase<EpiOut, pg8::StaticOrder, PG8_ALIGN, PG8_SP2>(F.lds, g, S, E, F.wave); } while (0)
    if (IN(0)) { p0_prologue(F); if constexpr (RBIT(0)) { __syncthreads(); p0_prologue(F); } } SEAM(0);
    if (IN(1)) { P1BODY(); if constexpr (RBIT(1)) { P1BODY(); } } SEAM(1);
    if (IN(2)) { p2_conv(F); if constexpr (RBIT(2)) { p2_conv(F); } } SEAM(2);
    if (IN(3)) { p3_prep(F); if constexpr (RBIT(3)) { p3_prep(F); } } SEAM(3);
#ifndef MIX_MAIN
#define MIX_MAIN 7
#endif
#ifndef MIX_REP
#define MIX_REP 7
#endif
    if (IN(4)) { p4_mixer<MIX_MAIN>(F); if constexpr (RBIT(4)) { __syncthreads(); p4_mixer<MIX_REP, 32>(F); } } SEAM(4);
    if (IN(5)) { P5BODY(); if constexpr (RBIT(5)) { P5BODY(); } } SEAM(5);
    if (IN(6)) { p5_final(F); if constexpr (RBIT(6)) { p5_final(F); } }
#undef IN
#undef SEAM
}

extern "C" void kernel_launch(void* const* d_in, const int* in_sizes, int n_in, void* d_out, int out_size, void* d_ws, size_t ws_size, hipStream_t stream) {
    static int grid = 0;
    if (grid == 0) {
        if (n_in != 21 || (size_t)out_size != O_END || ws_size < WS_END) { fprintf(stderr, "kernel_launch: shape/workspace mismatch (n_in %d out %d ws %zu need %zu)\n", n_in, out_size, ws_size, (size_t)WS_END); grid = -1; return; }
        int dev = 0, cus = 0;
        if (hipGetDevice(&dev) != hipSuccess || hipDeviceGetAttribute(&cus, hipDeviceAttributeMultiprocessorCount, dev) != hipSuccess) { grid = -1; return; }
        if (hipFuncSetAttribute((const void*)hymba_fwd, hipFuncAttributeMaxDynamicSharedMemorySize, LDS_BYTES) != hipSuccess) { fprintf(stderr, "kernel_launch: hipFuncSetAttribute failed\n"); grid = -1; return; }
        int per_cu = 0; (void)hipOccupancyMaxActiveBlocksPerMultiprocessor(&per_cu, (const void*)hymba_fwd, 512, LDS_BYTES); (void)hipGetLastError();
        grid = cus;
    }
    if (grid < 0) return;
    (void)hipMemsetAsync((char*)d_ws + WS_CTL, 0, CTL_ZERO_BYTES, stream);
    Params p{};
    for (int i = 0; i < 21; ++i) p.in[i] = (const float*)d_in[i];
    p.out = (float*)d_out; p.ws = (unsigned char*)d_ws; p.pad = 0;
#if MK_N_LAUNCHES == 1
    p.ph_lo = 0; p.ph_hi = N_PHASES; p.li = 0;
    hipLaunchKernelGGL(hymba_fwd, dim3(grid), dim3(512), LDS_BYTES, stream, p);
#else
    for (int k = 0; k < N_PHASES; ++k) { p.ph_lo = k; p.ph_hi = k + 1; p.li = 0; hipLaunchKernelGGL(hymba_fwd, dim3(grid), dim3(512), LDS_BYTES, stream, p); }
#endif
}
```
